# Optimizing an MI355X kernel written in HIP

```python
import math
import jax, jax.numpy as jnp
from jax import lax
import numpy as np

D_MODEL = 1024
BATCH = 8
SEQ = 2048
DEPTH = 1

N_MEM = 256
EPS = 1e-6
MLA_HEADS = 8
MLA_NOPE = 64
MLA_ROPE = 32
MLA_V = 64
MLA_Q_RANK = 384
MLA_KV_RANK = 256
ROPE_THETA = 10000.0
Q_BLOCK = 128
GLA_HEADS = 4
GLA_DK = 64
GLA_DV = 128
GLA_GATE_RANK = 16
GLA_TAU = 16.0
GLA_CHUNK = 64
X_HEADS = 4
X_DH = 128
D_FF = 2816
N_BRANCH = 3
IN_WIDTHS = (MLA_Q_RANK, MLA_KV_RANK, MLA_ROPE,
             GLA_HEADS * GLA_DK, GLA_HEADS * GLA_DK, GLA_HEADS * GLA_DV, GLA_GATE_RANK, GLA_HEADS * GLA_DV,
             X_HEADS * X_DH,
             N_BRANCH * D_MODEL)
D_IN = (MLA_Q_RANK + MLA_KV_RANK + MLA_ROPE + 2 * GLA_HEADS * GLA_DK + 2 * GLA_HEADS * GLA_DV
        + GLA_GATE_RANK + X_HEADS * X_DH + N_BRANCH * D_MODEL)

kernel_name = "hybrid_mla_gla_xattn_macaron"


def _rmsnorm(x, g):
    x32 = x.astype(jnp.float32)
    y = x32 * lax.rsqrt(jnp.mean(x32 * x32, axis=-1, keepdims=True) + EPS)
    return (y * g.astype(jnp.float32)).astype(x.dtype)


def _swiglu(x, wg, wu, wd):
    return (jax.nn.silu(x @ wg) * (x @ wu)) @ wd


def _rope(x, pos):
    half = x.shape[-1] // 2
    inv_freq = ROPE_THETA ** (-jnp.arange(half, dtype=jnp.float32) / half)
    ang = pos.astype(jnp.float32)[..., None] * inv_freq
    cos = jnp.cos(ang).astype(x.dtype)
    sin = jnp.sin(ang).astype(x.dtype)
    x1, x2 = x[..., :half], x[..., half:]
    return jnp.concatenate([x1 * cos - x2 * sin, x1 * sin + x2 * cos], axis=-1)


def _split_cols(z, widths):
    outs, start = [], 0
    for w in widths:
        outs.append(z[..., start:start + w])
        start += w
    return outs


def _mla(cq, ckv, krope, pos, q_norm, w_uq, kv_norm, w_ukv):
    B, S, _ = cq.shape
    H = MLA_HEADS
    q = (_rmsnorm(cq, q_norm) @ w_uq).reshape(B, S, H, MLA_NOPE + MLA_ROPE).transpose(0, 2, 1, 3)
    q = jnp.concatenate([q[..., :MLA_NOPE], _rope(q[..., MLA_NOPE:], pos[:, None, :])], axis=-1)
    kv = (_rmsnorm(ckv, kv_norm) @ w_ukv).reshape(B, S, H, MLA_NOPE + MLA_V).transpose(0, 2, 1, 3)
    k_nope, v = kv[..., :MLA_NOPE], kv[..., MLA_NOPE:]
    k_rope = jnp.broadcast_to(_rope(krope, pos)[:, None], (B, H, S, MLA_ROPE))
    k = jnp.concatenate([k_nope, k_rope], axis=-1)
    scale = 1.0 / math.sqrt(MLA_NOPE + MLA_ROPE)
    neg = jnp.finfo(jnp.float32).min
    outs = []
    for i in range(S // Q_BLOCK):
        s0, e = i * Q_BLOCK, (i + 1) * Q_BLOCK
        s = jnp.einsum('bhqd,bhkd->bhqk', q[:, :, s0:e], k[:, :, :e]).astype(jnp.float32) * scale
        mask = (s0 + jnp.arange(Q_BLOCK))[:, None] >= jnp.arange(e)[None, :]
        p = jax.nn.softmax(jnp.where(mask, s, neg), axis=-1).astype(v.dtype)
        outs.append(jnp.einsum('bhqk,bhkd->bhqd', p, v[:, :, :e]))
    o = jnp.concatenate(outs, axis=2)
    return o.transpose(0, 2, 1, 3).reshape(B, S, H * MLA_V)


def _gla(q, k, v, a_lr, r, w_a2, b_a, o_norm):
    B, S, _ = q.shape
    H, C = GLA_HEADS, GLA_CHUNK
    N = S // C
    f32 = jnp.float32

    def chunks(t, d):
        return t.reshape(B, N, C, H, d).transpose(0, 3, 1, 2, 4)

    qc = chunks(q.astype(f32), GLA_DK) * (GLA_DK ** -0.5)
    kc = chunks(k.astype(f32), GLA_DK)
    vc = chunks(v.astype(f32), GLA_DV)
    log_a = jax.nn.log_sigmoid((a_lr @ w_a2 + b_a).astype(f32)) / GLA_TAU
    bcum = jnp.cumsum(chunks(log_a, GLA_DK), axis=3)
    q_t = qc * jnp.exp(bcum)
    k_t = kc * jnp.exp(-bcum)
    att = jnp.einsum('bhncd,bhnjd->bhncj', q_t, k_t)
    tril = jnp.tril(jnp.ones((C, C), dtype=bool))
    o_intra = jnp.einsum('bhncj,bhnjv->bhncv', jnp.where(tril, att, 0.0), vc)
    b_last = bcum[:, :, :, -1:, :]
    dS = jnp.einsum('bhncd,bhncv->bhndv', kc * jnp.exp(b_last - bcum), vc)
    decay = jnp.exp(b_last[:, :, :, 0, :])

    def step(state, inp):
        dec, ds = inp
        return dec[..., None] * state + ds, state

    s0 = jnp.zeros((B, H, GLA_DK, GLA_DV), f32)
    _, s_prev = lax.scan(step, s0, (decay.transpose(2, 0, 1, 3), dS.transpose(2, 0, 1, 3, 4)))
    o_inter = jnp.einsum('bhncd,bhndv->bhncv', q_t, s_prev.transpose(1, 2, 0, 3, 4))
    o = (o_intra + o_inter).reshape(B, H, S, GLA_DV)
    o = _rmsnorm(o, o_norm)
    o = o.transpose(0, 2, 1, 3).reshape(B, S, H * GLA_DV).astype(r.dtype)
    return o * jax.nn.silu(r)


def _cross(xq, mem_n, w_kv):
    B, S, _ = xq.shape
    M = mem_n.shape[1]
    kv = (mem_n @ w_kv).reshape(B, M, 2, X_HEADS, X_DH)
    q = xq.reshape(B, S, X_HEADS, X_DH)
    s = jnp.einsum('bshd,bmhd->bhsm', q, kv[:, :, 0]).astype(jnp.float32) / math.sqrt(X_DH)
    p = jax.nn.softmax(s, axis=-1).astype(kv.dtype)
    o = jnp.einsum('bhsm,bmhd->bshd', p, kv[:, :, 1])
    return o.reshape(B, S, X_HEADS * X_DH)


def _mixer(h, mem, positions, mix_norm, mem_norm, w_in, gate_bias,
           mla_q_norm, mla_w_uq, mla_kv_norm, mla_w_ukv, mla_w_o,
           gla_w_a2, gla_b_a, gla_o_norm, gla_w_o, x_w_kv, x_w_o, w_out):
    B, S, D = h.shape
    u = _rmsnorm(h, mix_norm)
    z = u @ w_in
    cq, ckv, krope, gq, gk, gv, ga, gr, xq, gz = _split_cols(z, IN_WIDTHS)
    o_mla = _mla(cq, ckv, krope, positions, mla_q_norm, mla_w_uq, mla_kv_norm, mla_w_ukv) @ mla_w_o
    o_gla = _gla(gq, gk, gv, ga, gr, gla_w_a2, gla_b_a, gla_o_norm) @ gla_w_o
    o_x = _cross(xq, _rmsnorm(mem, mem_norm), x_w_kv) @ x_w_o
    gates = jax.nn.sigmoid(gz.reshape(B, S, N_BRANCH, D) + gate_bias)
    merged = gates[:, :, 0] * o_mla + gates[:, :, 1] * o_gla + gates[:, :, 2] * o_x
    return merged @ w_out


def setup_inputs(seed: int = 0) -> dict:
    key = jax.random.key(seed)
    ks = iter(jax.random.split(key, 40))
    L, D, F = DEPTH, D_MODEL, D_FF

    def w(shape, fan_in):
        return jax.random.normal(next(ks), shape, jnp.float32) * (fan_in ** -0.5)

    def gain(shape):
        return 1.0 + 0.05 * jax.random.normal(next(ks), shape, jnp.float32)

    def bias(shape, s=0.1):
        return s * jax.random.normal(next(ks), shape, jnp.float32)

    x = jax.random.normal(next(ks), (BATCH, SEQ, D), jnp.float32)
    mem = jax.random.normal(next(ks), (BATCH, N_MEM, D), jnp.float32)
    start = jax.random.randint(next(ks), (BATCH, 1), 0, 4096, dtype=jnp.int32)
    positions = (start + jnp.arange(SEQ, dtype=jnp.int32)[None, :]).astype(jnp.int32)
    return {
        "x": x, "mem": mem, "positions": positions,
        "ffn1_norm": gain((L, D)), "ffn1_wg": w((L, D, F), D), "ffn1_wu": w((L, D, F), D), "ffn1_wd": w((L, F, D), F),
        "mix_norm": gain((L, D)), "mem_norm": gain((L, D)),
        "w_in": w((L, D, D_IN), D), "gate_bias": bias((L, N_BRANCH, D)),
        "mla_q_norm": gain((L, MLA_Q_RANK)),
        "mla_w_uq": w((L, MLA_Q_RANK, MLA_HEADS * (MLA_NOPE + MLA_ROPE)), MLA_Q_RANK),
        "mla_kv_norm": gain((L, MLA_KV_RANK)),
        "mla_w_ukv": w((L, MLA_KV_RANK, MLA_HEADS * (MLA_NOPE + MLA_V)), MLA_KV_RANK),
        "mla_w_o": w((L, MLA_HEADS * MLA_V, D), MLA_HEADS * MLA_V),
        "gla_w_a2": w((L, GLA_GATE_RANK, GLA_HEADS * GLA_DK), GLA_GATE_RANK),
        "gla_b_a": bias((L, GLA_HEADS * GLA_DK)),
        "gla_o_norm": gain((L, GLA_DV)),
        "gla_w_o": w((L, GLA_HEADS * GLA_DV, D), GLA_HEADS * GLA_DV),
        "x_w_kv": w((L, D, 2 * X_HEADS * X_DH), D),
        "x_w_o": w((L, X_HEADS * X_DH, D), X_HEADS * X_DH),
        "w_out": w((L, D, D), D),
        "ffn2_norm": gain((L, D)), "ffn2_wg": w((L, D, F), D), "ffn2_wu": w((L, D, F), D), "ffn2_wd": w((L, F, D), F),
        "final_norm": gain((D,)),
    }


def reference(x, mem, positions, ffn1_norm, ffn1_wg, ffn1_wu, ffn1_wd, mix_norm, mem_norm, w_in, gate_bias,
              mla_q_norm, mla_w_uq, mla_kv_norm, mla_w_ukv, mla_w_o, gla_w_a2, gla_b_a, gla_o_norm, gla_w_o,
              x_w_kv, x_w_o, w_out, ffn2_norm, ffn2_wg, ffn2_wu, ffn2_wd, final_norm):
    h = x
    for l in range(DEPTH):
        h = h + 0.5 * _swiglu(_rmsnorm(h, ffn1_norm[l]), ffn1_wg[l], ffn1_wu[l], ffn1_wd[l])
        h = h + _mixer(h, mem, positions, mix_norm[l], mem_norm[l], w_in[l], gate_bias[l],
                       mla_q_norm[l], mla_w_uq[l], mla_kv_norm[l], mla_w_ukv[l], mla_w_o[l],
                       gla_w_a2[l], gla_b_a[l], gla_o_norm[l], gla_w_o[l], x_w_kv[l], x_w_o[l], w_out[l])
        h = h + 0.5 * _swiglu(_rmsnorm(h, ffn2_norm[l]), ffn2_wg[l], ffn2_wu[l], ffn2_wd[l])
    return _rmsnorm(h, final_norm)
```

```cpp
#include <hip/hip_runtime.h>
#include <cstdint>
#include <cstdio>

typedef unsigned short bf16;
__device__ __forceinline__ float bf2f(bf16 v) { return __uint_as_float((unsigned)v << 16); }
__device__ __forceinline__ bf16 f2bf(float f) { unsigned u = __float_as_uint(f); return (bf16)((u + 0x7fffu + ((u >> 16) & 1u)) >> 16); }

constexpr int NB = 8, SEQ = 2048, D = 1024, M = NB * SEQ, NMEM = 256, MMEM = NB * NMEM, FF = 2816, DIN = 5808;
constexpr float EPS = 1e-6f;
constexpr int ZC_W = 512, ZKV_W = 256, ZG_W = 1536, ZXQ_W = 512, Z1_W = 2816;
constexpr int ZC_KROPE = 384, ZC_GA = 416;
constexpr int ZG_Q = 0, ZG_K = 256, ZG_V = 512, ZG_R = 1024;
constexpr int QW = 768, KVW = 1024;
constexpr float QSCALE = 0.10206207261596577f * 1.4426950408889634f;
constexpr float XSCALE = 0.08838834764831845f * 1.4426950408889634f;
constexpr int GLA_N = SEQ / 64;

constexpr size_t MiB = 1u << 20;
constexpr size_t WS_CTL = 0, WS_COS = 1 * MiB, WS_SIN = 2 * MiB, WS_SSQQ = 3 * MiB, WS_SSQKV = 4 * MiB;
constexpr size_t WS_WGU1 = 5 * MiB, WS_WD1 = 16 * MiB, WS_WIN1 = 21 * MiB + 512 * 1024, WS_WGZ = 27 * MiB, WS_WUQ = 33 * MiB, WS_WUKV = 34 * MiB, WS_WOM = 35 * MiB, WS_WOG = 36 * MiB,
                 WS_WOX = 37 * MiB, WS_WXKV = 38 * MiB, WS_WOUT = 40 * MiB, WS_WGU2 = 42 * MiB, WS_WD2 = 53 * MiB;
constexpr size_t WS_MEMN = 59 * MiB, WS_XN = 63 * MiB, WS_SCR = 95 * MiB;
constexpr size_t SC_ACT = WS_SCR, SC_OMLA = WS_SCR, SC_OGLA = WS_SCR + 16 * MiB, SC_OX = WS_SCR + 32 * MiB, SC_KVX = WS_SCR + 48 * MiB, SC_GZ = WS_SCR + 52 * MiB,
                 SC_ZC = WS_SCR + 52 * MiB, SC_ZKV = WS_SCR + 68 * MiB, SC_ZG = WS_SCR + 76 * MiB, SC_DS = WS_SCR + 124 * MiB, SC_DEC = WS_SCR + 156 * MiB, SC_SPREV = WS_SCR,
                 SC_Q = WS_SCR + 76 * MiB, SC_KVM = WS_SCR + 100 * MiB, SC_KR = WS_SCR + 132 * MiB, SC_MERGED = WS_XN;
constexpr size_t WS_END = 256 * MiB;
static_assert(SC_DEC + MiB <= WS_END && SC_GZ + 96 * MiB <= WS_END, "ws map");

struct P {
    const float *x, *mem; const int* pos;
    const float *ffn1_norm, *ffn1_wg, *ffn1_wu, *ffn1_wd, *mix_norm, *mem_norm, *w_in, *gate_bias, *q_norm, *w_uq, *kv_norm, *w_ukv, *w_o_mla, *w_a2, *b_a, *o_norm, *w_o_gla,
        *x_w_kv, *x_w_o, *w_out, *ffn2_norm, *ffn2_wg, *ffn2_wu, *ffn2_wd, *final_norm;
    float* out; unsigned char* ws;
};

template <bool F32OUT> __global__ void __launch_bounds__(256) n_rmsnorm(const float* in, const float* g, bf16* outb, float* outf, int rows) {
    const int row = blockIdx.x * 4 + (threadIdx.x >> 6), lane = threadIdx.x & 63; if (row >= rows) return;
    const float* r = in + (size_t)row * D; float v[16]; float s = 0.f;
#pragma unroll
    for (int j = 0; j < 16; ++j) { v[j] = r[lane + 64 * j]; s += v[j] * v[j]; }
#pragma unroll
    for (int o = 1; o < 64; o <<= 1) s += __shfl_xor(s, o);
    const float rs = rsqrtf(s * (1.f / D) + EPS);
#pragma unroll
    for (int j = 0; j < 16; ++j) { const float y = v[j] * rs * g[lane + 64 * j]; if (F32OUT) outf[(size_t)row * D + lane + 64 * j] = y; else outb[(size_t)row * D + lane + 64 * j] = f2bf(y); }
}
__global__ void __launch_bounds__(256) n_rope_tab(const int* pos, float* cs, float* sn) {
    const int i = blockIdx.x * 256 + threadIdx.x; if (i >= M * 16) return; const int m = i >> 4, j = i & 15;
    const float inv = powf(10000.f, -(float)j / 16.f); const float ang = (float)pos[m] * inv; cs[i] = cosf(ang); sn[i] = sinf(ang);
}
template <int NACC, class Desc> __global__ void __launch_bounds__(256) n_gemm(Desc d) {
    __shared__ float As[NACC][16][65], Bs[NACC][16][65];
    const int tid = threadIdx.x, tx = tid & 15, ty = tid >> 4, row0 = blockIdx.y * 64, col0 = blockIdx.x * 64;
    float acc[NACC][4][4];
#pragma unroll
    for (int s = 0; s < NACC; ++s)
#pragma unroll
        for (int i = 0; i < 4; ++i)
#pragma unroll
            for (int j = 0; j < 4; ++j) acc[s][i][j] = 0.f;
    for (int k0 = 0; k0 < d.K; k0 += 16) {
#pragma unroll
        for (int s = 0; s < NACC; ++s) {
            const int ar = tid >> 2, ak = (tid & 3) * 4;
#pragma unroll
            for (int e = 0; e < 4; ++e) As[s][ak + e][ar] = d.a(s, row0 + ar, k0 + ak + e);
            const int bk = tid >> 4, bc = (tid & 15) * 4;
#pragma unroll
            for (int e = 0; e < 4; ++e) Bs[s][bk][bc + e] = d.b(s, k0 + bk, col0 + bc + e);
        }
        __syncthreads();
#pragma unroll
        for (int k = 0; k < 16; ++k)
#pragma unroll
            for (int s = 0; s < NACC; ++s) {
                float av[4], bv[4];
#pragma unroll
                for (int i = 0; i < 4; ++i) { av[i] = As[s][k][ty * 4 + i]; bv[i] = Bs[s][k][tx * 4 + i]; }
#pragma unroll
                for (int i = 0; i < 4; ++i)
#pragma unroll
                    for (int j = 0; j < 4; ++j) acc[s][i][j] += av[i] * bv[j];
            }
        __syncthreads();
    }
#pragma unroll
    for (int i = 0; i < 4; ++i)
#pragma unroll
        for (int j = 0; j < 4; ++j) { float a[NACC];
#pragma unroll
            for (int s = 0; s < NACC; ++s) a[s] = acc[s][i][j];
            d.epi(row0 + ty * 4 + i, col0 + tx * 4 + j, a); }
}
__device__ __forceinline__ float silu_f(float v) { return v / (1.f + __expf(-v)); }
__device__ __forceinline__ float sigmoid_f(float v) { return 1.f / (1.f + __expf(-v)); }

struct DUp { const bf16* A; const float *wg, *wu; bf16* act; int M, N, K, pad;
    __device__ float a(int, int r, int k) const { return bf2f(A[(size_t)r * D + k]); }
    __device__ float b(int s, int k, int c) const { return (s == 0 ? wg : wu)[(size_t)k * FF + c]; }
    __device__ void epi(int r, int c, const float (&a)[2]) const { act[(size_t)r * FF + c] = f2bf(silu_f(a[0]) * a[1]); } };
struct DRes { const bf16* A; const float* W; const float* base; float* out; int M, N, K, lda; float sc; int pad;
    __device__ float a(int, int r, int k) const { return bf2f(A[(size_t)r * lda + k]); }
    __device__ float b(int, int k, int c) const { return W[(size_t)k * D + c]; }
    __device__ void epi(int r, int c, const float (&a)[1]) const { out[(size_t)r * D + c] = base[(size_t)r * D + c] + sc * a[0]; } };
__device__ __forceinline__ int e1_src(int c) {
    if (c < 384) return c; if (c < 416) return 640 + (c - 384); if (c < 432) return 1696 + (c - 416); if (c < 512) return -1; if (c < 768) return 384 + (c - 512);
    if (c < 1024) return 672 + (c - 768); if (c < 1280) return 928 + (c - 1024); if (c < 1792) return 1184 + (c - 1280); if (c < 2304) return 1712 + (c - 1792); return 2224 + (c - 2304); }
struct DE1 { const bf16* A; const float* W; bf16 *zc, *zkv, *zg, *zxq; int M, N, K, pad;
    __device__ float a(int, int r, int k) const { return bf2f(A[(size_t)r * D + k]); }
    __device__ float b(int, int k, int c) const { const int s = e1_src(c); return s < 0 ? 0.f : W[(size_t)k * DIN + s]; }
    __device__ void epi(int r, int c, const float (&a)[1]) const { const bf16 v = f2bf(a[0]);
        if (c < 512) zc[(size_t)r * ZC_W + c] = v; else if (c < 768) zkv[(size_t)r * ZKV_W + c - 512] = v; else if (c < 2304) zg[(size_t)r * ZG_W + c - 768] = v; else zxq[(size_t)r * ZXQ_W + c - 2304] = v; } };
struct DPlain { const bf16* A; const float* W; bf16* O; int M, N, K, lda, ldw, ldo;
    __device__ float a(int, int r, int k) const { return bf2f(A[(size_t)r * lda + k]); }
    __device__ float b(int, int k, int c) const { return W[(size_t)k * ldw + c]; }
    __device__ void epi(int r, int c, const float (&a)[1]) const { O[(size_t)r * ldo + c] = f2bf(a[0]); } };
struct DQ { const bf16* zc; const float *W, *g, *ssq; bf16* Q; int M, N, K, pad;
    __device__ float a(int, int r, int k) const { return bf2f(zc[(size_t)r * ZC_W + k]); }
    __device__ float b(int, int k, int c) const { const int s = c < 512 ? 96 * (c >> 6) + (c & 63) : 96 * ((c - 512) >> 5) + 64 + (c & 31); return g[k] * W[(size_t)k * 768 + s]; }
    __device__ void epi(int r, int c, const float (&a)[1]) const { float s = 0.f; for (int j = 0; j < 12; ++j) s += ssq[(size_t)r * 12 + j]; Q[(size_t)r * QW + c] = f2bf(a[0] * rsqrtf(s * (1.f / 384.f) + EPS) * QSCALE); } };
struct DKV { const bf16* zkv; const float *W, *g, *ssq; bf16* KV; int M, N, K, pad;
    __device__ float a(int, int r, int k) const { return bf2f(zkv[(size_t)r * ZKV_W + k]); }
    __device__ float b(int, int k, int c) const { const int s = c < 512 ? 128 * (c >> 6) + (c & 63) : 128 * ((c - 512) >> 6) + 64 + (c & 63); return g[k] * W[(size_t)k * 1024 + s]; }
    __device__ void epi(int r, int c, const float (&a)[1]) const { float s = 0.f; for (int j = 0; j < 8; ++j) s += ssq[(size_t)r * 8 + j]; KV[(size_t)r * KVW + c] = f2bf(a[0] * rsqrtf(s * (1.f / 256.f) + EPS)); } };
struct DGate { const bf16* A; const float *W, *bias; bf16* gz; int M, N, K, pad;
    __device__ float a(int, int r, int k) const { return bf2f(A[(size_t)r * D + k]); }
    __device__ float b(int, int k, int c) const { return W[(size_t)k * DIN + 2736 + c]; }
    __device__ void epi(int r, int c, const float (&a)[1]) const { gz[(size_t)r * 3072 + c] = f2bf(sigmoid_f(a[0] + bias[c])); } };
struct DMerge { const bf16* O0; const float *W0, *W1, *W2; const bf16* gz; bf16* mg; int M, N, K, pad;
    __device__ float a(int s, int r, int k) const { return bf2f(O0[(size_t)s * M * 512 + (size_t)r * 512 + k]); }
    __device__ float b(int s, int k, int c) const { return (s == 0 ? W0 : s == 1 ? W1 : W2)[(size_t)k * D + c]; }
    __device__ void epi(int r, int c, const float (&a)[3]) const { const bf16* gp = gz + (size_t)r * 3072 + c; const float v = bf2f(gp[0]) * a[0] + bf2f(gp[1024]) * a[1] + bf2f(gp[2048]) * a[2]; mg[(size_t)r * D + c] = f2bf(v); } };

__global__ void __launch_bounds__(256) n_ssq(const bf16* zc, const bf16* zkv, float* sq, float* skv) {
    const int i = blockIdx.x * 256 + threadIdx.x; if (i >= M * 20) return; const int r = i / 20, j = i % 20; float s = 0.f;
    if (j < 12) { for (int c = 0; c < 32; ++c) { const float v = bf2f(zc[(size_t)r * ZC_W + 32 * j + c]); s += v * v; } sq[(size_t)r * 12 + j] = s; }
    else { for (int c = 0; c < 32; ++c) { const float v = bf2f(zkv[(size_t)r * ZKV_W + 32 * (j - 12) + c]); s += v * v; } skv[(size_t)r * 8 + (j - 12)] = s; }
}
__global__ void __launch_bounds__(256) n_rope(bf16* Q, const bf16* zc, bf16* KR, const float* cs, const float* sn) {
    const int i = blockIdx.x * 256 + threadIdx.x; if (i >= M * 9 * 16) return; const int r = i / 144, h = (i % 144) / 16, j = i & 15;
    const float c = cs[r * 16 + j], s = sn[r * 16 + j];
    if (h < 8) { bf16* q = Q + (size_t)r * QW + 512 + 32 * h; const float x1 = bf2f(q[j]), x2 = bf2f(q[j + 16]); q[j] = f2bf(x1 * c - x2 * s); q[j + 16] = f2bf(x1 * s + x2 * c); }
    else { const bf16* z = zc + (size_t)r * ZC_W + ZC_KROPE; const float x1 = bf2f(z[j]), x2 = bf2f(z[j + 16]); KR[(size_t)r * 32 + j] = f2bf(x1 * c - x2 * s); KR[(size_t)r * 32 + j + 16] = f2bf(x1 * s + x2 * c); }
}
__global__ void __launch_bounds__(256) n_mla_attn(const bf16* Q, const bf16* KV, const bf16* KR, bf16* O) {
    const int i = blockIdx.x * 256 + threadIdx.x; const int sl = i & 3, q = (i >> 2) % SEQ, h = (i >> 2) / SEQ % 8, b = (i >> 2) / SEQ / 8; if (b >= NB) return;
    const size_t r = (size_t)b * SEQ + q; float qv[96];
#pragma unroll
    for (int d = 0; d < 64; ++d) qv[d] = bf2f(Q[r * QW + 64 * h + d]);
#pragma unroll
    for (int d = 0; d < 32; ++d) qv[64 + d] = bf2f(Q[r * QW + 512 + 32 * h + d]);
    float m = -INFINITY, l = 0.f, acc[16];
#pragma unroll
    for (int d = 0; d < 16; ++d) acc[d] = 0.f;
    for (int k = 0; k <= q; ++k) { const size_t kr = (size_t)b * SEQ + k; float s = 0.f;
#pragma unroll
        for (int d = 0; d < 64; ++d) s += qv[d] * bf2f(KV[kr * KVW + 64 * h + d]);
#pragma unroll
        for (int d = 0; d < 32; ++d) s += qv[64 + d] * bf2f(KR[kr * 32 + d]);
        const float mn = fmaxf(m, s), f = exp2f(m - mn), p = exp2f(s - mn); m = mn; l = l * f + p;
#pragma unroll
        for (int d = 0; d < 16; ++d) acc[d] = acc[d] * f + p * bf2f(KV[kr * KVW + 512 + 64 * h + 16 * sl + d]); }
    const float il = 1.f / l;
#pragma unroll
    for (int d = 0; d < 16; ++d) O[r * 512 + 64 * h + 16 * sl + d] = f2bf(acc[d] * il);
}
__global__ void __launch_bounds__(256) n_cross_attn(const bf16* XQ, const bf16* KVX, bf16* O) {
    const int i = blockIdx.x * 256 + threadIdx.x; const int sl = i & 3, q = (i >> 2) % SEQ, h = (i >> 2) / SEQ % 4, b = (i >> 2) / SEQ / 4; if (b >= NB) return;
    const size_t r = (size_t)b * SEQ + q; float qv[128];
#pragma unroll
    for (int d = 0; d < 128; ++d) qv[d] = bf2f(XQ[r * ZXQ_W + 128 * h + d]) * XSCALE;
    float m = -INFINITY, l = 0.f, acc[32];
#pragma unroll
    for (int d = 0; d < 32; ++d) acc[d] = 0.f;
    for (int k = 0; k < NMEM; ++k) { const size_t kr = (size_t)b * NMEM + k; float s = 0.f;
#pragma unroll
        for (int d = 0; d < 128; ++d) s += qv[d] * bf2f(KVX[kr * 1024 + 128 * h + d]);
        const float mn = fmaxf(m, s), f = exp2f(m - mn), p = exp2f(s - mn); m = mn; l = l * f + p;
#pragma unroll
        for (int d = 0; d < 32; ++d) acc[d] = acc[d] * f + p * bf2f(KVX[kr * 1024 + 512 + 128 * h + 32 * sl + d]); }
    const float il = 1.f / l;
#pragma unroll
    for (int d = 0; d < 32; ++d) O[r * 512 + 128 * h + 32 * sl + d] = f2bf(acc[d] * il);
}
__global__ void __launch_bounds__(128) n_gla_rec(const bf16* zc, const bf16* zg, const float* w_a2, const float* b_a, float* otmp) {
    __shared__ float a_s[64], k_s[64], q_s[64];
    const int b = blockIdx.x >> 2, h = blockIdx.x & 3, dv = threadIdx.x; float S[64];
#pragma unroll
    for (int d = 0; d < 64; ++d) S[d] = 0.f;
    for (int t = 0; t < SEQ; ++t) { const size_t r = (size_t)b * SEQ + t;
        if (dv < 64) { float pre = b_a[64 * h + dv];
            for (int j = 0; j < 16; ++j) pre += bf2f(zc[r * ZC_W + ZC_GA + j]) * w_a2[j * 256 + 64 * h + dv];
            const float ls = fminf(pre, 0.f) - log1pf(__expf(-fabsf(pre)));
            a_s[dv] = __expf(ls * (1.f / 16.f)); k_s[dv] = bf2f(zg[r * ZG_W + ZG_K + 64 * h + dv]); q_s[dv] = bf2f(zg[r * ZG_W + ZG_Q + 64 * h + dv]); }
        __syncthreads();
        const float v = bf2f(zg[r * ZG_W + ZG_V + 128 * h + dv]); float o = 0.f;
#pragma unroll
        for (int d = 0; d < 64; ++d) { S[d] = a_s[d] * S[d] + k_s[d] * v; o += q_s[d] * S[d]; }
        otmp[r * 512 + 128 * h + dv] = o * 0.125f;
        __syncthreads(); }
}
__global__ void __launch_bounds__(256) n_gla_fin(const float* otmp, const bf16* zg, const float* o_norm, bf16* O) {
    const int w = blockIdx.x * 4 + (threadIdx.x >> 6), lane = threadIdx.x & 63; if (w >= M * 4) return; const int r = w >> 2, h = w & 3;
    const float a = otmp[(size_t)r * 512 + 128 * h + lane], c = otmp[(size_t)r * 512 + 128 * h + 64 + lane]; float s = a * a + c * c;
#pragma unroll
    for (int o = 1; o < 64; o <<= 1) s += __shfl_xor(s, o);
    const float rs = rsqrtf(s * (1.f / 128.f) + EPS);
    const float r0 = bf2f(zg[(size_t)r * ZG_W + ZG_R + 128 * h + lane]), r1 = bf2f(zg[(size_t)r * ZG_W + ZG_R + 128 * h + 64 + lane]);
    O[(size_t)r * 512 + 128 * h + lane] = f2bf(a * rs * o_norm[lane] * silu_f(r0)); O[(size_t)r * 512 + 128 * h + 64 + lane] = f2bf(c * rs * o_norm[64 + lane] * silu_f(r1));
}

extern "C" void kernel_launch(void* const* d_in, const int* in_sizes, int n_in, void* d_out, int out_size, void* d_ws, size_t ws_size, hipStream_t stream) {
    if (n_in != 28 || in_sizes[0] != M * D || out_size != M * D || ws_size < WS_END) { fprintf(stderr, "kernel_launch: unexpected shapes (n_in %d, in0 %d, out %d, ws %zu)\n", n_in, n_in > 0 ? in_sizes[0] : -1, out_size, ws_size); return; }
    P p{};
    p.x = (const float*)d_in[0]; p.mem = (const float*)d_in[1]; p.pos = (const int*)d_in[2];
    p.ffn1_norm = (const float*)d_in[3]; p.ffn1_wg = (const float*)d_in[4]; p.ffn1_wu = (const float*)d_in[5]; p.ffn1_wd = (const float*)d_in[6]; p.mix_norm = (const float*)d_in[7]; p.mem_norm = (const float*)d_in[8];
    p.w_in = (const float*)d_in[9]; p.gate_bias = (const float*)d_in[10]; p.q_norm = (const float*)d_in[11]; p.w_uq = (const float*)d_in[12]; p.kv_norm = (const float*)d_in[13]; p.w_ukv = (const float*)d_in[14];
    p.w_o_mla = (const float*)d_in[15]; p.w_a2 = (const float*)d_in[16]; p.b_a = (const float*)d_in[17]; p.o_norm = (const float*)d_in[18]; p.w_o_gla = (const float*)d_in[19]; p.x_w_kv = (const float*)d_in[20];
    p.x_w_o = (const float*)d_in[21]; p.w_out = (const float*)d_in[22]; p.ffn2_norm = (const float*)d_in[23]; p.ffn2_wg = (const float*)d_in[24]; p.ffn2_wu = (const float*)d_in[25]; p.ffn2_wd = (const float*)d_in[26];
    p.final_norm = (const float*)d_in[27]; p.out = (float*)d_out; p.ws = (unsigned char*)d_ws;
    unsigned char* ws = p.ws;
    float *cs = (float*)(ws + WS_COS), *sn = (float*)(ws + WS_SIN), *ssqq = (float*)(ws + WS_SSQQ), *ssqkv = (float*)(ws + WS_SSQKV);
    bf16 *XN = (bf16*)(ws + WS_XN), *MEMN = (bf16*)(ws + WS_MEMN), *ACT = (bf16*)(ws + SC_ACT), *OMLA = (bf16*)(ws + SC_OMLA), *OGLA = (bf16*)(ws + SC_OGLA), *OX = (bf16*)(ws + SC_OX), *KVX = (bf16*)(ws + SC_KVX),
         *GZ = (bf16*)(ws + SC_GZ), *ZC = (bf16*)(ws + SC_ZC), *ZKV = (bf16*)(ws + SC_ZKV), *ZG = (bf16*)(ws + SC_ZG), *ZXQ = OX, *Q = (bf16*)(ws + SC_Q), *KVM = (bf16*)(ws + SC_KVM), *KR = (bf16*)(ws + SC_KR),
         *MERGED = (bf16*)(ws + SC_MERGED);
    float* OTMP = (float*)(ws + SC_DS);
    n_rope_tab<<<M * 16 / 256, 256, 0, stream>>>(p.pos, cs, sn);
    n_rmsnorm<false><<<M / 4, 256, 0, stream>>>(p.x, p.ffn1_norm, XN, nullptr, M);
    n_rmsnorm<false><<<MMEM / 4, 256, 0, stream>>>(p.mem, p.mem_norm, MEMN, nullptr, MMEM);
    n_gemm<2, DUp><<<dim3(FF / 64, M / 64), 256, 0, stream>>>(DUp{XN, p.ffn1_wg, p.ffn1_wu, ACT, M, FF, D, 0});
    n_gemm<1, DRes><<<dim3(D / 64, M / 64), 256, 0, stream>>>(DRes{ACT, p.ffn1_wd, p.x, p.out, M, D, FF, FF, 0.5f, 0});
    n_rmsnorm<false><<<M / 4, 256, 0, stream>>>(p.out, p.mix_norm, XN, nullptr, M);
    n_gemm<1, DE1><<<dim3(Z1_W / 64, M / 64), 256, 0, stream>>>(DE1{XN, p.w_in, ZC, ZKV, ZG, ZXQ, M, Z1_W, D, 0});
    n_gemm<1, DPlain><<<dim3(1024 / 64, MMEM / 64), 256, 0, stream>>>(DPlain{MEMN, p.x_w_kv, KVX, MMEM, 1024, D, D, 1024, 1024});
    n_ssq<<<(M * 20 + 255) / 256, 256, 0, stream>>>(ZC, ZKV, ssqq, ssqkv);
    n_gla_rec<<<NB * 4, 128, 0, stream>>>(ZC, ZG, p.w_a2, p.b_a, OTMP);
    n_gla_fin<<<M * 4 / 4, 256, 0, stream>>>(OTMP, ZG, p.o_norm, OGLA);
    n_gemm<1, DQ><<<dim3(QW / 64, M / 64), 256, 0, stream>>>(DQ{ZC, p.w_uq, p.q_norm, ssqq, Q, M, QW, 384, 0});
    n_gemm<1, DKV><<<dim3(KVW / 64, M / 64), 256, 0, stream>>>(DKV{ZKV, p.w_ukv, p.kv_norm, ssqkv, KVM, M, KVW, 256, 0});
    n_rope<<<(M * 144 + 255) / 256, 256, 0, stream>>>(Q, ZC, KR, cs, sn);
    n_mla_attn<<<NB * 8 * SEQ * 4 / 256, 256, 0, stream>>>(Q, KVM, KR, OMLA);
    { bf16* OXT = (bf16*)(ws + SC_DS); n_cross_attn<<<NB * 4 * SEQ * 4 / 256, 256, 0, stream>>>(ZXQ, KVX, OXT); (void)hipMemcpyAsync(OX, OXT, (size_t)M * 512 * 2, hipMemcpyDeviceToDevice, stream); }
    n_gemm<1, DGate><<<dim3(3072 / 64, M / 64), 256, 0, stream>>>(DGate{XN, p.w_in, p.gate_bias, GZ, M, 3072, D, 0});
    n_gemm<3, DMerge><<<dim3(D / 64, M / 64), 256, 0, stream>>>(DMerge{OMLA, p.w_o_mla, p.w_o_gla, p.x_w_o, GZ, MERGED, M, D, 512, 0});
    n_gemm<1, DRes><<<dim3(D / 64, M / 64), 256, 0, stream>>>(DRes{MERGED, p.w_out, p.out, p.out, M, D, D, D, 1.0f, 0});
    n_rmsnorm<false><<<M / 4, 256, 0, stream>>>(p.out, p.ffn2_norm, XN, nullptr, M);
    n_gemm<2, DUp><<<dim3(FF / 64, M / 64), 256, 0, stream>>>(DUp{XN, p.ffn2_wg, p.ffn2_wu, ACT, M, FF, D, 0});
    n_gemm<1, DRes><<<dim3(D / 64, M / 64), 256, 0, stream>>>(DRes{ACT, p.ffn2_wd, p.out, p.out, M, D, FF, FF, 0.5f, 0});
    n_rmsnorm<true><<<M / 4, 256, 0, stream>>>(p.out, p.final_norm, nullptr, p.out, M);
}
```

```cpp
#include <hip/hip_runtime.h>
#include <cstdint>
#include <cstdio>


typedef unsigned short bf16;
__device__ __forceinline__ float bf2f(bf16 v) { return __uint_as_float((unsigned)v << 16); }
__device__ __forceinline__ bf16 f2bf(float f) { unsigned u = __float_as_uint(f); return (bf16)((u + 0x7fffu + ((u >> 16) & 1u)) >> 16); }

constexpr int NB = 8, SEQ = 2048, D = 1024, M = NB * SEQ, NMEM = 256, MMEM = NB * NMEM, FF = 2816, DIN = 5808;
constexpr float EPS = 1e-6f;
constexpr int ZC_W = 512, ZKV_W = 256, ZG_W = 1536, ZXQ_W = 512, Z1_W = 2816;
constexpr int ZC_KROPE = 384, ZC_GA = 416;
constexpr int ZG_Q = 0, ZG_K = 256, ZG_V = 512, ZG_R = 1024;
constexpr int QW = 768, KVW = 1024;
constexpr float QSCALE = 0.10206207261596577f * 1.4426950408889634f;
constexpr float XSCALE = 0.08838834764831845f * 1.4426950408889634f;
constexpr int GLA_N = SEQ / 64;

constexpr size_t MiB = 1u << 20;
constexpr size_t WS_CTL = 0, WS_COS = 1 * MiB, WS_SIN = 2 * MiB, WS_SSQQ = 3 * MiB, WS_SSQKV = 4 * MiB;
constexpr size_t WS_WGU1 = 5 * MiB, WS_WD1 = 16 * MiB, WS_WIN1 = 21 * MiB + 512 * 1024, WS_WGZ = 27 * MiB, WS_WUQ = 33 * MiB, WS_WUKV = 34 * MiB, WS_WOM = 35 * MiB, WS_WOG = 36 * MiB,
                 WS_WOX = 37 * MiB, WS_WXKV = 38 * MiB, WS_WOUT = 40 * MiB, WS_WGU2 = 42 * MiB, WS_WD2 = 53 * MiB;
constexpr size_t WS_MEMN = 59 * MiB, WS_XN = 63 * MiB, WS_SCR = 95 * MiB;
constexpr size_t SC_ACT = WS_SCR, SC_OMLA = WS_SCR, SC_OGLA = WS_SCR + 16 * MiB, SC_OX = WS_SCR + 32 * MiB, SC_KVX = WS_SCR + 48 * MiB, SC_GZ = WS_SCR + 52 * MiB,
                 SC_ZC = WS_SCR + 52 * MiB, SC_ZKV = WS_SCR + 68 * MiB, SC_ZG = WS_SCR + 76 * MiB, SC_DS = WS_SCR + 124 * MiB, SC_DEC = WS_SCR + 156 * MiB, SC_SPREV = WS_SCR,
                 SC_Q = WS_SCR + 76 * MiB, SC_KVM = WS_SCR + 100 * MiB, SC_KR = WS_SCR + 132 * MiB, SC_MERGED = WS_XN;
constexpr size_t WS_END = 256 * MiB;
static_assert(SC_DEC + MiB <= WS_END && SC_GZ + 96 * MiB <= WS_END, "ws map");

struct P {
    const float *x, *mem; const int* pos;
    const float *ffn1_norm, *ffn1_wg, *ffn1_wu, *ffn1_wd, *mix_norm, *mem_norm, *w_in, *gate_bias, *q_norm, *w_uq, *kv_norm, *w_ukv, *w_o_mla, *w_a2, *b_a, *o_norm, *w_o_gla,
        *x_w_kv, *x_w_o, *w_out, *ffn2_norm, *ffn2_wg, *ffn2_wu, *ffn2_wd, *final_norm;
    float* out; unsigned char* ws;
};

template <bool F32OUT> __global__ void __launch_bounds__(256) n_rmsnorm(const float* in, const float* g, bf16* outb, float* outf, int rows) {
    const int row = blockIdx.x * 4 + (threadIdx.x >> 6), lane = threadIdx.x & 63; if (row >= rows) return;
    const float* r = in + (size_t)row * D; float v[16]; float s = 0.f;
#pragma unroll
    for (int j = 0; j < 16; ++j) { v[j] = r[lane + 64 * j]; s += v[j] * v[j]; }
#pragma unroll
    for (int o = 1; o < 64; o <<= 1) s += __shfl_xor(s, o);
    const float rs = rsqrtf(s * (1.f / D) + EPS);
#pragma unroll
    for (int j = 0; j < 16; ++j) { const float y = v[j] * rs * g[lane + 64 * j]; if (F32OUT) outf[(size_t)row * D + lane + 64 * j] = y; else outb[(size_t)row * D + lane + 64 * j] = f2bf(y); }
}
__global__ void __launch_bounds__(256) n_rope_tab(const int* pos, float* cs, float* sn) {
    const int i = blockIdx.x * 256 + threadIdx.x; if (i >= M * 16) return; const int m = i >> 4, j = i & 15;
    const float inv = powf(10000.f, -(float)j / 16.f); const float ang = (float)pos[m] * inv; cs[i] = cosf(ang); sn[i] = sinf(ang);
}
template <int NACC, class Desc> __global__ void __launch_bounds__(256) n_gemm(Desc d) {
    __shared__ float As[NACC][16][65], Bs[NACC][16][65];
    const int tid = threadIdx.x, tx = tid & 15, ty = tid >> 4, row0 = blockIdx.y * 64, col0 = blockIdx.x * 64;
    float acc[NACC][4][4];
#pragma unroll
    for (int s = 0; s < NACC; ++s)
#pragma unroll
        for (int i = 0; i < 4; ++i)
#pragma unroll
            for (int j = 0; j < 4; ++j) acc[s][i][j] = 0.f;
    for (int k0 = 0; k0 < d.K; k0 += 16) {
#pragma unroll
        for (int s = 0; s < NACC; ++s) {
            const int ar = tid >> 2, ak = (tid & 3) * 4;
#pragma unroll
            for (int e = 0; e < 4; ++e) As[s][ak + e][ar] = d.a(s, row0 + ar, k0 + ak + e);
            const int bk = tid >> 4, bc = (tid & 15) * 4;
#pragma unroll
            for (int e = 0; e < 4; ++e) Bs[s][bk][bc + e] = d.b(s, k0 + bk, col0 + bc + e);
        }
        __syncthreads();
#pragma unroll
        for (int k = 0; k < 16; ++k)
#pragma unroll
            for (int s = 0; s < NACC; ++s) {
                float av[4], bv[4];
#pragma unroll
                for (int i = 0; i < 4; ++i) { av[i] = As[s][k][ty * 4 + i]; bv[i] = Bs[s][k][tx * 4 + i]; }
#pragma unroll
                for (int i = 0; i < 4; ++i)
#pragma unroll
                    for (int j = 0; j < 4; ++j) acc[s][i][j] += av[i] * bv[j];
            }
        __syncthreads();
    }
#pragma unroll
    for (int i = 0; i < 4; ++i)
#pragma unroll
        for (int j = 0; j < 4; ++j) { float a[NACC];
#pragma unroll
            for (int s = 0; s < NACC; ++s) a[s] = acc[s][i][j];
            d.epi(row0 + ty * 4 + i, col0 + tx * 4 + j, a); }
}
__device__ __forceinline__ float silu_f(float v) { return v / (1.f + __expf(-v)); }
__device__ __forceinline__ float sigmoid_f(float v) { return 1.f / (1.f + __expf(-v)); }

struct DUp { const bf16* A; const float *wg, *wu; bf16* act; int M, N, K, pad;
    __device__ float a(int, int r, int k) const { return bf2f(A[(size_t)r * D + k]); }
    __device__ float b(int s, int k, int c) const { return (s == 0 ? wg : wu)[(size_t)k * FF + c]; }
    __device__ void epi(int r, int c, const float (&a)[2]) const { act[(size_t)r * FF + c] = f2bf(silu_f(a[0]) * a[1]); } };
struct DRes { const bf16* A; const float* W; const float* base; float* out; int M, N, K, lda; float sc; int pad;
    __device__ float a(int, int r, int k) const { return bf2f(A[(size_t)r * lda + k]); }
    __device__ float b(int, int k, int c) const { return W[(size_t)k * D + c]; }
    __device__ void epi(int r, int c, const float (&a)[1]) const { out[(size_t)r * D + c] = base[(size_t)r * D + c] + sc * a[0]; } };
__device__ __forceinline__ int e1_src(int c) {
    if (c < 384) return c; if (c < 416) return 640 + (c - 384); if (c < 432) return 1696 + (c - 416); if (c < 512) return -1; if (c < 768) return 384 + (c - 512);
    if (c < 1024) return 672 + (c - 768); if (c < 1280) return 928 + (c - 1024); if (c < 1792) return 1184 + (c - 1280); if (c < 2304) return 1712 + (c - 1792); return 2224 + (c - 2304); }
struct DE1 { const bf16* A; const float* W; bf16 *zc, *zkv, *zg, *zxq; int M, N, K, pad;
    __device__ float a(int, int r, int k) const { return bf2f(A[(size_t)r * D + k]); }
    __device__ float b(int, int k, int c) const { const int s = e1_src(c); return s < 0 ? 0.f : W[(size_t)k * DIN + s]; }
    __device__ void epi(int r, int c, const float (&a)[1]) const { const bf16 v = f2bf(a[0]);
        if (c < 512) zc[(size_t)r * ZC_W + c] = v; else if (c < 768) zkv[(size_t)r * ZKV_W + c - 512] = v; else if (c < 2304) zg[(size_t)r * ZG_W + c - 768] = v; else zxq[(size_t)r * ZXQ_W + c - 2304] = v; } };
struct DPlain { const bf16* A; const float* W; bf16* O; int M, N, K, lda, ldw, ldo;
    __device__ float a(int, int r, int k) const { return bf2f(A[(size_t)r * lda + k]); }
    __device__ float b(int, int k, int c) const { return W[(size_t)k * ldw + c]; }
    __device__ void epi(int r, int c, const float (&a)[1]) const { O[(size_t)r * ldo + c] = f2bf(a[0]); } };
struct DQ { const bf16* zc; const float *W, *g, *ssq; bf16* Q; int M, N, K, pad;
    __device__ float a(int, int r, int k) const { return bf2f(zc[(size_t)r * ZC_W + k]); }
    __device__ float b(int, int k, int c) const { const int s = c < 512 ? 96 * (c >> 6) + (c & 63) : 96 * ((c - 512) >> 5) + 64 + (c & 31); return g[k] * W[(size_t)k * 768 + s]; }
    __device__ void epi(int r, int c, const float (&a)[1]) const { float s = 0.f; for (int j = 0; j < 12; ++j) s += ssq[(size_t)r * 12 + j]; Q[(size_t)r * QW + c] = f2bf(a[0] * rsqrtf(s * (1.f / 384.f) + EPS) * QSCALE); } };
struct DKV { const bf16* zkv; const float *W, *g, *ssq; bf16* KV; int M, N, K, pad;
    __device__ float a(int, int r, int k) const { return bf2f(zkv[(size_t)r * ZKV_W + k]); }
    __device__ float b(int, int k, int c) const { const int s = c < 512 ? 128 * (c >> 6) + (c & 63) : 128 * ((c - 512) >> 6) + 64 + (c & 63); return g[k] * W[(size_t)k * 1024 + s]; }
    __device__ void epi(int r, int c, const float (&a)[1]) const { float s = 0.f; for (int j = 0; j < 8; ++j) s += ssq[(size_t)r * 8 + j]; KV[(size_t)r * KVW + c] = f2bf(a[0] * rsqrtf(s * (1.f / 256.f) + EPS)); } };
struct DGate { const bf16* A; const float *W, *bias; bf16* gz; int M, N, K, pad;
    __device__ float a(int, int r, int k) const { return bf2f(A[(size_t)r * D + k]); }
    __device__ float b(int, int k, int c) const { return W[(size_t)k * DIN + 2736 + c]; }
    __device__ void epi(int r, int c, const float (&a)[1]) const { gz[(size_t)r * 3072 + c] = f2bf(sigmoid_f(a[0] + bias[c])); } };
struct DMerge { const bf16* O0; const float *W0, *W1, *W2; const bf16* gz; bf16* mg; int M, N, K, pad;
    __device__ float a(int s, int r, int k) const { return bf2f(O0[(size_t)s * M * 512 + (size_t)r * 512 + k]); }
    __device__ float b(int s, int k, int c) const { return (s == 0 ? W0 : s == 1 ? W1 : W2)[(size_t)k * D + c]; }
    __device__ void epi(int r, int c, const float (&a)[3]) const { const bf16* gp = gz + (size_t)r * 3072 + c; const float v = bf2f(gp[0]) * a[0] + bf2f(gp[1024]) * a[1] + bf2f(gp[2048]) * a[2]; mg[(size_t)r * D + c] = f2bf(v); } };

__global__ void __launch_bounds__(256) n_ssq(const bf16* zc, const bf16* zkv, float* sq, float* skv) {
    const int i = blockIdx.x * 256 + threadIdx.x; if (i >= M * 20) return; const int r = i / 20, j = i % 20; float s = 0.f;
    if (j < 12) { for (int c = 0; c < 32; ++c) { const float v = bf2f(zc[(size_t)r * ZC_W + 32 * j + c]); s += v * v; } sq[(size_t)r * 12 + j] = s; }
    else { for (int c = 0; c < 32; ++c) { const float v = bf2f(zkv[(size_t)r * ZKV_W + 32 * (j - 12) + c]); s += v * v; } skv[(size_t)r * 8 + (j - 12)] = s; }
}
__global__ void __launch_bounds__(256) n_rope(bf16* Q, const bf16* zc, bf16* KR, const float* cs, const float* sn) {
    const int i = blockIdx.x * 256 + threadIdx.x; if (i >= M * 9 * 16) return; const int r = i / 144, h = (i % 144) / 16, j = i & 15;
    const float c = cs[r * 16 + j], s = sn[r * 16 + j];
    if (h < 8) { bf16* q = Q + (size_t)r * QW + 512 + 32 * h; const float x1 = bf2f(q[j]), x2 = bf2f(q[j + 16]); q[j] = f2bf(x1 * c - x2 * s); q[j + 16] = f2bf(x1 * s + x2 * c); }
    else { const bf16* z = zc + (size_t)r * ZC_W + ZC_KROPE; const float x1 = bf2f(z[j]), x2 = bf2f(z[j + 16]); KR[(size_t)r * 32 + j] = f2bf(x1 * c - x2 * s); KR[(size_t)r * 32 + j + 16] = f2bf(x1 * s + x2 * c); }
}
__global__ void __launch_bounds__(256) n_mla_attn(const bf16* Q, const bf16* KV, const bf16* KR, bf16* O) {
    const int i = blockIdx.x * 256 + threadIdx.x; const int sl = i & 3, q = (i >> 2) % SEQ, h = (i >> 2) / SEQ % 8, b = (i >> 2) / SEQ / 8; if (b >= NB) return;
    const size_t r = (size_t)b * SEQ + q; float qv[96];
#pragma unroll
    for (int d = 0; d < 64; ++d) qv[d] = bf2f(Q[r * QW + 64 * h + d]);
#pragma unroll
    for (int d = 0; d < 32; ++d) qv[64 + d] = bf2f(Q[r * QW + 512 + 32 * h + d]);
    float m = -INFINITY, l = 0.f, acc[16];
#pragma unroll
    for (int d = 0; d < 16; ++d) acc[d] = 0.f;
    for (int k = 0; k <= q; ++k) { const size_t kr = (size_t)b * SEQ + k; float s = 0.f;
#pragma unroll
        for (int d = 0; d < 64; ++d) s += qv[d] * bf2f(KV[kr * KVW + 64 * h + d]);
#pragma unroll
        for (int d = 0; d < 32; ++d) s += qv[64 + d] * bf2f(KR[kr * 32 + d]);
        const float mn = fmaxf(m, s), f = exp2f(m - mn), p = exp2f(s - mn); m = mn; l = l * f + p;
#pragma unroll
        for (int d = 0; d < 16; ++d) acc[d] = acc[d] * f + p * bf2f(KV[kr * KVW + 512 + 64 * h + 16 * sl + d]); }
    const float il = 1.f / l;
#pragma unroll
    for (int d = 0; d < 16; ++d) O[r * 512 + 64 * h + 16 * sl + d] = f2bf(acc[d] * il);
}
__global__ void __launch_bounds__(256) n_cross_attn(const bf16* XQ, const bf16* KVX, bf16* O) {
    const int i = blockIdx.x * 256 + threadIdx.x; const int sl = i & 3, q = (i >> 2) % SEQ, h = (i >> 2) / SEQ % 4, b = (i >> 2) / SEQ / 4; if (b >= NB) return;
    const size_t r = (size_t)b * SEQ + q; float qv[128];
#pragma unroll
    for (int d = 0; d < 128; ++d) qv[d] = bf2f(XQ[r * ZXQ_W + 128 * h + d]) * XSCALE;
    float m = -INFINITY, l = 0.f, acc[32];
#pragma unroll
    for (int d = 0; d < 32; ++d) acc[d] = 0.f;
    for (int k = 0; k < NMEM; ++k) { const size_t kr = (size_t)b * NMEM + k; float s = 0.f;
#pragma unroll
        for (int d = 0; d < 128; ++d) s += qv[d] * bf2f(KVX[kr * 1024 + 128 * h + d]);
        const float mn = fmaxf(m, s), f = exp2f(m - mn), p = exp2f(s - mn); m = mn; l = l * f + p;
#pragma unroll
        for (int d = 0; d < 32; ++d) acc[d] = acc[d] * f + p * bf2f(KVX[kr * 1024 + 512 + 128 * h + 32 * sl + d]); }
    const float il = 1.f / l;
#pragma unroll
    for (int d = 0; d < 32; ++d) O[r * 512 + 128 * h + 32 * sl + d] = f2bf(acc[d] * il);
}
__global__ void __launch_bounds__(128) n_gla_rec(const bf16* zc, const bf16* zg, const float* w_a2, const float* b_a, float* otmp) {
    __shared__ float a_s[64], k_s[64], q_s[64];
    const int b = blockIdx.x >> 2, h = blockIdx.x & 3, dv = threadIdx.x; float S[64];
#pragma unroll
    for (int d = 0; d < 64; ++d) S[d] = 0.f;
    for (int t = 0; t < SEQ; ++t) { const size_t r = (size_t)b * SEQ + t;
        if (dv < 64) { float pre = b_a[64 * h + dv];
            for (int j = 0; j < 16; ++j) pre += bf2f(zc[r * ZC_W + ZC_GA + j]) * w_a2[j * 256 + 64 * h + dv];
            const float ls = fminf(pre, 0.f) - log1pf(__expf(-fabsf(pre)));
            a_s[dv] = __expf(ls * (1.f / 16.f)); k_s[dv] = bf2f(zg[r * ZG_W + ZG_K + 64 * h + dv]); q_s[dv] = bf2f(zg[r * ZG_W + ZG_Q + 64 * h + dv]); }
        __syncthreads();
        const float v = bf2f(zg[r * ZG_W + ZG_V + 128 * h + dv]); float o = 0.f;
#pragma unroll
        for (int d = 0; d < 64; ++d) { S[d] = a_s[d] * S[d] + k_s[d] * v; o += q_s[d] * S[d]; }
        otmp[r * 512 + 128 * h + dv] = o * 0.125f;
        __syncthreads(); }
}
__global__ void __launch_bounds__(256) n_gla_fin(const float* otmp, const bf16* zg, const float* o_norm, bf16* O) {
    const int w = blockIdx.x * 4 + (threadIdx.x >> 6), lane = threadIdx.x & 63; if (w >= M * 4) return; const int r = w >> 2, h = w & 3;
    const float a = otmp[(size_t)r * 512 + 128 * h + lane], c = otmp[(size_t)r * 512 + 128 * h + 64 + lane]; float s = a * a + c * c;
#pragma unroll
    for (int o = 1; o < 64; o <<= 1) s += __shfl_xor(s, o);
    const float rs = rsqrtf(s * (1.f / 128.f) + EPS);
    const float r0 = bf2f(zg[(size_t)r * ZG_W + ZG_R + 128 * h + lane]), r1 = bf2f(zg[(size_t)r * ZG_W + ZG_R + 128 * h + 64 + lane]);
    O[(size_t)r * 512 + 128 * h + lane] = f2bf(a * rs * o_norm[lane] * silu_f(r0)); O[(size_t)r * 512 + 128 * h + 64 + lane] = f2bf(c * rs * o_norm[64 + lane] * silu_f(r1));
}


__global__ void __launch_bounds__(256) n_gate_fin(bf16* gz, const float* bias) { const size_t i = (size_t)blockIdx.x * 256 + threadIdx.x; gz[i] = f2bf(sigmoid_f(bf2f(gz[i]) + bias[i % 3072])); }
__global__ void __launch_bounds__(256) n_flush(const float* x, float* sink) { float s = 0.f; for (size_t i = (size_t)blockIdx.x * 256 + threadIdx.x; i < (size_t)M * D; i += (size_t)gridDim.x * 256) s += x[i]; if (s == 123.456f) sink[0] = s; }
namespace pg8 {
#define PG8_LAS __attribute__((address_space(3)))
typedef unsigned short bf16_t;
typedef short bf16x8 __attribute__((ext_vector_type(8)));
typedef float f32x4 __attribute__((ext_vector_type(4)));
typedef unsigned u32x4 __attribute__((ext_vector_type(4)));
typedef unsigned u32x2 __attribute__((ext_vector_type(2)));
constexpr int BM = 256, BK = 64, HALF = 128, HTB = HALF * BK * 2  , STAGE_BYTES = 8 * HTB, NXCD = 8, WGM = 8;

__host__ __device__ __forceinline__ int lds_byte(int r, int c) { const int st = (r >> 4) * 2 + (c >> 5), rr = r & 15, cc = c & 31, ob = rr * 64 + cc * 2; return st * 1024 + (ob ^ (((ob >> 9) & 1) << 5)); }
__host__ __device__ __forceinline__ void stage_rc(int b, int& R, int& C) { const int st = b / 1024, sb = b % 1024, swz = sb ^ (((sb >> 9) & 1) << 5); R = (st >> 1) * 16 + swz / 64; C = (st & 1) * 32 + (swz % 64) / 2; }
__host__ __device__ __forceinline__ int perm32(int rho) { const int n = rho >> 4, i = rho & 15; return 8 * (i >> 2) + 4 * n + (i & 3); }

struct Unit { int pm, pn, z; };
struct Gemm { const bf16_t* A; const bf16_t* Bt; size_t zA, zB; int lda, ldb, K, pad; };

__device__ __forceinline__ void tile_of(int L, int nM, int nN, Unit& u) {
    const int nwg = nM * nN; int wgid = L; { const int q = nwg / NXCD, r = nwg % NXCD, xcd = wgid % NXCD, off = wgid / NXCD; wgid = (xcd < r ? xcd * (q + 1) : r * (q + 1) + (xcd - r) * q) + off; }
    const int nig = WGM * nN, gid = wgid / nig, fm = gid * WGM, gsz = (nM - fm) < WGM ? (nM - fm) : WGM;
    u.pm = fm + ((wgid % nig) % gsz); u.pn = (wgid % nig) / gsz;
}
struct StaticOrder {
    int nM, nN, nwg, G, c;
    __device__ void init(int M_, int N_, int G_, int c_) { nM = M_ / BM; nN = N_ / BM; nwg = nM * nN; G = G_; c = c_; }
    __device__ bool next(int i, Unit& u) const { const long L = (long)i * G + c; if (L >= nwg) return false; tile_of((int)L, nM, nN, u); u.z = 0; return true; }
    __device__ __forceinline__ void a_ready(const Unit&) const {}
    __device__ __forceinline__ void done(const Unit&) const {}
};
struct MergeOrder {
    int nM, nN, nwg, G, c;
    __device__ void init(int M_, int N_, int G_, int c_) { nM = M_ / BM; nN = N_ / BM; nwg = nM * nN; G = G_; c = c_; }
    __device__ bool next(int i, Unit& u) const { const int r = i / 3; const long L = (long)r * G + c; if (L >= nwg) return false; tile_of((int)L, nM, nN, u); u.z = i - 3 * r; return true; }
    __device__ __forceinline__ void a_ready(const Unit&) const {}
    __device__ __forceinline__ void done(const Unit&) const {}
};

typedef float f32x2_t __attribute__((ext_vector_type(2))); typedef __bf16 bf16x2_t __attribute__((ext_vector_type(2)));
__device__ __forceinline__ unsigned cvt_pk_bf16(float lo, float hi) { f32x2_t v = {lo, hi}; bf16x2_t b = __builtin_convertvector(v, bf16x2_t); return __builtin_bit_cast(unsigned, b); }
__device__ __forceinline__ float fsig(float v) { return __builtin_amdgcn_rcpf(1.f + __builtin_amdgcn_exp2f(-1.4426950408889634f * v)); }
__device__ __forceinline__ f32x4 bfx4lo(u32x2 w) { return (f32x4){__uint_as_float(w.x << 16), __uint_as_float(w.x & 0xffff0000u), __uint_as_float(w.y << 16), __uint_as_float(w.y & 0xffff0000u)}; }
__device__ __forceinline__ u32x4 pack8(f32x4 v0, f32x4 v1) { u32x4 w; w.x = cvt_pk_bf16(v0[0], v0[1]); w.y = cvt_pk_bf16(v0[2], v0[3]); w.z = cvt_pk_bf16(v1[0], v1[1]); w.w = cvt_pk_bf16(v1[2], v1[3]); return w; }

struct EpiSwiGLU {
    static constexpr bool PERM = true, AFTER_DRAIN = false; bf16_t* O; int ldc, pad;
    __device__ __forceinline__ void operator()(const f32x4 (&acc)[2][2][4][2], const Unit& u, int wr, int wc, int fr, int fq) const {
        const int row0 = u.pm * BM + wr * 64 + fr, col0 = u.pn * HALF + wc * 32 + 8 * fq;
#pragma unroll
        for (int ai = 0; ai < 2; ++ai)
#pragma unroll
            for (int m = 0; m < 4; ++m) { f32x4 v[2];
#pragma unroll
                for (int n = 0; n < 2; ++n) { const f32x4 g = acc[ai][0][m][n], up = acc[ai][1][m][n];
#pragma unroll
                    for (int e = 0; e < 4; ++e) v[n][e] = g[e] * fsig(g[e]) * up[e]; }
                *(u32x4*)(O + (size_t)(row0 + ai * HALF + m * 16) * ldc + col0) = pack8(v[0], v[1]); }
    }
};
struct EpiResid {
    static constexpr bool PERM = true, AFTER_DRAIN = false; const float* base; float* out; float sc; int pad;
    __device__ __forceinline__ void operator()(const f32x4 (&acc)[2][2][4][2], const Unit& u, int wr, int wc, int fr, int fq) const {
        const int row0 = u.pm * BM + wr * 64 + fr, col0 = u.pn * BM + wc * 32 + 8 * fq;
#pragma unroll
        for (int ai = 0; ai < 2; ++ai)
#pragma unroll
            for (int m = 0; m < 4; ++m) {
#pragma unroll
                for (int bj = 0; bj < 2; ++bj) { const size_t off = (size_t)(row0 + ai * HALF + m * 16) * D + col0 + bj * HALF;
                    const f32x4 b0 = *(const f32x4*)(base + off), b1 = *(const f32x4*)(base + off + 4);
                    *(f32x4*)(out + off) = b0 + acc[ai][bj][m][0] * sc; *(f32x4*)(out + off + 4) = b1 + acc[ai][bj][m][1] * sc; }
                asm volatile("" ::: "memory"); }
    }
};
struct EpiZ1 {
    static constexpr bool PERM = true, AFTER_DRAIN = false; bf16_t *zc, *zkv, *zg, *zxq; float *ssqq, *ssqkv;
    __device__ __forceinline__ void operator()(const f32x4 (&acc)[2][2][4][2], const Unit& u, int wr, int wc, int fr, int fq) const {
        const int pn = u.pn; bf16_t* base; int ldc, cb;
        if (pn < 2) { base = zc; ldc = ZC_W; cb = 256 * pn; } else if (pn == 2) { base = zkv; ldc = ZKV_W; cb = 0; } else if (pn < 9) { base = zg; ldc = ZG_W; cb = 256 * (pn - 3); } else { base = zxq; ldc = ZXQ_W; cb = 256 * (pn - 9); }
        const int row0 = u.pm * BM + wr * 64 + fr, col0 = cb + wc * 32 + 8 * fq;
#pragma unroll
        for (int ai = 0; ai < 2; ++ai)
#pragma unroll
            for (int m = 0; m < 4; ++m) { const int row = row0 + ai * HALF + m * 16;
#pragma unroll
                for (int bj = 0; bj < 2; ++bj) *(u32x4*)(base + (size_t)row * ldc + col0 + bj * HALF) = pack8(acc[ai][bj][m][0], acc[ai][bj][m][1]);
                if (pn <= 2) {
#pragma unroll
                    for (int bj = 0; bj < 2; ++bj) { const f32x4 a = acc[ai][bj][m][0], b = acc[ai][bj][m][1];
                        float s = (a[0] * a[0] + a[1] * a[1]) + (a[2] * a[2] + a[3] * a[3]) + (b[0] * b[0] + b[1] * b[1]) + (b[2] * b[2] + b[3] * b[3]);
                        s += __shfl_xor(s, 16); s += __shfl_xor(s, 32);
                        if (fq == 0) { if (pn == 0) ssqq[(size_t)row * 12 + 4 * bj + wc] = s; else if (pn == 1) { if (bj == 0) ssqq[(size_t)row * 12 + 8 + wc] = s; } else ssqkv[(size_t)row * 8 + 4 * bj + wc] = s; } } } }
    }
};
struct EpiPlain {
    static constexpr bool PERM = true, AFTER_DRAIN = false; bf16_t* O; int ldc, pad;
    __device__ __forceinline__ void operator()(const f32x4 (&acc)[2][2][4][2], const Unit& u, int wr, int wc, int fr, int fq) const {
        const int row0 = u.pm * BM + wr * 64 + fr, col0 = u.pn * BM + wc * 32 + 8 * fq;
#pragma unroll
        for (int ai = 0; ai < 2; ++ai)
#pragma unroll
            for (int m = 0; m < 4; ++m)
#pragma unroll
                for (int bj = 0; bj < 2; ++bj) *(u32x4*)(O + (size_t)(row0 + ai * HALF + m * 16) * ldc + col0 + bj * HALF) = pack8(acc[ai][bj][m][0], acc[ai][bj][m][1]);
    }
};
struct EpiQ {
    static constexpr bool PERM = false, AFTER_DRAIN = false; bf16_t* Q; const float *ssq, *cs, *sn;
    __device__ __forceinline__ void operator()(const f32x4 (&acc)[2][2][4][2], const Unit& u, int wr, int wc, int fr, int fq) const {
#pragma unroll
        for (int ai = 0; ai < 2; ++ai)
#pragma unroll
            for (int m = 0; m < 4; ++m) { const int row = u.pm * BM + ai * HALF + wr * 64 + m * 16 + fr;
                const f32x4 s0 = *(const f32x4*)(ssq + (size_t)row * 12), s1 = *(const f32x4*)(ssq + (size_t)row * 12 + 4), s2 = *(const f32x4*)(ssq + (size_t)row * 12 + 8);
                const float ss = ((s0[0] + s0[1]) + (s0[2] + s0[3])) + ((s1[0] + s1[1]) + (s1[2] + s1[3])) + ((s2[0] + s2[1]) + (s2[2] + s2[3]));
                const float sc = rsqrtf(ss * (1.f / 384.f) + EPS) * QSCALE;
                if (u.pn < 2) {
#pragma unroll
                    for (int bj = 0; bj < 2; ++bj)
#pragma unroll
                        for (int n = 0; n < 2; ++n) { const f32x4 v = acc[ai][bj][m][n] * sc; u32x2 w; w.x = cvt_pk_bf16(v[0], v[1]); w.y = cvt_pk_bf16(v[2], v[3]);
                            *(u32x2*)(Q + (size_t)row * QW + u.pn * BM + bj * HALF + wc * 32 + 16 * n + 4 * fq) = w; }
                } else { const f32x4 c4 = *(const f32x4*)(cs + (size_t)row * 16 + 4 * fq), s4 = *(const f32x4*)(sn + (size_t)row * 16 + 4 * fq);
#pragma unroll
                    for (int bj = 0; bj < 2; ++bj) { const f32x4 x1 = acc[ai][bj][m][0] * sc, x2 = acc[ai][bj][m][1] * sc; const f32x4 o1 = x1 * c4 - x2 * s4, o2 = x1 * s4 + x2 * c4;
                        u32x2 w1, w2; w1.x = cvt_pk_bf16(o1[0], o1[1]); w1.y = cvt_pk_bf16(o1[2], o1[3]); w2.x = cvt_pk_bf16(o2[0], o2[1]); w2.y = cvt_pk_bf16(o2[2], o2[3]);
                        bf16_t* q = Q + (size_t)row * QW + 512 + bj * HALF + wc * 32 + 4 * fq; *(u32x2*)q = w1; *(u32x2*)(q + 16) = w2; } }
                asm volatile("" ::: "memory"); }
    }
};
struct EpiKV {
    static constexpr bool PERM = true, AFTER_DRAIN = false; bf16_t* O; const float* ssq;
    __device__ __forceinline__ void operator()(const f32x4 (&acc)[2][2][4][2], const Unit& u, int wr, int wc, int fr, int fq) const {
        const int row0 = u.pm * BM + wr * 64 + fr, col0 = u.pn * BM + wc * 32 + 8 * fq;
#pragma unroll
        for (int ai = 0; ai < 2; ++ai)
#pragma unroll
            for (int m = 0; m < 4; ++m) { const int row = row0 + ai * HALF + m * 16;
                const f32x4 s0 = *(const f32x4*)(ssq + (size_t)row * 8), s1 = *(const f32x4*)(ssq + (size_t)row * 8 + 4);
                const float sc = rsqrtf((((s0[0] + s0[1]) + (s0[2] + s0[3])) + ((s1[0] + s1[1]) + (s1[2] + s1[3]))) * (1.f / 256.f) + EPS);
#pragma unroll
                for (int bj = 0; bj < 2; ++bj) *(u32x4*)(O + (size_t)row * KVW + col0 + bj * HALF) = pack8(acc[ai][bj][m][0] * sc, acc[ai][bj][m][1] * sc);
                asm volatile("" ::: "memory"); }
    }
};
struct EpiGate {
    static constexpr bool PERM = true, AFTER_DRAIN = false; bf16_t* O; const float* bias;
    __device__ __forceinline__ void operator()(const f32x4 (&acc)[2][2][4][2], const Unit& u, int wr, int wc, int fr, int fq) const {
        const int row0 = u.pm * BM + wr * 64 + fr, col0 = u.pn * BM + wc * 32 + 8 * fq;
        f32x4 bv[2][2];
#pragma unroll
        for (int bj = 0; bj < 2; ++bj)
#pragma unroll
            for (int n = 0; n < 2; ++n) bv[bj][n] = *(const f32x4*)(bias + col0 + bj * HALF + 4 * n);
#pragma unroll
        for (int ai = 0; ai < 2; ++ai)
#pragma unroll
            for (int m = 0; m < 4; ++m)
#pragma unroll
                for (int bj = 0; bj < 2; ++bj) { f32x4 v[2];
#pragma unroll
                    for (int n = 0; n < 2; ++n) { const f32x4 t = acc[ai][bj][m][n] + bv[bj][n];
#pragma unroll
                        for (int e = 0; e < 4; ++e) v[n][e] = fsig(t[e]); }
                    *(u32x4*)(O + (size_t)(row0 + ai * HALF + m * 16) * 3072 + col0 + bj * HALF) = pack8(v[0], v[1]); }
    }
};
struct EpiMerge {
    static constexpr bool PERM = true, AFTER_DRAIN = false; bf16_t* MG; const bf16_t* gz;
    __device__ __forceinline__ void operator()(const f32x4 (&acc)[2][2][4][2], const Unit& u, int wr, int wc, int fr, int fq) const {
        const int row0 = u.pm * BM + wr * 64 + fr, col0 = u.pn * BM + wc * 32 + 8 * fq;
#pragma unroll
        for (int ai = 0; ai < 2; ++ai)
#pragma unroll
            for (int m = 0; m < 4; ++m) {
#pragma unroll
                for (int bj = 0; bj < 2; ++bj) { const int row = row0 + ai * HALF + m * 16, col = col0 + bj * HALF;
                    const u32x4 gw = *(const u32x4*)(gz + (size_t)row * 3072 + 1024 * u.z + col);
                    f32x4 v0 = bfx4lo((u32x2){gw.x, gw.y}) * acc[ai][bj][m][0], v1 = bfx4lo((u32x2){gw.z, gw.w}) * acc[ai][bj][m][1];
                    bf16_t* mp = MG + (size_t)row * D + col;
                    if (u.z > 0) {
                        const unsigned long long o0 = __hip_atomic_load((const unsigned long long*)mp, __ATOMIC_RELAXED, __HIP_MEMORY_SCOPE_AGENT), o1 = __hip_atomic_load((const unsigned long long*)mp + 1, __ATOMIC_RELAXED, __HIP_MEMORY_SCOPE_AGENT);
                        v0 += bfx4lo((u32x2){(unsigned)o0, (unsigned)(o0 >> 32)}); v1 += bfx4lo((u32x2){(unsigned)o1, (unsigned)(o1 >> 32)}); }
                    *(u32x4*)mp = pack8(v0, v1); }
                asm volatile("" ::: "memory"); }
    }
};

template <class Epi, class Sched, bool ALIGN_EPI = false, bool SP2 = false>
__device__ __forceinline__ void gemm_phase(PG8_LAS unsigned char* lds, const Gemm g, const Sched& S, const Epi& E) {
    const int tid = threadIdx.x, wid = __builtin_amdgcn_readfirstlane(tid >> 6), lane = tid & 63, wr = wid >> 2, wc = wid & 3, fr = lane & 15, fq = lane >> 4;
    const int K = g.K, nt = K / BK;
    unsigned voffA[2], voffB[2];
#pragma unroll
    for (int i = 0; i < 2; ++i) { int R, C; stage_rc(tid * 16 + i * 8192, R, C); const int Rb = Epi::PERM ? ((R & ~31) + perm32(R & 31)) : R;
        voffA[i] = (unsigned)(R * g.lda + C) * 2u; voffB[i] = (unsigned)(Rb * g.ldb + C) * 2u; }
    const size_t kstep = (size_t)(BK * 2);
    const size_t hstepA = (size_t)HALF * g.lda * 2, hstepB = (size_t)HALF * g.ldb * 2;
    const size_t tstepA = 2 * hstepA, tstepB = 2 * hstepB;
    const unsigned ldsw = (unsigned)wid * 1024u;
    const int aoff = lds_byte(wr * 64 + fr, fq * 8), boff = lds_byte(wc * 32 + fr, fq * 8);
#define PG8_SA(b, h) (((b) * 2 + (h)) * HTB)
#define PG8_SB(b, h) ((4 + (b) * 2 + (h)) * HTB)
#define PG8_STAGE(bufoff, gbase, voff) do { _Pragma("unroll") for (int _i = 0; _i < 2; ++_i) \
        __builtin_amdgcn_global_load_lds((const unsigned*)((const char*)(gbase) + (voff)[_i]), (PG8_LAS unsigned*)(lds + (bufoff) + ldsw + _i * 8192), 16, 0, 0); } while (0)
#define PG8_LDA(dst, b, h) do { _Pragma("unroll") for (int m = 0; m < 4; ++m) _Pragma("unroll") for (int k = 0; k < 2; ++k) dst[m][k] = *(const PG8_LAS bf16x8*)(lds + PG8_SA(b, h) + aoff + m * 2048 + k * 1024); } while (0)
#define PG8_LDB(dst, b, h) do { _Pragma("unroll") for (int n = 0; n < 2; ++n) _Pragma("unroll") for (int k = 0; k < 2; ++k) dst[n][k] = *(const PG8_LAS bf16x8*)(lds + PG8_SB(b, h) + boff + n * 2048 + k * 1024); } while (0)
#define PG8_MMA(ai, bj, At, Bt) do { __builtin_amdgcn_s_setprio(1); _Pragma("unroll") for (int m = 0; m < 4; ++m) _Pragma("unroll") for (int n = 0; n < 2; ++n) _Pragma("unroll") for (int k = 0; k < 2; ++k) \
        acc[ai][bj][m][n] = __builtin_amdgcn_mfma_f32_16x16x32_bf16(Bt[n][k], At[m][k], acc[ai][bj][m][n], 0, 0, 0); __builtin_amdgcn_s_setprio(0); } while (0)
#define PG8_WAIT_V(n) asm volatile("s_waitcnt vmcnt(" #n ")" ::: "memory")
#define PG8_WAIT_L(n) asm volatile("s_waitcnt lgkmcnt(" #n ")" ::: "memory")
#define PG8_BAR __builtin_amdgcn_s_barrier()
#define PG8_SCHED __builtin_amdgcn_sched_barrier(0)
    Unit cur, nxt; int ui = 0;
    if (!S.next(0, cur)) return;
    f32x4 acc[2][2][4][2];
#pragma unroll
    for (int a = 0; a < 2; ++a)
#pragma unroll
        for (int b = 0; b < 2; ++b)
#pragma unroll
            for (int m = 0; m < 4; ++m)
#pragma unroll
                for (int n = 0; n < 2; ++n) acc[a][b][m][n] = (f32x4){0.f, 0.f, 0.f, 0.f};
    bf16x8 At[4][2], B0[2][2], B1[2][2];
    const char* cA = (const char*)g.A + (size_t)cur.z * g.zA + (size_t)cur.pm * tstepA; const char* cB = (const char*)g.Bt + (size_t)cur.z * g.zB + (size_t)cur.pn * tstepB;
    S.a_ready(cur);
    if constexpr (SP2) {
        PG8_STAGE(PG8_SB(0, 0), cB, voffB); PG8_STAGE(PG8_SB(0, 1), cB + hstepB, voffB); PG8_STAGE(PG8_SA(0, 0), cA, voffA); PG8_STAGE(PG8_SA(0, 1), cA + hstepA, voffA);
        if (wr == 1) PG8_BAR;
        PG8_WAIT_V(2); PG8_BAR;
        PG8_STAGE(PG8_SB(1, 0), cB + kstep, voffB); PG8_STAGE(PG8_SA(1, 0), cA + kstep, voffA); PG8_STAGE(PG8_SB(1, 1), cB + hstepB + kstep, voffB);
        PG8_WAIT_V(6); PG8_BAR;
    } else {
        PG8_STAGE(PG8_SB(0, 0), cB, voffB); PG8_STAGE(PG8_SA(0, 0), cA, voffA); PG8_STAGE(PG8_SB(0, 1), cB + hstepB, voffB); PG8_STAGE(PG8_SA(0, 1), cA + hstepA, voffA);
        if (wr == 1) PG8_BAR;
        PG8_WAIT_V(4); PG8_BAR;
        PG8_STAGE(PG8_SB(1, 0), cB + kstep, voffB); PG8_STAGE(PG8_SA(1, 0), cA + kstep, voffA); PG8_STAGE(PG8_SB(1, 1), cB + hstepB + kstep, voffB);
        PG8_WAIT_V(6); PG8_BAR;
    }
    for (;;) {
        const bool has_next = S.next(ui + 1, nxt);
        const char* nA = has_next ? (const char*)g.A + (size_t)nxt.z * g.zA + (size_t)nxt.pm * tstepA : cA; const char* nB = has_next ? (const char*)g.Bt + (size_t)nxt.z * g.zB + (size_t)nxt.pn * tstepB : cB;
#pragma unroll 1
        for (int t = 0; t < nt; t += 2) {
            const bool last = (t == nt - 2);
            const char* a1 = cA + (size_t)(t + 1) * kstep;
            const char* a2 = last ? nA : cA + (size_t)(t + 2) * kstep; const char* b2 = last ? nB : cB + (size_t)(t + 2) * kstep;
            const char* a3 = a2 + kstep; const char* b3 = b2 + kstep;
            if (last && has_next) S.a_ready(nxt);
            if constexpr (SP2) {
            PG8_LDB(B0, 0, 0); PG8_LDB(B1, 0, 1); PG8_SCHED; PG8_LDA(At, 0, 0); PG8_STAGE(PG8_SA(1, 1), a1 + hstepA, voffA);
            PG8_WAIT_V(8); PG8_WAIT_L(0); PG8_BAR; PG8_MMA(0, 0, At, B0); PG8_MMA(0, 1, At, B1); PG8_BAR; PG8_SCHED;
            PG8_LDA(At, 0, 1); PG8_STAGE(PG8_SB(0, 0), b2, voffB); PG8_STAGE(PG8_SB(0, 1), b2 + hstepB, voffB); PG8_STAGE(PG8_SA(0, 0), a2, voffA);
            PG8_WAIT_V(8); PG8_WAIT_L(0); PG8_BAR; PG8_MMA(1, 0, At, B0); PG8_MMA(1, 1, At, B1); PG8_BAR; PG8_SCHED;
            PG8_LDB(B0, 1, 0); PG8_LDB(B1, 1, 1); PG8_SCHED; PG8_LDA(At, 1, 0); PG8_STAGE(PG8_SA(0, 1), a2 + hstepA, voffA);
            PG8_WAIT_V(8); PG8_WAIT_L(0); PG8_BAR; PG8_MMA(0, 0, At, B0); PG8_MMA(0, 1, At, B1); PG8_BAR; PG8_SCHED;
            PG8_LDA(At, 1, 1); PG8_STAGE(PG8_SB(1, 0), b3, voffB); PG8_STAGE(PG8_SB(1, 1), b3 + hstepB, voffB); PG8_STAGE(PG8_SA(1, 0), a3, voffA);
            PG8_WAIT_V(8); PG8_WAIT_L(0); PG8_BAR; PG8_MMA(1, 0, At, B0); PG8_MMA(1, 1, At, B1); PG8_BAR; PG8_SCHED;
            } else {
            PG8_LDB(B0, 0, 0); PG8_SCHED; PG8_LDA(At, 0, 0); PG8_STAGE(PG8_SA(1, 1), a1 + hstepA, voffA);
            PG8_WAIT_L(8); PG8_BAR; PG8_WAIT_L(0); PG8_MMA(0, 0, At, B0); PG8_BAR; PG8_SCHED;
            PG8_LDB(B1, 0, 1); PG8_STAGE(PG8_SB(0, 0), b2, voffB);
            PG8_BAR; PG8_WAIT_L(0); PG8_MMA(0, 1, At, B1); PG8_BAR;
            PG8_LDA(At, 0, 1); PG8_STAGE(PG8_SA(0, 0), a2, voffA);
            PG8_BAR; PG8_WAIT_L(0); PG8_MMA(1, 0, At, B0); PG8_BAR; PG8_SCHED;
            PG8_STAGE(PG8_SB(0, 1), b2 + hstepB, voffB);
            PG8_WAIT_V(6); PG8_BAR; PG8_MMA(1, 1, At, B1); PG8_BAR;
            PG8_LDB(B0, 1, 0); PG8_SCHED; PG8_LDA(At, 1, 0); PG8_STAGE(PG8_SA(0, 1), a2 + hstepA, voffA);
            PG8_WAIT_L(8); PG8_BAR; PG8_WAIT_L(0); PG8_MMA(0, 0, At, B0); PG8_BAR; PG8_SCHED;
            PG8_LDB(B1, 1, 1); PG8_STAGE(PG8_SB(1, 0), b3, voffB);
            PG8_BAR; PG8_WAIT_L(0); PG8_MMA(0, 1, At, B1); PG8_BAR;
            PG8_LDA(At, 1, 1); PG8_STAGE(PG8_SA(1, 0), a3, voffA);
            PG8_BAR; PG8_WAIT_L(0); PG8_MMA(1, 0, At, B0); PG8_BAR; PG8_SCHED;
            PG8_STAGE(PG8_SB(1, 1), b3 + hstepB, voffB);
            PG8_WAIT_V(6); PG8_BAR; PG8_MMA(1, 1, At, B1); PG8_BAR;
            }
        }
        if constexpr (ALIGN_EPI) { if (wr == 0) PG8_BAR; }
        if constexpr (!Epi::AFTER_DRAIN) { E(acc, cur, wr, wc, fr, fq); S.done(cur); }
        if (!has_next) break;
#pragma unroll
        for (int a = 0; a < 2; ++a)
#pragma unroll
            for (int b = 0; b < 2; ++b)
#pragma unroll
                for (int m = 0; m < 4; ++m)
#pragma unroll
                    for (int n = 0; n < 2; ++n) acc[a][b][m][n] = (f32x4){0.f, 0.f, 0.f, 0.f};
        cur = nxt; cA = nA; cB = nB; ++ui;
        if constexpr (ALIGN_EPI) { if (wr == 1) PG8_BAR; }
    }
    PG8_WAIT_V(0);
    if constexpr (!ALIGN_EPI) { if (wr == 0) PG8_BAR; }
    PG8_BAR;
    if constexpr (Epi::AFTER_DRAIN) { E.fused(acc, cur, wr, wc, fr, fq, lds, wid, lane); S.done(cur); }
#undef PG8_SA
#undef PG8_SB
#undef PG8_STAGE
#undef PG8_LDA
#undef PG8_LDB
#undef PG8_MMA
#undef PG8_WAIT_V
#undef PG8_WAIT_L
#undef PG8_BAR
#undef PG8_SCHED
}
}


namespace att {
typedef short bf16x8 __attribute__((ext_vector_type(8)));
typedef short bf16x4 __attribute__((ext_vector_type(4)));
typedef float f32x16 __attribute__((ext_vector_type(16)));
typedef unsigned u32x4 __attribute__((ext_vector_type(4)));
#define ALAS __attribute__((address_space(3)))
__device__ __forceinline__ int crow(int r, int hi) { return (r & 3) + 8 * (r >> 2) + 4 * hi; }
__device__ __forceinline__ unsigned pk(float lo, float hi) { return pg8::cvt_pk_bf16(lo, hi); }
__device__ __forceinline__ float swap_max(float v) { auto rr = __builtin_amdgcn_permlane32_swap(__float_as_uint(v), __float_as_uint(v), false, false); return fmaxf(__uint_as_float(rr[0]), __uint_as_float(rr[1])); }
__device__ __forceinline__ float swap_add(float v) { auto rr = __builtin_amdgcn_permlane32_swap(__float_as_uint(v), __float_as_uint(v), false, false); return __uint_as_float(rr[0]) + __uint_as_float(rr[1]); }
__device__ __forceinline__ bf16x8 pack8r(const f32x16& p, int b) {
    u32x4 w; w.x = pk(p[b], p[b + 1]); w.y = pk(p[b + 2], p[b + 3]); w.z = pk(p[b + 4], p[b + 5]); w.w = pk(p[b + 6], p[b + 7]); return __builtin_bit_cast(bf16x8, w); }

template <class T> __device__ __forceinline__ void attn_unit(ALAS unsigned char* lds, const T& t, int b, int qb) {
    constexpr int NDS = T::NDS, NDH = T::NDH, KP = NDS * 32 + 16, VP = 136, KB = 64 * KP, VB = NDH * 32 * VP, NKC = NDS * 2, NVC = NDH * 4;
    const int tid = threadIdx.x, lane = tid & 63, r = lane & 31, h = lane >> 5, w = __builtin_amdgcn_readfirstlane(tid >> 6);
    ALAS unsigned char* Kl = lds; ALAS unsigned char* Vl = lds + 2 * KB; ALAS float* wsc = (ALAS float*)(lds + 2 * KB + 2 * VB) + 32 * w;
    const int q0 = qb * 256; const size_t qrow = (size_t)b * SEQ + q0 + 32 * w + r;
    bf16x8 qf[NDS];
#pragma unroll
    for (int d0 = 0; d0 < NDS; ++d0) qf[d0] = *(const bf16x8*)t.qptr(qrow, d0, h);
    const int NT = T::CAUSAL ? 4 * qb + 4 : T::NKV / 64; const int my_last = T::CAUSAL ? 4 * qb + (w >> 1) : NT - 1;
    const size_t kvrow0 = (size_t)b * (T::CAUSAL ? SEQ : T::NKV) + lane;
    f32x16 o[NDH];
#pragma unroll
    for (int dh = 0; dh < NDH; ++dh)
#pragma unroll
        for (int i = 0; i < 16; ++i) o[dh][i] = 0.f;
    float m = -1e30f, l = 0.f;
    u32x4 kreg[2], vreg[2];
#define ATT_LOAD(tile) do { const size_t kr_ = kvrow0 + (size_t)(tile) * 64; \
        _Pragma("unroll") for (int i_ = 0; i_ < 2; ++i_) { if (w + 8 * i_ < NKC) kreg[i_] = *(const u32x4*)t.kchunk(kr_, w + 8 * i_); if (w + 8 * i_ < NVC) vreg[i_] = *(const u32x4*)t.vchunk(kr_, w + 8 * i_); } } while (0)
#define ATT_WRITE(buf) do { ALAS unsigned char* kb_ = Kl + (buf) * KB; ALAS unsigned char* vb_ = Vl + (buf) * VB; \
        _Pragma("unroll") for (int i_ = 0; i_ < 2; ++i_) { if (w + 8 * i_ < NKC) *(ALAS u32x4*)(kb_ + lane * KP + (w + 8 * i_) * 16) = kreg[i_]; \
            if (w + 8 * i_ < NVC) { const u32x4 v_ = vreg[i_]; ALAS unsigned short* vp_ = (ALAS unsigned short*)(vb_ + (8 * (w + 8 * i_)) * VP + lane * 2); \
                vp_[0 * (VP / 2)] = (unsigned short)(v_.x & 0xffff); vp_[1 * (VP / 2)] = (unsigned short)(v_.x >> 16); vp_[2 * (VP / 2)] = (unsigned short)(v_.y & 0xffff); vp_[3 * (VP / 2)] = (unsigned short)(v_.y >> 16); \
                vp_[4 * (VP / 2)] = (unsigned short)(v_.z & 0xffff); vp_[5 * (VP / 2)] = (unsigned short)(v_.z >> 16); vp_[6 * (VP / 2)] = (unsigned short)(v_.w & 0xffff); vp_[7 * (VP / 2)] = (unsigned short)(v_.w >> 16); } } } while (0)
    ATT_LOAD(0); ATT_WRITE(0); __syncthreads();
    for (int tile = 0; tile < NT; ++tile) {
        const bool more = tile + 1 < NT;
        if (more) ATT_LOAD(tile + 1);
        if (tile <= my_last) {
            const ALAS unsigned char* Kb = Kl + (tile & 1) * KB; const ALAS unsigned char* Vb = Vl + (tile & 1) * VB;
            f32x16 p0, p1;
#pragma unroll
            for (int i = 0; i < 16; ++i) { p0[i] = 0.f; p1[i] = 0.f; }
#pragma unroll
            for (int d0 = 0; d0 < NDS; ++d0) { const bf16x8 a0 = *(const ALAS bf16x8*)(Kb + r * KP + (16 * d0 + 8 * h) * 2), a1 = *(const ALAS bf16x8*)(Kb + (32 + r) * KP + (16 * d0 + 8 * h) * 2);
                p0 = __builtin_amdgcn_mfma_f32_32x32x16_bf16(a0, qf[d0], p0, 0, 0, 0); p1 = __builtin_amdgcn_mfma_f32_32x32x16_bf16(a1, qf[d0], p1, 0, 0, 0); }
            if (T::SCALE != 1.0f) {
#pragma unroll
                for (int i = 0; i < 16; ++i) { p0[i] *= T::SCALE; p1[i] *= T::SCALE; } }
            if (T::CAUSAL && tile >= 4 * qb) { const int qi = q0 + 32 * w + r, kb0 = 64 * tile;
#pragma unroll
                for (int i = 0; i < 16; ++i) { const int kv = kb0 + crow(i, h); if (kv > qi) p0[i] = -1e30f; if (kv + 32 > qi) p1[i] = -1e30f; } }
            float mx = fmaxf(p0[0], p1[0]);
#pragma unroll
            for (int i = 1; i < 16; ++i) mx = fmaxf(mx, fmaxf(p0[i], p1[i]));
            mx = swap_max(mx);
            const float mn = fmaxf(m, mx);
            if (__any(mn > m)) { const float alpha = __builtin_amdgcn_exp2f(m - mn); l *= alpha; m = mn;
                if (h == 0) wsc[r] = alpha;
#pragma unroll
                for (int i = 0; i < 16; ++i) { const float f = wsc[crow(i, h)];
#pragma unroll
                    for (int dh = 0; dh < NDH; ++dh) o[dh][i] *= f; } }
            float ls = 0.f;
#pragma unroll
            for (int i = 0; i < 16; ++i) { p0[i] = __builtin_amdgcn_exp2f(p0[i] - m); p1[i] = __builtin_amdgcn_exp2f(p1[i] - m); ls += p0[i] + p1[i]; }
            l += ls;
            bf16x8 pa[4]; pa[0] = pack8r(p0, 0); pa[1] = pack8r(p0, 8); pa[2] = pack8r(p1, 0); pa[3] = pack8r(p1, 8);
#pragma unroll
            for (int dh = 0; dh < NDH; ++dh)
#pragma unroll
                for (int ks = 0; ks < 4; ++ks) { const ALAS unsigned char* vp = Vb + (32 * dh + r) * VP + (16 * ks + 4 * h) * 2;
                    const bf16x4 lo = *(const ALAS bf16x4*)vp, hi = *(const ALAS bf16x4*)(vp + 16);
                    const bf16x8 vb = {lo[0], lo[1], lo[2], lo[3], hi[0], hi[1], hi[2], hi[3]};
                    o[dh] = __builtin_amdgcn_mfma_f32_32x32x16_bf16(pa[ks], vb, o[dh], 0, 0, 0); }
        }
        if (more) ATT_WRITE((tile + 1) & 1);
        __syncthreads();
    }
#undef ATT_LOAD
#undef ATT_WRITE
    l = swap_add(l);
    if (h == 0) wsc[r] = 1.f / l;
#pragma unroll
    for (int i = 0; i < 16; ++i) { const float f = wsc[crow(i, h)]; bf16* op = t.optr((size_t)b * SEQ + q0 + 32 * w + crow(i, h));
#pragma unroll
        for (int dh = 0; dh < NDH; ++dh) op[32 * dh + r] = f2bf(o[dh][i] * f); }
}
struct MlaT { static constexpr int NDS = 6, NDH = 2, NKV = SEQ; static constexpr bool CAUSAL = true; static constexpr float SCALE = 1.0f;
    const bf16 *Q, *KV, *KR; bf16* O; int head, pad;
    __device__ __forceinline__ const bf16* qptr(size_t row, int d0, int h) const { return d0 < 4 ? Q + row * QW + 64 * head + 16 * d0 + 8 * h : Q + row * QW + 512 + 32 * head + 16 * (d0 - 4) + 8 * h; }
    __device__ __forceinline__ const bf16* kchunk(size_t row, int c) const { return c < 8 ? KV + row * KVW + 64 * head + 8 * c : KR + row * 32 + 8 * (c - 8); }
    __device__ __forceinline__ const bf16* vchunk(size_t row, int c) const { return KV + row * KVW + 512 + 64 * head + 8 * c; }
    __device__ __forceinline__ bf16* optr(size_t row) const { return O + row * 512 + 64 * head; } };
struct CrossT { static constexpr int NDS = 8, NDH = 4, NKV = NMEM; static constexpr bool CAUSAL = false; static constexpr float SCALE = XSCALE;
    const bf16 *Q, *KV; bf16* O; int head, pad;
    __device__ __forceinline__ const bf16* qptr(size_t row, int d0, int h) const { return Q + row * ZXQ_W + 128 * head + 16 * d0 + 8 * h; }
    __device__ __forceinline__ const bf16* kchunk(size_t row, int c) const { return KV + row * 1024 + 128 * head + 8 * c; }
    __device__ __forceinline__ const bf16* vchunk(size_t row, int c) const { return KV + row * 1024 + 512 + 128 * head + 8 * c; }
    __device__ __forceinline__ bf16* optr(size_t row) const { return O + row * 512 + 128 * head; } };

constexpr int G_W = 0, G_B = 4096, G_LA = 4352, G_SEG = G_LA + 64 * 65 * 4, G_QT = G_SEG + 8 * 64 * 4, G_KT = G_QT + 64 * 144, G_VT = G_KT + 64 * 144, G_OT = G_VT + 128 * 144, G_END = G_OT + 64 * 132 * 4;
static_assert(G_END <= 131072 && (G_QT % 16) == 0 && (G_OT % 16) == 0, "gla lds map");
__device__ __forceinline__ void gla_load_w(ALAS unsigned char* lds, const float* w_a2, const float* b_a, int h) {
    ALAS float* W = (ALAS float*)(lds + G_W); ALAS float* Bv = (ALAS float*)(lds + G_B); const int tid = threadIdx.x;
    for (int i = tid; i < 1024; i += 512) W[i] = w_a2[(i >> 6) * 256 + 64 * h + (i & 63)];
    if (tid < 64) Bv[tid] = b_a[64 * h + tid];
}
__device__ __forceinline__ void gla_bcum(ALAS unsigned char* lds, const bf16* zc, size_t row0) {
    const ALAS float* W = (const ALAS float*)(lds + G_W); const ALAS float* Bv = (const ALAS float*)(lds + G_B); ALAS float* LA = (ALAS float*)(lds + G_LA); ALAS float* SEGS = (ALAS float*)(lds + G_SEG);
    const int tid = threadIdx.x; { const int t = tid >> 3, db = tid & 7;
        const u32x4 g0 = *(const u32x4*)(zc + (row0 + t) * ZC_W + ZC_GA), g1 = *(const u32x4*)(zc + (row0 + t) * ZC_W + ZC_GA + 8);
        float ga[16]; ga[0] = __uint_as_float(g0.x << 16); ga[1] = __uint_as_float(g0.x & 0xffff0000u); ga[2] = __uint_as_float(g0.y << 16); ga[3] = __uint_as_float(g0.y & 0xffff0000u);
        ga[4] = __uint_as_float(g0.z << 16); ga[5] = __uint_as_float(g0.z & 0xffff0000u); ga[6] = __uint_as_float(g0.w << 16); ga[7] = __uint_as_float(g0.w & 0xffff0000u);
        ga[8] = __uint_as_float(g1.x << 16); ga[9] = __uint_as_float(g1.x & 0xffff0000u); ga[10] = __uint_as_float(g1.y << 16); ga[11] = __uint_as_float(g1.y & 0xffff0000u);
        ga[12] = __uint_as_float(g1.z << 16); ga[13] = __uint_as_float(g1.z & 0xffff0000u); ga[14] = __uint_as_float(g1.w << 16); ga[15] = __uint_as_float(g1.w & 0xffff0000u);
#pragma unroll
        for (int e = 0; e < 8; ++e) { const int d = 8 * db + e; float pre = Bv[d];
#pragma unroll
            for (int j = 0; j < 16; ++j) pre += ga[j] * W[j * 64 + d];
            LA[t * 65 + d] = (fminf(pre, 0.f) - __logf(1.f + __expf(-fabsf(pre)))) * (1.f / 16.f); } }
    __syncthreads();
    const int d = tid & 63, sg = tid >> 6; float v[8];
#pragma unroll
    for (int i = 0; i < 8; ++i) v[i] = LA[(8 * sg + i) * 65 + d];
#pragma unroll
    for (int i = 1; i < 8; ++i) v[i] += v[i - 1];
    SEGS[sg * 64 + d] = v[7];
    __syncthreads();
    float off = 0.f;
#pragma unroll
    for (int s2 = 0; s2 < 7; ++s2) off += (s2 < sg) ? SEGS[s2 * 64 + d] : 0.f;
#pragma unroll
    for (int i = 0; i < 8; ++i) LA[(8 * sg + i) * 65 + d] = v[i] + off;
    __syncthreads();
}
__device__ __forceinline__ void gla_stage_vt(ALAS unsigned char* lds, const bf16* zg, size_t row0, int h) {
    const int tid = threadIdx.x, lane = tid & 63, w = tid >> 6;
#pragma unroll
    for (int i = 0; i < 2; ++i) { const int c = w + 8 * i; const u32x4 v = *(const u32x4*)(zg + (row0 + lane) * ZG_W + ZG_V + 128 * h + 8 * c);
        ALAS unsigned short* vp = (ALAS unsigned short*)(lds + G_VT + (8 * c) * 144 + lane * 2);
        vp[0 * 72] = (unsigned short)(v.x & 0xffff); vp[1 * 72] = (unsigned short)(v.x >> 16); vp[2 * 72] = (unsigned short)(v.y & 0xffff); vp[3 * 72] = (unsigned short)(v.y >> 16);
        vp[4 * 72] = (unsigned short)(v.z & 0xffff); vp[5 * 72] = (unsigned short)(v.z >> 16); vp[6 * 72] = (unsigned short)(v.w & 0xffff); vp[7 * 72] = (unsigned short)(v.w >> 16); }
}
__device__ __forceinline__ void gla_pass_a(ALAS unsigned char* lds, const bf16* zc, const bf16* zg, float* DS, float* DEC, int b, int h, int n) {
    const int tid = threadIdx.x, lane = tid & 63, r = lane & 31, hh = lane >> 5, w = __builtin_amdgcn_readfirstlane(tid >> 6); const size_t row0 = (size_t)b * SEQ + 64 * n;
    gla_bcum(lds, zc, row0);
    const ALAS float* LA = (const ALAS float*)(lds + G_LA);
    { const int t = tid >> 3, db = tid & 7; const u32x4 kk = *(const u32x4*)(zg + (row0 + t) * ZG_W + ZG_K + 64 * h + 8 * db);
      float kf[8]; kf[0] = __uint_as_float(kk.x << 16); kf[1] = __uint_as_float(kk.x & 0xffff0000u); kf[2] = __uint_as_float(kk.y << 16); kf[3] = __uint_as_float(kk.y & 0xffff0000u);
      kf[4] = __uint_as_float(kk.z << 16); kf[5] = __uint_as_float(kk.z & 0xffff0000u); kf[6] = __uint_as_float(kk.w << 16); kf[7] = __uint_as_float(kk.w & 0xffff0000u);
#pragma unroll
      for (int e = 0; e < 8; ++e) { const int d = 8 * db + e; const float kd = kf[e] * __expf(LA[63 * 65 + d] - LA[t * 65 + d]); *(ALAS unsigned short*)(lds + G_KT + d * 144 + t * 2) = f2bf(kd); } }
    gla_stage_vt(lds, zg, row0, h);
    __syncthreads();
    const int dvt = w >> 1, dt = w & 1; f32x16 acc;
#pragma unroll
    for (int i = 0; i < 16; ++i) acc[i] = 0.f;
#pragma unroll
    for (int ks = 0; ks < 4; ++ks) { const bf16x8 a = *(const ALAS bf16x8*)(lds + G_VT + (32 * dvt + r) * 144 + (16 * ks + 8 * hh) * 2), bb = *(const ALAS bf16x8*)(lds + G_KT + (32 * dt + r) * 144 + (16 * ks + 8 * hh) * 2);
        acc = __builtin_amdgcn_mfma_f32_32x32x16_bf16(a, bb, acc, 0, 0, 0); }
    float* dsp = DS + ((size_t)((b * 4 + h) * GLA_N + n) * 128) * 64;
#pragma unroll
    for (int i = 0; i < 16; ++i) dsp[(32 * dvt + crow(i, hh)) * 64 + 32 * dt + r] = acc[i];
    if (tid < 64) DEC[(size_t)((b * 4 + h) * GLA_N + n) * 64 + tid] = __expf(LA[63 * 65 + tid]);
    __syncthreads();
}
__device__ __forceinline__ void gla_pass_c(ALAS unsigned char* lds, const bf16* zc, const bf16* zg, const bf16* SPREV, const float* o_norm, bf16* OG, int b, int h, int n) {
    const int tid = threadIdx.x, lane = tid & 63, r = lane & 31, hh = lane >> 5, w = __builtin_amdgcn_readfirstlane(tid >> 6); const size_t row0 = (size_t)b * SEQ + 64 * n;
    gla_bcum(lds, zc, row0);
    const ALAS float* LA = (const ALAS float*)(lds + G_LA);
    { const int t = tid >> 3, db = tid & 7; const u32x4 qq = *(const u32x4*)(zg + (row0 + t) * ZG_W + ZG_Q + 64 * h + 8 * db), kk = *(const u32x4*)(zg + (row0 + t) * ZG_W + ZG_K + 64 * h + 8 * db);
      const unsigned qw[4] = {qq.x, qq.y, qq.z, qq.w}, kw[4] = {kk.x, kk.y, kk.z, kk.w}; unsigned qo[4], ko[4];
#pragma unroll
      for (int e = 0; e < 4; ++e) { const float b0 = LA[t * 65 + 8 * db + 2 * e], b1 = LA[t * 65 + 8 * db + 2 * e + 1]; const float e0 = __expf(b0), e1 = __expf(b1), i0 = __expf(-b0), i1 = __expf(-b1);
          qo[e] = pk(__uint_as_float(qw[e] << 16) * 0.125f * e0, __uint_as_float(qw[e] & 0xffff0000u) * 0.125f * e1); ko[e] = pk(__uint_as_float(kw[e] << 16) * i0, __uint_as_float(kw[e] & 0xffff0000u) * i1); }
      *(ALAS u32x4*)(lds + G_QT + t * 144 + db * 16) = (u32x4){qo[0], qo[1], qo[2], qo[3]}; *(ALAS u32x4*)(lds + G_KT + t * 144 + db * 16) = (u32x4){ko[0], ko[1], ko[2], ko[3]}; }
    gla_stage_vt(lds, zg, row0, h);
    __syncthreads();
    const int ci = w >> 2, vi = w & 3; bf16x8 pa[4];
#pragma unroll
    for (int jh = 0; jh < 2; ++jh) { if (jh <= ci) { f32x16 pj;
#pragma unroll
            for (int i = 0; i < 16; ++i) pj[i] = 0.f;
#pragma unroll
            for (int ks = 0; ks < 4; ++ks) { const bf16x8 a = *(const ALAS bf16x8*)(lds + G_KT + (32 * jh + r) * 144 + (16 * ks + 8 * hh) * 2), bb = *(const ALAS bf16x8*)(lds + G_QT + (32 * ci + r) * 144 + (16 * ks + 8 * hh) * 2);
                pj = __builtin_amdgcn_mfma_f32_32x32x16_bf16(a, bb, pj, 0, 0, 0); }
#pragma unroll
            for (int i = 0; i < 16; ++i) if (32 * jh + crow(i, hh) > 32 * ci + r) pj[i] = 0.f;
            pa[2 * jh] = pack8r(pj, 0); pa[2 * jh + 1] = pack8r(pj, 8); } else { pa[2 * jh] = (bf16x8){0, 0, 0, 0, 0, 0, 0, 0}; pa[2 * jh + 1] = pa[2 * jh]; } }
    f32x16 acc;
#pragma unroll
    for (int i = 0; i < 16; ++i) acc[i] = 0.f;
#pragma unroll
    for (int ks = 0; ks < 4; ++ks) { if ((ks >> 1) <= ci) { const ALAS unsigned char* vp = lds + G_VT + (32 * vi + r) * 144 + (16 * ks + 4 * hh) * 2;
            const bf16x4 lo = *(const ALAS bf16x4*)vp, hi = *(const ALAS bf16x4*)(vp + 16); const bf16x8 vb = {lo[0], lo[1], lo[2], lo[3], hi[0], hi[1], hi[2], hi[3]};
            acc = __builtin_amdgcn_mfma_f32_32x32x16_bf16(pa[ks], vb, acc, 0, 0, 0); } }
    const bf16* sp = SPREV + ((size_t)((b * 4 + h) * GLA_N + n) * 128) * 64;
#pragma unroll
    for (int ks = 0; ks < 4; ++ks) { const bf16x8 a = *(const ALAS bf16x8*)(lds + G_QT + (32 * ci + r) * 144 + (16 * ks + 8 * hh) * 2), bb = *(const bf16x8*)(sp + (32 * vi + r) * 64 + 16 * ks + 8 * hh);
        acc = __builtin_amdgcn_mfma_f32_32x32x16_bf16(a, bb, acc, 0, 0, 0); }
    ALAS float* OT = (ALAS float*)(lds + G_OT);
#pragma unroll
    for (int i = 0; i < 16; ++i) OT[(32 * ci + crow(i, hh)) * 132 + 32 * vi + r] = acc[i];
    __syncthreads();
    { const int c = tid >> 3, part = tid & 7; float v[16]; float ss = 0.f;
#pragma unroll
      for (int e = 0; e < 16; ++e) { v[e] = OT[c * 132 + 16 * part + e]; ss += v[e] * v[e]; }
      ss += __shfl_xor(ss, 1); ss += __shfl_xor(ss, 2); ss += __shfl_xor(ss, 4);
      const float rs = rsqrtf(ss * (1.f / 128.f) + EPS);
      const u32x4 g0 = *(const u32x4*)(zg + (row0 + c) * ZG_W + ZG_R + 128 * h + 16 * part), g1 = *(const u32x4*)(zg + (row0 + c) * ZG_W + ZG_R + 128 * h + 16 * part + 8);
      const unsigned gw[8] = {g0.x, g0.y, g0.z, g0.w, g1.x, g1.y, g1.z, g1.w}; unsigned ow[8];
#pragma unroll
      for (int e = 0; e < 8; ++e) { const float r0 = __uint_as_float(gw[e] << 16), r1 = __uint_as_float(gw[e] & 0xffff0000u);
          ow[e] = pk(v[2 * e] * rs * o_norm[16 * part + 2 * e] * (r0 * pg8::fsig(r0)), v[2 * e + 1] * rs * o_norm[16 * part + 2 * e + 1] * (r1 * pg8::fsig(r1))); }
      bf16* op = OG + (row0 + c) * 512 + 128 * h + 16 * part; *(u32x4*)op = (u32x4){ow[0], ow[1], ow[2], ow[3]}; *(u32x4*)(op + 8) = (u32x4){ow[4], ow[5], ow[6], ow[7]}; }
    __syncthreads();
}
#undef ALAS
}
constexpr int NWAVES = 8;
constexpr int RING_OFF = 0, RING_BYTES = 131072;
constexpr int LDSCTL_OFF = RING_BYTES, MISC_OFF = LDSCTL_OFF + 320;
constexpr int LDS_BYTES = 147456;
constexpr int CW_TMO = 0, CW_CODE = 1, CW_BAR = 4096;
constexpr size_t CTL_ZERO_BYTES = 1 * MiB;
constexpr int NPH = 18;
#define GAS __attribute__((address_space(1)))
#define LAS __attribute__((address_space(3)))
typedef unsigned short bf16;
typedef unsigned v4u __attribute__((ext_vector_type(4)));
typedef float f32x4 __attribute__((ext_vector_type(4)));
typedef short bf16x8 __attribute__((ext_vector_type(8)));
typedef GAS unsigned gu32;
typedef GAS unsigned long long gu64;
#define RLX_AGENT __ATOMIC_RELAXED, __HIP_MEMORY_SCOPE_AGENT
#define LDS_WAIT() asm volatile("s_waitcnt lgkmcnt(0)" ::: "memory")
#define VM_WAIT() asm volatile("s_waitcnt vmcnt(0)" ::: "memory")
__device__ __forceinline__ unsigned long long rt() { return __builtin_amdgcn_s_memrealtime(); }
__device__ __forceinline__ unsigned f2bfu(float f) { unsigned u = __builtin_bit_cast(unsigned, f); return (u + 0x7fffu + ((u >> 16) & 1u)) >> 16; }
__device__ __forceinline__ unsigned pk2(float lo, float hi) { return f2bfu(lo) | (f2bfu(hi) << 16); }

#define XB_TMO      128
#define XB_XCNT(j)  (256  + 64 * (j))
#define XB_XSUB(j)  (1280 + 64 * (j))
#define XB_XGEN(j)  (2304 + 64 * (j))
#define XB_TOP      3328
#define XB_TOPGEN   3392
#define XCD_BAR_WORDS 3456
#define XB_SPIN_CAP (1u << 18)

__device__ __forceinline__ unsigned xb_ld(unsigned* p)              { return __hip_atomic_load(p, __ATOMIC_RELAXED, __HIP_MEMORY_SCOPE_AGENT); }
__device__ __forceinline__ unsigned xb_add(unsigned* p, unsigned v) { return __hip_atomic_fetch_add(p, v, __ATOMIC_RELAXED, __HIP_MEMORY_SCOPE_AGENT); }
__device__ __forceinline__ unsigned xb_xcc_id() { return (unsigned)__builtin_amdgcn_s_getreg((3 << 11) | 20) & 0xFu; }
#define XB_SPIN(cond, bar) do { unsigned _sp = 0; while (cond) { __builtin_amdgcn_s_sleep(1); \
    if ((++_sp & 255u) == 0u) { if (xb_ld(&(bar)[XB_TMO])) break; if (_sp > XB_SPIN_CAP) { atomicAdd(&(bar)[XB_TMO], 1u); break; } } } } while (0)

struct XcdBarrier {
    unsigned* bar; unsigned x;
    volatile LAS unsigned* st;
};

__device__ __forceinline__ XcdBarrier xcd_barrier_post(unsigned* bar, volatile LAS unsigned* st) {
    XcdBarrier b; b.bar = bar; b.x = xb_xcc_id(); b.st = st;
    if (threadIdx.x == 0) (void)xb_add(&bar[XB_XCNT(b.x)], 1u);
    return b;
}
__device__ __forceinline__ void xcd_barrier_complete(unsigned* bar, unsigned x, unsigned& nloc, unsigned& nx) {
    const unsigned G = gridDim.x * gridDim.y * gridDim.z;
    unsigned sum, cnt, mine, sp = 0u;
    for (;;) {
        sum = 0u; cnt = 0u; mine = 0u;
#pragma unroll
        for (unsigned j = 0; j < 16; ++j) { const unsigned c = xb_ld(&bar[XB_XCNT(j)]); sum += c; cnt += (c > 0u) ? 1u : 0u; mine = (j == x) ? c : mine; }
        if (sum == G) break;
        __builtin_amdgcn_s_sleep(1);
        if ((++sp & 255u) == 0u) { if (xb_ld(&bar[XB_TMO])) break; if (sp > XB_SPIN_CAP) { atomicAdd(&bar[XB_TMO], 1u); break; } }
    }
    nloc = mine > 0u ? mine : 1u; nx = cnt > 0u ? cnt : 1u;
}

__device__ __forceinline__ void xcd_barrier(const XcdBarrier& b) {
    asm volatile("s_waitcnt vmcnt(0)" ::: "memory");
    __syncthreads();
    if (threadIdx.x == 0) {
        unsigned* bar = b.bar;
        __builtin_amdgcn_s_waitcnt(0);
        unsigned nloc = b.st[0], nx = b.st[1];
        if (nloc == 0u) { xcd_barrier_complete(bar, b.x, nloc, nx); b.st[0] = nloc; b.st[1] = nx; }
        const unsigned old = xb_add(&bar[XB_XSUB(b.x)], 1u);
        const unsigned gen = old / nloc;
        if (old + 1u == (gen + 1u) * nloc) {
            __builtin_amdgcn_fence(__ATOMIC_RELEASE, "agent");
            asm volatile("s_waitcnt vmcnt(0)" ::: "memory");
            const unsigned og = xb_add(&bar[XB_TOP], 1u);
            const unsigned tg = og / nx;
            if (og + 1u == (tg + 1u) * nx) xb_add(&bar[XB_TOPGEN], 1u);
            else XB_SPIN(xb_ld(&bar[XB_TOPGEN]) == tg, bar);
            __builtin_amdgcn_fence(__ATOMIC_ACQUIRE, "agent");
            xb_add(&bar[XB_XGEN(b.x)], 1u);
            asm volatile("s_waitcnt vmcnt(0)" ::: "memory");
        } else {
            XB_SPIN(xb_ld(&bar[XB_XGEN(b.x)]) == gen, bar);
            __builtin_amdgcn_fence(__ATOMIC_ACQUIRE, "agent");
            asm volatile("s_waitcnt vmcnt(0)" ::: "memory");
        }
    }
    __syncthreads();
}

__device__ __forceinline__ float wave_sum(float v) {
#pragma unroll
    for (int o = 1; o < 64; o <<= 1) v += __shfl_xor(v, o);
    return v;
}
struct ConvJob { const float* W; const float* gain; bf16* WT; int ldw, col0, nvalid, K, k0, drow0; };
__device__ __forceinline__ void conv_item(const ConvJob& j, LAS float* scr, int lane) {
    const int c = lane & 31;
#pragma unroll 8
    for (int i = 0; i < 32; ++i) { const int kk = 2 * i + (lane >> 5); float v = 0.f; if (c < j.nvalid) v = j.W[(size_t)(j.k0 + kk) * j.ldw + j.col0 + c]; if (j.gain) v *= j.gain[j.k0 + kk]; scr[kk * 33 + c] = v; }
    LDS_WAIT(); asm volatile("" ::: "memory");
    const int ch = lane & 7;
#pragma unroll
    for (int t = 0; t < 4; ++t) { const int n = (lane >> 3) + 8 * t; const LAS float* s = scr + (8 * ch) * 33 + n;
        v4u o; o.x = pk2(s[0 * 33], s[1 * 33]); o.y = pk2(s[2 * 33], s[3 * 33]); o.z = pk2(s[4 * 33], s[5 * 33]); o.w = pk2(s[6 * 33], s[7 * 33]);
        *(GAS v4u*)(j.WT + (size_t)(j.drow0 + n) * j.K + j.k0 + 8 * ch) = o; }
    LDS_WAIT(); asm volatile("" ::: "memory");
}
__device__ __forceinline__ void rms_row_to_bf16(const float* xrow, const float* g, bf16* orow, int lane) {
    const GAS f32x4* xr = (const GAS f32x4*)xrow + lane; const GAS f32x4* gr = (const GAS f32x4*)g + lane;
    f32x4 v[4]; float s = 0.f;
#pragma unroll
    for (int j = 0; j < 4; ++j) { v[j] = xr[64 * j]; s += (v[j].x * v[j].x + v[j].y * v[j].y) + (v[j].z * v[j].z + v[j].w * v[j].w); }
    const float rs = rsqrtf(wave_sum(s) * (1.f / D) + EPS);
    GAS unsigned long long* o8 = (GAS unsigned long long*)orow + lane;
#pragma unroll
    for (int j = 0; j < 4; ++j) { const f32x4 gg = gr[64 * j]; o8[64 * j] = (unsigned long long)pk2(v[j].x * rs * gg.x, v[j].y * rs * gg.y) | ((unsigned long long)pk2(v[j].z * rs * gg.z, v[j].w * rs * gg.w) << 32); }
}
__device__ __forceinline__ void rms_row_to_f32(float* xrow, const float* g, int lane) {
    GAS f32x4* xr = (GAS f32x4*)xrow + lane; const GAS f32x4* gr = (const GAS f32x4*)g + lane;
    f32x4 v[4]; float s = 0.f;
#pragma unroll
    for (int j = 0; j < 4; ++j) { v[j] = xr[64 * j]; s += (v[j].x * v[j].x + v[j].y * v[j].y) + (v[j].z * v[j].z + v[j].w * v[j].w); }
    const float rs = rsqrtf(wave_sum(s) * (1.f / D) + EPS);
#pragma unroll
    for (int j = 0; j < 4; ++j) { const f32x4 gg = gr[64 * j]; xr[64 * j] = v[j] * rs * gg; }
}

struct Args { P p; int ph_lo, ph_hi, li, pad; };
__global__ void __launch_bounds__(NWAVES * 64, 2) mega(Args args) {
    extern __shared__ __attribute__((aligned(16))) unsigned char lds_raw[];
    LAS unsigned char* lds = (LAS unsigned char*)lds_raw;
    volatile LAS unsigned* MISC = (volatile LAS unsigned*)(lds + MISC_OFF);
    const int tid = threadIdx.x, lane = tid & 63, wave = __builtin_amdgcn_readfirstlane(tid >> 6);
    const int G = gridDim.x; const int bx = blockIdx.x; const int vcu = (G % 8 == 0) ? (bx % 8) * (G / 8) + bx / 8 : bx;
    const P& p = args.p; unsigned char* ws = p.ws;
    gu32* ctl = (gu32*)(ws + WS_CTL);
    for (int u = tid; u < (LDS_BYTES - LDSCTL_OFF) / 4; u += NWAVES * 64) ((LAS unsigned*)(lds + LDSCTL_OFF))[u] = 0u;
#ifdef LDSPOISON
    for (int u = tid; u < RING_BYTES / 16; u += NWAVES * 64) ((LAS v4u*)lds)[u] = (v4u){0x7fc07fc0u, 0x7fc07fc0u, 0x7fc07fc0u, 0x7fc07fc0u};
#endif
    __syncthreads();
    XcdBarrier bar = xcd_barrier_post((unsigned*)(ctl + CW_BAR) + args.li * XCD_BAR_WORDS, MISC + 8);
    const int lo = args.ph_lo, hi = args.ph_hi;
#ifndef PHMASK
#define PHMASK 0x3ffff
#endif
#define IN(k) (((PHMASK >> (k)) & 1) && lo <= (k) && (k) < hi)
#define SEAM(k) do { if (IN(k) && IN((k) + 1)) xcd_barrier(bar); } while (0)
    float *cs = (float*)(ws + WS_COS), *sn = (float*)(ws + WS_SIN), *ssqq = (float*)(ws + WS_SSQQ), *ssqkv = (float*)(ws + WS_SSQKV);
    bf16 *XN = (bf16*)(ws + WS_XN), *MEMN = (bf16*)(ws + WS_MEMN), *ACT = (bf16*)(ws + SC_ACT), *OMLA = (bf16*)(ws + SC_OMLA), *OX = (bf16*)(ws + SC_OX), *KVX = (bf16*)(ws + SC_KVX),
         *GZ = (bf16*)(ws + SC_GZ), *ZC = (bf16*)(ws + SC_ZC), *ZKV = (bf16*)(ws + SC_ZKV), *ZG = (bf16*)(ws + SC_ZG), *ZXQ = OX, *Q = (bf16*)(ws + SC_Q), *KVM = (bf16*)(ws + SC_KVM), *KR = (bf16*)(ws + SC_KR),
         *MERGED = (bf16*)(ws + SC_MERGED);
    const int gw = vcu * NWAVES + wave, NGW = G * NWAVES;

    if (IN(0)) {
        LAS float* scr = (LAS float*)(lds + RING_OFF + wave * 16384);
        constexpr int I_GU = 16 * 176, I_D = 44 * 32, I_IN1 = 16 * 88, I_GZ = 16 * 96, I_UQ = 6 * 24, I_UKV = 4 * 32, I_O = 8 * 32, I_SQ = 16 * 32;
        constexpr int NITEMS = 2 * I_GU + 2 * I_D + I_IN1 + I_GZ + I_UQ + I_UKV + 3 * I_O + 2 * I_SQ;
        for (int it = gw; it < NITEMS; it += NGW) {
            int r = it; ConvJob j; j.gain = nullptr; j.nvalid = 32;
            if (r < 2 * I_GU) { const int second = r >= I_GU; if (second) r -= I_GU; const int kb = r / 176, rb = r % 176, tile = rb >> 3, sub = rb & 7;
                j.W = sub < 4 ? (second ? p.ffn2_wg : p.ffn1_wg) : (second ? p.ffn2_wu : p.ffn1_wu); j.ldw = FF; j.col0 = 128 * tile + 32 * (sub & 3); j.K = D; j.k0 = 64 * kb; j.WT = (bf16*)(ws + (second ? WS_WGU2 : WS_WGU1)); j.drow0 = 32 * rb; }
            else if ((r -= 2 * I_GU) < 2 * I_D) { const int second = r >= I_D; if (second) r -= I_D; const int kb = r / 32, rb = r % 32;
                j.W = second ? p.ffn2_wd : p.ffn1_wd; j.ldw = D; j.col0 = 32 * rb; j.K = FF; j.k0 = 64 * kb; j.WT = (bf16*)(ws + (second ? WS_WD2 : WS_WD1)); j.drow0 = 32 * rb; }
            else if ((r -= 2 * I_D) < I_IN1) { const int kb = r / 88, rb = r % 88; const int s = e1_src(32 * rb);
                j.W = p.w_in; j.ldw = DIN; j.col0 = s < 0 ? 0 : s; j.nvalid = s < 0 ? 0 : (32 * rb == ZC_GA ? 16 : 32); j.K = D; j.k0 = 64 * kb; j.WT = (bf16*)(ws + WS_WIN1); j.drow0 = 32 * rb; }
            else if ((r -= I_IN1) < I_GZ) { const int kb = r / 96, rb = r % 96;
                j.W = p.w_in; j.ldw = DIN; j.col0 = 2736 + 32 * rb; j.K = D; j.k0 = 64 * kb; j.WT = (bf16*)(ws + WS_WGZ); j.drow0 = 32 * rb; }
            else if ((r -= I_GZ) < I_UQ) { const int kb = r / 24, rb = r % 24, r0 = 32 * rb;
                j.W = p.w_uq; j.ldw = 768; j.col0 = r0 < 512 ? 96 * (r0 >> 6) + (r0 & 63) : 96 * ((r0 - 512) >> 5) + 64; j.gain = p.q_norm; j.K = 384; j.k0 = 64 * kb; j.WT = (bf16*)(ws + WS_WUQ); j.drow0 = r0; }
            else if ((r -= I_UQ) < I_UKV) { const int kb = r / 32, rb = r % 32, r0 = 32 * rb;
                j.W = p.w_ukv; j.ldw = 1024; j.col0 = r0 < 512 ? 128 * (r0 >> 6) + (r0 & 63) : 128 * ((r0 - 512) >> 6) + 64 + (r0 & 63); j.gain = p.kv_norm; j.K = 256; j.k0 = 64 * kb; j.WT = (bf16*)(ws + WS_WUKV); j.drow0 = r0; }
            else if ((r -= I_UKV) < 3 * I_O) { const int which = r / I_O; r -= which * I_O; const int kb = r / 32, rb = r % 32;
                j.W = which == 0 ? p.w_o_mla : which == 1 ? p.w_o_gla : p.x_w_o; j.ldw = D; j.col0 = 32 * rb; j.K = 512; j.k0 = 64 * kb; j.WT = (bf16*)(ws + WS_WOM + (size_t)which * MiB); j.drow0 = 32 * rb; }
            else { r -= 3 * I_O; const int which = r / I_SQ; r -= which * I_SQ; const int kb = r / 32, rb = r % 32;
                j.W = which == 0 ? p.x_w_kv : p.w_out; j.ldw = D; j.col0 = 32 * rb; j.K = D; j.k0 = 64 * kb; j.WT = (bf16*)(ws + (which == 0 ? WS_WXKV : WS_WOUT)); j.drow0 = 32 * rb; }
            conv_item(j, scr, lane);
        }
        for (int m = gw; m < M; m += NGW) rms_row_to_bf16(p.x + (size_t)m * D, p.ffn1_norm, XN + (size_t)m * D, lane);
        for (int m = gw; m < MMEM; m += NGW) rms_row_to_bf16(p.mem + (size_t)m * D, p.mem_norm, MEMN + (size_t)m * D, lane);
        for (int i = vcu * NWAVES * 64 + tid; i < M * 16; i += G * NWAVES * 64) { const int m = i >> 4, jj = i & 15;
            const float inv = powf(10000.f, -(float)jj / 16.f); const float ang = (float)p.pos[m] * inv; cs[i] = cosf(ang); sn[i] = sinf(ang); }
    }
    SEAM(0);
#define GEMM_PHASE(EPI, ORDER, g, S, E) pg8::gemm_phase<EPI, ORDER, true, true>(lds + RING_OFF, g, S, E)
    if (IN(1)) { pg8::Gemm g{XN, (const bf16*)(ws + WS_WGU1), 0, 0, D, D, D, 0}; pg8::StaticOrder S; S.init(M, 2 * FF, G, bx); pg8::EpiSwiGLU E{ACT, FF, 0}; GEMM_PHASE(pg8::EpiSwiGLU, pg8::StaticOrder, g, S, E); }
    SEAM(1);
    if (IN(2)) { pg8::Gemm g{ACT, (const bf16*)(ws + WS_WD1), 0, 0, FF, FF, FF, 0}; pg8::StaticOrder S; S.init(M, D, G, bx); pg8::EpiResid E{p.x, p.out, 0.5f, 0}; GEMM_PHASE(pg8::EpiResid, pg8::StaticOrder, g, S, E); }
    SEAM(2);
    if (IN(3)) { for (int m = gw; m < M; m += NGW) rms_row_to_bf16(p.out + (size_t)m * D, p.mix_norm, XN + (size_t)m * D, lane); }
    SEAM(3);
    if (IN(4)) {
        { pg8::Gemm g{XN, (const bf16*)(ws + WS_WIN1), 0, 0, D, D, D, 0}; pg8::StaticOrder S; S.init(M, Z1_W, G, bx); pg8::EpiZ1 E{ZC, ZKV, ZG, ZXQ, ssqq, ssqkv}; GEMM_PHASE(pg8::EpiZ1, pg8::StaticOrder, g, S, E); }
        { pg8::Gemm g{MEMN, (const bf16*)(ws + WS_WXKV), 0, 0, D, D, D, 0}; pg8::StaticOrder S; S.init(MMEM, 1024, G, (bx + 192) % G); pg8::EpiPlain E{KVX, 1024, 0}; GEMM_PHASE(pg8::EpiPlain, pg8::StaticOrder, g, S, E); }
    }
    SEAM(4);
    float* DSb = (float*)(ws + SC_DS); float* DECb = (float*)(ws + SC_DEC); bf16* SPREV = (bf16*)(ws + SC_SPREV); bf16* OGLA = (bf16*)(ws + SC_OGLA);
    if (IN(5)) { int lasth = -1;
        for (int u = vcu; u < NB * 4 * GLA_N; u += G) { const int n = u & 31, h = (u >> 5) & 3, b = u >> 7;
            if (h != lasth) { __syncthreads(); att::gla_load_w(lds, p.w_a2, p.b_a, h); __syncthreads(); lasth = h; }
            att::gla_pass_a(lds, ZC, ZG, DSb, DECb, b, h, n); } }
    SEAM(5);
    if (IN(6)) { for (int gid = vcu * NWAVES * 64 + tid; gid < NB * 4 * 4096; gid += G * NWAVES * 64) { const int bh = gid >> 12, e2 = gid & 4095, dv = e2 >> 5, d = 2 * (e2 & 31); float s0 = 0.f, s1 = 0.f;
            const float* dsp = DSb + ((size_t)bh * GLA_N * 128 + dv) * 64 + d; const float* dcp = DECb + (size_t)bh * GLA_N * 64 + d; bf16* spp = SPREV + ((size_t)bh * GLA_N * 128 + dv) * 64 + d;
#pragma unroll 4
            for (int n = 0; n < GLA_N; ++n) { *(unsigned*)(spp + (size_t)n * 8192) = pk2(s0, s1); const float2 ds = *(const float2*)(dsp + (size_t)n * 8192), dc = *(const float2*)(dcp + n * 64); s0 = dc.x * s0 + ds.x; s1 = dc.y * s1 + ds.y; } } }
    SEAM(6);
    if (IN(7)) { int lasth = -1;
        for (int u = vcu; u < NB * 4 * GLA_N; u += G) { const int n = u & 31, h = (u >> 5) & 3, b = u >> 7;
            if (h != lasth) { __syncthreads(); att::gla_load_w(lds, p.w_a2, p.b_a, h); __syncthreads(); lasth = h; }
            att::gla_pass_c(lds, ZC, ZG, SPREV, p.o_norm, OGLA, b, h, n); } }
    SEAM(7);
    if (IN(8)) {
        for (int i = vcu * NWAVES * 64 + tid; i < M * 16; i += G * NWAVES * 64) { const int r = i >> 4, jj = i & 15; const float c = cs[i], s = sn[i];
            const bf16* z = ZC + (size_t)r * ZC_W + ZC_KROPE; const float x1 = bf2f(z[jj]), x2 = bf2f(z[jj + 16]); KR[(size_t)r * 32 + jj] = f2bf(x1 * c - x2 * s); KR[(size_t)r * 32 + jj + 16] = f2bf(x1 * s + x2 * c); }
        { pg8::Gemm g{ZC, (const bf16*)(ws + WS_WUQ), 0, 0, ZC_W, 384, 384, 0}; pg8::StaticOrder S; S.init(M, QW, G, bx); pg8::EpiQ E{Q, ssqq, cs, sn}; GEMM_PHASE(pg8::EpiQ, pg8::StaticOrder, g, S, E); }
        { pg8::Gemm g{ZKV, (const bf16*)(ws + WS_WUKV), 0, 0, ZKV_W, 256, 256, 0}; pg8::StaticOrder S; S.init(M, KVW, G, (bx + 192) % G); pg8::EpiKV E{KVM, ssqkv}; GEMM_PHASE(pg8::EpiKV, pg8::StaticOrder, g, S, E); }
    }
    SEAM(8);
    if (IN(9)) { for (int it = vcu; it < NB * 8 * 4; it += G) { const int s4 = it & 3, hd = (it >> 2) & 7, b = it >> 5; att::MlaT T{Q, KVM, KR, OMLA, hd, 0};
            att::attn_unit<att::MlaT>(lds, T, b, 7 - s4); att::attn_unit<att::MlaT>(lds, T, b, s4); } }
    SEAM(9);
    if (IN(10)) { for (int it = vcu; it < NB * 4 * 8; it += G) { const int qb = it & 7, hd = (it >> 3) & 3, b = it >> 5; att::CrossT T{ZXQ, KVX, OX, hd, 0}; att::attn_unit<att::CrossT>(lds, T, b, qb); } }
    SEAM(10);
    if (IN(11)) { pg8::Gemm g{XN, (const bf16*)(ws + WS_WGZ), 0, 0, D, D, D, 0}; pg8::StaticOrder S; S.init(M, 3072, G, bx);
#ifdef X3
        pg8::EpiPlain E{GZ, 3072, 0}; GEMM_PHASE(pg8::EpiPlain, pg8::StaticOrder, g, S, E);
#else
        pg8::EpiGate E{GZ, p.gate_bias}; GEMM_PHASE(pg8::EpiGate, pg8::StaticOrder, g, S, E);
#endif
    }
    SEAM(11);
    if (IN(12)) { pg8::Gemm g{OMLA, (const bf16*)(ws + WS_WOM), (size_t)16 * MiB, (size_t)1 * MiB, 512, 512, 512, 0}; pg8::MergeOrder S; S.init(M, D, G, bx); pg8::EpiMerge E{MERGED, GZ}; GEMM_PHASE(pg8::EpiMerge, pg8::MergeOrder, g, S, E); }
    SEAM(12);
    if (IN(13)) { pg8::Gemm g{MERGED, (const bf16*)(ws + WS_WOUT), 0, 0, D, D, D, 0}; pg8::StaticOrder S; S.init(M, D, G, bx); pg8::EpiResid E{p.out, p.out, 1.0f, 0}; GEMM_PHASE(pg8::EpiResid, pg8::StaticOrder, g, S, E); }
    SEAM(13);
    if (IN(14)) { for (int m = gw; m < M; m += NGW) rms_row_to_bf16(p.out + (size_t)m * D, p.ffn2_norm, XN + (size_t)m * D, lane); }
    SEAM(14);
    if (IN(15)) { pg8::Gemm g{XN, (const bf16*)(ws + WS_WGU2), 0, 0, D, D, D, 0}; pg8::StaticOrder S; S.init(M, 2 * FF, G, bx); pg8::EpiSwiGLU E{ACT, FF, 0}; GEMM_PHASE(pg8::EpiSwiGLU, pg8::StaticOrder, g, S, E); }
    SEAM(15);
    if (IN(16)) { pg8::Gemm g{ACT, (const bf16*)(ws + WS_WD2), 0, 0, FF, FF, FF, 0}; pg8::StaticOrder S; S.init(M, D, G, bx); pg8::EpiResid E{p.out, p.out, 0.5f, 0}; GEMM_PHASE(pg8::EpiResid, pg8::StaticOrder, g, S, E); }
    SEAM(16);
    if (IN(17)) { for (int m = gw; m < M; m += NGW) rms_row_to_f32(p.out + (size_t)m * D, p.final_norm, lane); }
#undef IN
#undef SEAM
}

#ifndef FASTMASK
#define FASTMASK 0x3FFFFu
#endif
extern "C" void kernel_launch(void* const* d_in, const int* in_sizes, int n_in, void* d_out, int out_size, void* d_ws, size_t ws_size, hipStream_t stream) {
    if (n_in != 28 || in_sizes[0] != M * D || out_size != M * D || ws_size < WS_END) { fprintf(stderr, "kernel_launch: unexpected shapes (n_in %d, in0 %d, out %d, ws %zu)\n", n_in, n_in > 0 ? in_sizes[0] : -1, out_size, ws_size); return; }
    static int grid = 0;
    if (grid == 0) {
        int dev = 0, cus = 0;
        if (hipGetDevice(&dev) != hipSuccess || hipDeviceGetAttribute(&cus, hipDeviceAttributeMultiprocessorCount, dev) != hipSuccess) { fprintf(stderr, "kernel_launch: device query failed\n"); grid = -1; return; }
        if (hipFuncSetAttribute((const void*)mega, hipFuncAttributeMaxDynamicSharedMemorySize, LDS_BYTES) != hipSuccess) { fprintf(stderr, "kernel_launch: hipFuncSetAttribute failed\n"); grid = -1; return; }
        int per_cu = 0; if (hipOccupancyMaxActiveBlocksPerMultiprocessor(&per_cu, (const void*)mega, NWAVES * 64, LDS_BYTES) != hipSuccess || per_cu < 1) fprintf(stderr, "kernel_launch: occupancy query says %d\n", per_cu);
        (void)hipGetLastError();
        grid = cus;
    }
    if (grid < 0) return;
    P p{};
    p.x = (const float*)d_in[0]; p.mem = (const float*)d_in[1]; p.pos = (const int*)d_in[2];
    p.ffn1_norm = (const float*)d_in[3]; p.ffn1_wg = (const float*)d_in[4]; p.ffn1_wu = (const float*)d_in[5]; p.ffn1_wd = (const float*)d_in[6]; p.mix_norm = (const float*)d_in[7]; p.mem_norm = (const float*)d_in[8];
    p.w_in = (const float*)d_in[9]; p.gate_bias = (const float*)d_in[10]; p.q_norm = (const float*)d_in[11]; p.w_uq = (const float*)d_in[12]; p.kv_norm = (const float*)d_in[13]; p.w_ukv = (const float*)d_in[14];
    p.w_o_mla = (const float*)d_in[15]; p.w_a2 = (const float*)d_in[16]; p.b_a = (const float*)d_in[17]; p.o_norm = (const float*)d_in[18]; p.w_o_gla = (const float*)d_in[19]; p.x_w_kv = (const float*)d_in[20];
    p.x_w_o = (const float*)d_in[21]; p.w_out = (const float*)d_in[22]; p.ffn2_norm = (const float*)d_in[23]; p.ffn2_wg = (const float*)d_in[24]; p.ffn2_wu = (const float*)d_in[25]; p.ffn2_wd = (const float*)d_in[26];
    p.final_norm = (const float*)d_in[27]; p.out = (float*)d_out; p.ws = (unsigned char*)d_ws;
    unsigned char* ws = p.ws;
    float *cs = (float*)(ws + WS_COS), *sn = (float*)(ws + WS_SIN), *ssqq = (float*)(ws + WS_SSQQ), *ssqkv = (float*)(ws + WS_SSQKV);
    bf16 *XN = (bf16*)(ws + WS_XN), *MEMN = (bf16*)(ws + WS_MEMN), *ACT = (bf16*)(ws + SC_ACT), *OMLA = (bf16*)(ws + SC_OMLA), *OGLA = (bf16*)(ws + SC_OGLA), *OX = (bf16*)(ws + SC_OX), *KVX = (bf16*)(ws + SC_KVX),
         *GZ = (bf16*)(ws + SC_GZ), *ZC = (bf16*)(ws + SC_ZC), *ZKV = (bf16*)(ws + SC_ZKV), *ZG = (bf16*)(ws + SC_ZG), *ZXQ = OX, *Q = (bf16*)(ws + SC_Q), *KVM = (bf16*)(ws + SC_KVM), *KR = (bf16*)(ws + SC_KR),
         *MERGED = (bf16*)(ws + SC_MERGED);
    float* OTMP = (float*)(ws + SC_DS);
    (void)hipMemsetAsync((char*)d_ws + WS_CTL, 0, CTL_ZERO_BYTES, stream);
    const unsigned mask = FASTMASK; int li = 0;
    for (int ph = 0; ph < NPH; ) {
        const bool fast = (mask >> (ph >= 5 && ph <= 7 ? 5 : ph)) & 1u;
        if (fast) { int e = ph + 1; while (e < NPH && ((mask >> (e >= 5 && e <= 7 ? 5 : e)) & 1u)) ++e;
            Args a{}; a.p = p; a.ph_lo = ph; a.ph_hi = e; a.li = li++; a.pad = 0;
            hipLaunchKernelGGL(mega, dim3(grid), dim3(NWAVES * 64), LDS_BYTES, stream, a);
#ifdef X3
            if (ph == 11) n_gate_fin<<<M * 3072 / 256, 256, 0, stream>>>(GZ, p.gate_bias);
#endif
#ifdef X2
            if (ph == 11) n_gemm<1, DGate><<<dim3(3072 / 64, M / 64), 256, 0, stream>>>(DGate{XN, p.w_in, p.gate_bias, GZ, M, 3072, D, 0});
#endif
            ph = e; continue; }
        switch (ph) {
        case 0: n_rope_tab<<<M * 16 / 256, 256, 0, stream>>>(p.pos, cs, sn); n_rmsnorm<false><<<M / 4, 256, 0, stream>>>(p.x, p.ffn1_norm, XN, nullptr, M); n_rmsnorm<false><<<MMEM / 4, 256, 0, stream>>>(p.mem, p.mem_norm, MEMN, nullptr, MMEM); break;
        case 1: n_gemm<2, DUp><<<dim3(FF / 64, M / 64), 256, 0, stream>>>(DUp{XN, p.ffn1_wg, p.ffn1_wu, ACT, M, FF, D, 0}); break;
        case 2: n_gemm<1, DRes><<<dim3(D / 64, M / 64), 256, 0, stream>>>(DRes{ACT, p.ffn1_wd, p.x, p.out, M, D, FF, FF, 0.5f, 0}); break;
        case 3: n_rmsnorm<false><<<M / 4, 256, 0, stream>>>(p.out, p.mix_norm, XN, nullptr, M); break;
        case 4: n_gemm<1, DE1><<<dim3(Z1_W / 64, M / 64), 256, 0, stream>>>(DE1{XN, p.w_in, ZC, ZKV, ZG, ZXQ, M, Z1_W, D, 0});
                n_gemm<1, DPlain><<<dim3(1024 / 64, MMEM / 64), 256, 0, stream>>>(DPlain{MEMN, p.x_w_kv, KVX, MMEM, 1024, D, D, 1024, 1024});
                n_ssq<<<(M * 20 + 255) / 256, 256, 0, stream>>>(ZC, ZKV, ssqq, ssqkv); break;
        case 5: n_gla_rec<<<NB * 4, 128, 0, stream>>>(ZC, ZG, p.w_a2, p.b_a, OTMP); n_gla_fin<<<M * 4 / 4, 256, 0, stream>>>(OTMP, ZG, p.o_norm, OGLA); break;
        case 6: case 7: break;
        case 8: n_gemm<1, DQ><<<dim3(QW / 64, M / 64), 256, 0, stream>>>(DQ{ZC, p.w_uq, p.q_norm, ssqq, Q, M, QW, 384, 0});
                n_gemm<1, DKV><<<dim3(KVW / 64, M / 64), 256, 0, stream>>>(DKV{ZKV, p.w_ukv, p.kv_norm, ssqkv, KVM, M, KVW, 256, 0});
                n_rope<<<(M * 144 + 255) / 256, 256, 0, stream>>>(Q, ZC, KR, cs, sn); break;
        case 9: n_mla_attn<<<NB * 8 * SEQ * 4 / 256, 256, 0, stream>>>(Q, KVM, KR, OMLA); break;
        case 10: { bf16* OXT = (bf16*)(ws + SC_DS); n_cross_attn<<<NB * 4 * SEQ * 4 / 256, 256, 0, stream>>>(ZXQ, KVX, OXT); (void)hipMemcpyAsync(OX, OXT, (size_t)M * 512 * 2, hipMemcpyDeviceToDevice, stream); } break;
        case 11: n_gemm<1, DGate><<<dim3(3072 / 64, M / 64), 256, 0, stream>>>(DGate{XN, p.w_in, p.gate_bias, GZ, M, 3072, D, 0}); break;
        case 12: n_gemm<3, DMerge><<<dim3(D / 64, M / 64), 256, 0, stream>>>(DMerge{OMLA, p.w_o_mla, p.w_o_gla, p.x_w_o, GZ, MERGED, M, D, 512, 0}); break;
        case 13: n_gemm<1, DRes><<<dim3(D / 64, M / 64), 256, 0, stream>>>(DRes{MERGED, p.w_out, p.out, p.out, M, D, D, D, 1.0f, 0}); break;
        case 14: n_rmsnorm<false><<<M / 4, 256, 0, stream>>>(p.out, p.ffn2_norm, XN, nullptr, M); break;
        case 15: n_gemm<2, DUp><<<dim3(FF / 64, M / 64), 256, 0, stream>>>(DUp{XN, p.ffn2_wg, p.ffn2_wu, ACT, M, FF, D, 0}); break;
        case 16: n_gemm<1, DRes><<<dim3(D / 64, M / 64), 256, 0, stream>>>(DRes{ACT, p.ffn2_wd, p.out, p.out, M, D, FF, FF, 0.5f, 0}); break;
        case 17: n_rmsnorm<true><<<M / 4, 256, 0, stream>>>(p.out, p.final_norm, nullptr, p.out, M); break;
        }
        ++ph;
    }
}
```

```cpp
#include <hip/hip_runtime.h>
#include <cstdint>
#include <cstdio>


typedef unsigned short bf16;
__device__ __forceinline__ float bf2f(bf16 v) { return __uint_as_float((unsigned)v << 16); }
__device__ __forceinline__ bf16 f2bf(float f) { unsigned u = __float_as_uint(f); return (bf16)((u + 0x7fffu + ((u >> 16) & 1u)) >> 16); }

constexpr int NB = 8, SEQ = 2048, D = 1024, M = NB * SEQ, NMEM = 256, MMEM = NB * NMEM, FF = 2816, DIN = 5808;
constexpr float EPS = 1e-6f;
constexpr int ZC_W = 512, ZKV_W = 256, ZG_W = 1536, ZXQ_W = 512, Z1_W = 2816;
constexpr int ZC_KROPE = 384, ZC_GA = 416;
constexpr int ZG_Q = 0, ZG_K = 256, ZG_V = 512, ZG_R = 1024;
constexpr int QW = 768, KVW = 1024;
constexpr float QSCALE = 0.10206207261596577f * 1.4426950408889634f;
constexpr float XSCALE = 0.08838834764831845f * 1.4426950408889634f;
constexpr int GLA_N = SEQ / 64;

constexpr size_t MiB = 1u << 20;
constexpr size_t WS_CTL = 0, WS_COS = 1 * MiB, WS_SIN = 2 * MiB, WS_SSQQ = 3 * MiB, WS_SSQKV = 4 * MiB;
constexpr size_t WS_WGU1 = 5 * MiB, WS_WD1 = 16 * MiB, WS_WIN1 = 21 * MiB + 512 * 1024, WS_WGZ = 27 * MiB, WS_WUQ = 33 * MiB, WS_WUKV = 34 * MiB, WS_WOM = 35 * MiB, WS_WOG = 36 * MiB,
                 WS_WOX = 37 * MiB, WS_WXKV = 38 * MiB, WS_WOUT = 40 * MiB, WS_WGU2 = 42 * MiB, WS_WD2 = 53 * MiB;
constexpr size_t WS_MEMN = 59 * MiB, WS_XN = 63 * MiB, WS_SCR = 95 * MiB;
constexpr size_t SC_ACT = WS_SCR, SC_OMLA = WS_SCR, SC_OGLA = WS_SCR + 16 * MiB, SC_OX = WS_SCR + 32 * MiB, SC_KVX = WS_SCR + 48 * MiB, SC_GZ = WS_SCR + 52 * MiB,
                 SC_ZC = WS_SCR + 52 * MiB, SC_ZKV = WS_SCR + 68 * MiB, SC_ZG = WS_SCR + 76 * MiB, SC_DS = WS_SCR + 124 * MiB, SC_DEC = WS_SCR + 156 * MiB, SC_SPREV = WS_SCR,
                 SC_Q = WS_SCR + 76 * MiB, SC_KVM = WS_SCR + 100 * MiB, SC_KR = WS_SCR + 132 * MiB, SC_MERGED = WS_XN;
constexpr size_t WS_END = 256 * MiB;
static_assert(SC_DEC + MiB <= WS_END && SC_GZ + 96 * MiB <= WS_END, "ws map");

struct P {
    const float *x, *mem; const int* pos;
    const float *ffn1_norm, *ffn1_wg, *ffn1_wu, *ffn1_wd, *mix_norm, *mem_norm, *w_in, *gate_bias, *q_norm, *w_uq, *kv_norm, *w_ukv, *w_o_mla, *w_a2, *b_a, *o_norm, *w_o_gla,
        *x_w_kv, *x_w_o, *w_out, *ffn2_norm, *ffn2_wg, *ffn2_wu, *ffn2_wd, *final_norm;
    float* out; unsigned char* ws;
};

template <bool F32OUT> __global__ void __launch_bounds__(256) n_rmsnorm(const float* in, const float* g, bf16* outb, float* outf, int rows) {
    const int row = blockIdx.x * 4 + (threadIdx.x >> 6), lane = threadIdx.x & 63; if (row >= rows) return;
    const float* r = in + (size_t)row * D; float v[16]; float s = 0.f;
#pragma unroll
    for (int j = 0; j < 16; ++j) { v[j] = r[lane + 64 * j]; s += v[j] * v[j]; }
#pragma unroll
    for (int o = 1; o < 64; o <<= 1) s += __shfl_xor(s, o);
    const float rs = rsqrtf(s * (1.f / D) + EPS);
#pragma unroll
    for (int j = 0; j < 16; ++j) { const float y = v[j] * rs * g[lane + 64 * j]; if (F32OUT) outf[(size_t)row * D + lane + 64 * j] = y; else outb[(size_t)row * D + lane + 64 * j] = f2bf(y); }
}
__global__ void __launch_bounds__(256) n_rope_tab(const int* pos, float* cs, float* sn) {
    const int i = blockIdx.x * 256 + threadIdx.x; if (i >= M * 16) return; const int m = i >> 4, j = i & 15;
    const float inv = powf(10000.f, -(float)j / 16.f); const float ang = (float)pos[m] * inv; cs[i] = cosf(ang); sn[i] = sinf(ang);
}
template <int NACC, class Desc> __global__ void __launch_bounds__(256) n_gemm(Desc d) {
    __shared__ float As[NACC][16][65], Bs[NACC][16][65];
    const int tid = threadIdx.x, tx = tid & 15, ty = tid >> 4, row0 = blockIdx.y * 64, col0 = blockIdx.x * 64;
    float acc[NACC][4][4];
#pragma unroll
    for (int s = 0; s < NACC; ++s)
#pragma unroll
        for (int i = 0; i < 4; ++i)
#pragma unroll
            for (int j = 0; j < 4; ++j) acc[s][i][j] = 0.f;
    for (int k0 = 0; k0 < d.K; k0 += 16) {
#pragma unroll
        for (int s = 0; s < NACC; ++s) {
            const int ar = tid >> 2, ak = (tid & 3) * 4;
#pragma unroll
            for (int e = 0; e < 4; ++e) As[s][ak + e][ar] = d.a(s, row0 + ar, k0 + ak + e);
            const int bk = tid >> 4, bc = (tid & 15) * 4;
#pragma unroll
            for (int e = 0; e < 4; ++e) Bs[s][bk][bc + e] = d.b(s, k0 + bk, col0 + bc + e);
        }
        __syncthreads();
#pragma unroll
        for (int k = 0; k < 16; ++k)
#pragma unroll
            for (int s = 0; s < NACC; ++s) {
                float av[4], bv[4];
#pragma unroll
                for (int i = 0; i < 4; ++i) { av[i] = As[s][k][ty * 4 + i]; bv[i] = Bs[s][k][tx * 4 + i]; }
#pragma unroll
                for (int i = 0; i < 4; ++i)
#pragma unroll
                    for (int j = 0; j < 4; ++j) acc[s][i][j] += av[i] * bv[j];
            }
        __syncthreads();
    }
#pragma unroll
    for (int i = 0; i < 4; ++i)
#pragma unroll
        for (int j = 0; j < 4; ++j) { float a[NACC];
#pragma unroll
            for (int s = 0; s < NACC; ++s) a[s] = acc[s][i][j];
            d.epi(row0 + ty * 4 + i, col0 + tx * 4 + j, a); }
}
__device__ __forceinline__ float silu_f(float v) { return v / (1.f + __expf(-v)); }
__device__ __forceinline__ float sigmoid_f(float v) { return 1.f / (1.f + __expf(-v)); }

struct DUp { const bf16* A; const float *wg, *wu; bf16* act; int M, N, K, pad;
    __device__ float a(int, int r, int k) const { return bf2f(A[(size_t)r * D + k]); }
    __device__ float b(int s, int k, int c) const { return (s == 0 ? wg : wu)[(size_t)k * FF + c]; }
    __device__ void epi(int r, int c, const float (&a)[2]) const { act[(size_t)r * FF + c] = f2bf(silu_f(a[0]) * a[1]); } };
struct DRes { const bf16* A; const float* W; const float* base; float* out; int M, N, K, lda; float sc; int pad;
    __device__ float a(int, int r, int k) const { return bf2f(A[(size_t)r * lda + k]); }
    __device__ float b(int, int k, int c) const { return W[(size_t)k * D + c]; }
    __device__ void epi(int r, int c, const float (&a)[1]) const { out[(size_t)r * D + c] = base[(size_t)r * D + c] + sc * a[0]; } };
__device__ __forceinline__ int e1_src(int c) {
    if (c < 384) return c; if (c < 416) return 640 + (c - 384); if (c < 432) return 1696 + (c - 416); if (c < 512) return -1; if (c < 768) return 384 + (c - 512);
    if (c < 1024) return 672 + (c - 768); if (c < 1280) return 928 + (c - 1024); if (c < 1792) return 1184 + (c - 1280); if (c < 2304) return 1712 + (c - 1792); return 2224 + (c - 2304); }
struct DE1 { const bf16* A; const float* W; bf16 *zc, *zkv, *zg, *zxq; int M, N, K, pad;
    __device__ float a(int, int r, int k) const { return bf2f(A[(size_t)r * D + k]); }
    __device__ float b(int, int k, int c) const { const int s = e1_src(c); return s < 0 ? 0.f : W[(size_t)k * DIN + s]; }
    __device__ void epi(int r, int c, const float (&a)[1]) const { const bf16 v = f2bf(a[0]);
        if (c < 512) zc[(size_t)r * ZC_W + c] = v; else if (c < 768) zkv[(size_t)r * ZKV_W + c - 512] = v; else if (c < 2304) zg[(size_t)r * ZG_W + c - 768] = v; else zxq[(size_t)r * ZXQ_W + c - 2304] = v; } };
struct DPlain { const bf16* A; const float* W; bf16* O; int M, N, K, lda, ldw, ldo;
    __device__ float a(int, int r, int k) const { return bf2f(A[(size_t)r * lda + k]); }
    __device__ float b(int, int k, int c) const { return W[(size_t)k * ldw + c]; }
    __device__ void epi(int r, int c, const float (&a)[1]) const { O[(size_t)r * ldo + c] = f2bf(a[0]); } };
struct DQ { const bf16* zc; const float *W, *g, *ssq; bf16* Q; int M, N, K, pad;
    __device__ float a(int, int r, int k) const { return bf2f(zc[(size_t)r * ZC_W + k]); }
    __device__ float b(int, int k, int c) const { const int s = c < 512 ? 96 * (c >> 6) + (c & 63) : 96 * ((c - 512) >> 5) + 64 + (c & 31); return g[k] * W[(size_t)k * 768 + s]; }
    __device__ void epi(int r, int c, const float (&a)[1]) const { float s = 0.f; for (int j = 0; j < 12; ++j) s += ssq[(size_t)r * 12 + j]; Q[(size_t)r * QW + c] = f2bf(a[0] * rsqrtf(s * (1.f / 384.f) + EPS) * QSCALE); } };
struct DKV { const bf16* zkv; const float *W, *g, *ssq; bf16* KV; int M, N, K, pad;
    __device__ float a(int, int r, int k) const { return bf2f(zkv[(size_t)r * ZKV_W + k]); }
    __device__ float b(int, int k, int c) const { const int s = c < 512 ? 128 * (c >> 6) + (c & 63) : 128 * ((c - 512) >> 6) + 64 + (c & 63); return g[k] * W[(size_t)k * 1024 + s]; }
    __device__ void epi(int r, int c, const float (&a)[1]) const { float s = 0.f; for (int j = 0; j < 8; ++j) s += ssq[(size_t)r * 8 + j]; KV[(size_t)r * KVW + c] = f2bf(a[0] * rsqrtf(s * (1.f / 256.f) + EPS)); } };
struct DGate { const bf16* A; const float *W, *bias; bf16* gz; int M, N, K, pad;
    __device__ float a(int, int r, int k) const { return bf2f(A[(size_t)r * D + k]); }
    __device__ float b(int, int k, int c) const { return W[(size_t)k * DIN + 2736 + c]; }
    __device__ void epi(int r, int c, const float (&a)[1]) const { gz[(size_t)r * 3072 + c] = f2bf(sigmoid_f(a[0] + bias[c])); } };
struct DMerge { const bf16* O0; const float *W0, *W1, *W2; const bf16* gz; bf16* mg; int M, N, K, pad;
    __device__ float a(int s, int r, int k) const { return bf2f(O0[(size_t)s * M * 512 + (size_t)r * 512 + k]); }
    __device__ float b(int s, int k, int c) const { return (s == 0 ? W0 : s == 1 ? W1 : W2)[(size_t)k * D + c]; }
    __device__ void epi(int r, int c, const float (&a)[3]) const { const bf16* gp = gz + (size_t)r * 3072 + c; const float v = bf2f(gp[0]) * a[0] + bf2f(gp[1024]) * a[1] + bf2f(gp[2048]) * a[2]; mg[(size_t)r * D + c] = f2bf(v); } };

__global__ void __launch_bounds__(256) n_ssq(const bf16* zc, const bf16* zkv, float* sq, float* skv) {
    const int i = blockIdx.x * 256 + threadIdx.x; if (i >= M * 20) return; const int r = i / 20, j = i % 20; float s = 0.f;
    if (j < 12) { for (int c = 0; c < 32; ++c) { const float v = bf2f(zc[(size_t)r * ZC_W + 32 * j + c]); s += v * v; } sq[(size_t)r * 12 + j] = s; }
    else { for (int c = 0; c < 32; ++c) { const float v = bf2f(zkv[(size_t)r * ZKV_W + 32 * (j - 12) + c]); s += v * v; } skv[(size_t)r * 8 + (j - 12)] = s; }
}
__global__ void __launch_bounds__(256) n_rope(bf16* Q, const bf16* zc, bf16* KR, const float* cs, const float* sn) {
    const int i = blockIdx.x * 256 + threadIdx.x; if (i >= M * 9 * 16) return; const int r = i / 144, h = (i % 144) / 16, j = i & 15;
    const float c = cs[r * 16 + j], s = sn[r * 16 + j];
    if (h < 8) { bf16* q = Q + (size_t)r * QW + 512 + 32 * h; const float x1 = bf2f(q[j]), x2 = bf2f(q[j + 16]); q[j] = f2bf(x1 * c - x2 * s); q[j + 16] = f2bf(x1 * s + x2 * c); }
    else { const bf16* z = zc + (size_t)r * ZC_W + ZC_KROPE; const float x1 = bf2f(z[j]), x2 = bf2f(z[j + 16]); KR[(size_t)r * 32 + j] = f2bf(x1 * c - x2 * s); KR[(size_t)r * 32 + j + 16] = f2bf(x1 * s + x2 * c); }
}
__global__ void __launch_bounds__(256) n_mla_attn(const bf16* Q, const bf16* KV, const bf16* KR, bf16* O) {
    const int i = blockIdx.x * 256 + threadIdx.x; const int sl = i & 3, q = (i >> 2) % SEQ, h = (i >> 2) / SEQ % 8, b = (i >> 2) / SEQ / 8; if (b >= NB) return;
    const size_t r = (size_t)b * SEQ + q; float qv[96];
#pragma unroll
    for (int d = 0; d < 64; ++d) qv[d] = bf2f(Q[r * QW + 64 * h + d]);
#pragma unroll
    for (int d = 0; d < 32; ++d) qv[64 + d] = bf2f(Q[r * QW + 512 + 32 * h + d]);
    float m = -INFINITY, l = 0.f, acc[16];
#pragma unroll
    for (int d = 0; d < 16; ++d) acc[d] = 0.f;
    for (int k = 0; k <= q; ++k) { const size_t kr = (size_t)b * SEQ + k; float s = 0.f;
#pragma unroll
        for (int d = 0; d < 64; ++d) s += qv[d] * bf2f(KV[kr * KVW + 64 * h + d]);
#pragma unroll
        for (int d = 0; d < 32; ++d) s += qv[64 + d] * bf2f(KR[kr * 32 + d]);
        const float mn = fmaxf(m, s), f = exp2f(m - mn), p = exp2f(s - mn); m = mn; l = l * f + p;
#pragma unroll
        for (int d = 0; d < 16; ++d) acc[d] = acc[d] * f + p * bf2f(KV[kr * KVW + 512 + 64 * h + 16 * sl + d]); }
    const float il = 1.f / l;
#pragma unroll
    for (int d = 0; d < 16; ++d) O[r * 512 + 64 * h + 16 * sl + d] = f2bf(acc[d] * il);
}
__global__ void __launch_bounds__(256) n_cross_attn(const bf16* XQ, const bf16* KVX, bf16* O) {
    const int i = blockIdx.x * 256 + threadIdx.x; const int sl = i & 3, q = (i >> 2) % SEQ, h = (i >> 2) / SEQ % 4, b = (i >> 2) / SEQ / 4; if (b >= NB) return;
    const size_t r = (size_t)b * SEQ + q; float qv[128];
#pragma unroll
    for (int d = 0; d < 128; ++d) qv[d] = bf2f(XQ[r * ZXQ_W + 128 * h + d]) * XSCALE;
    float m = -INFINITY, l = 0.f, acc[32];
#pragma unroll
    for (int d = 0; d < 32; ++d) acc[d] = 0.f;
    for (int k = 0; k < NMEM; ++k) { const size_t kr = (size_t)b * NMEM + k; float s = 0.f;
#pragma unroll
        for (int d = 0; d < 128; ++d) s += qv[d] * bf2f(KVX[kr * 1024 + 128 * h + d]);
        const float mn = fmaxf(m, s), f = exp2f(m - mn), p = exp2f(s - mn); m = mn; l = l * f + p;
#pragma unroll
        for (int d = 0; d < 32; ++d) acc[d] = acc[d] * f + p * bf2f(KVX[kr * 1024 + 512 + 128 * h + 32 * sl + d]); }
    const float il = 1.f / l;
#pragma unroll
    for (int d = 0; d < 32; ++d) O[r * 512 + 128 * h + 32 * sl + d] = f2bf(acc[d] * il);
}
__global__ void __launch_bounds__(128) n_gla_rec(const bf16* zc, const bf16* zg, const float* w_a2, const float* b_a, float* otmp) {
    __shared__ float a_s[64], k_s[64], q_s[64];
    const int b = blockIdx.x >> 2, h = blockIdx.x & 3, dv = threadIdx.x; float S[64];
#pragma unroll
    for (int d = 0; d < 64; ++d) S[d] = 0.f;
    for (int t = 0; t < SEQ; ++t) { const size_t r = (size_t)b * SEQ + t;
        if (dv < 64) { float pre = b_a[64 * h + dv];
            for (int j = 0; j < 16; ++j) pre += bf2f(zc[r * ZC_W + ZC_GA + j]) * w_a2[j * 256 + 64 * h + dv];
            const float ls = fminf(pre, 0.f) - log1pf(__expf(-fabsf(pre)));
            a_s[dv] = __expf(ls * (1.f / 16.f)); k_s[dv] = bf2f(zg[r * ZG_W + ZG_K + 64 * h + dv]); q_s[dv] = bf2f(zg[r * ZG_W + ZG_Q + 64 * h + dv]); }
        __syncthreads();
        const float v = bf2f(zg[r * ZG_W + ZG_V + 128 * h + dv]); float o = 0.f;
#pragma unroll
        for (int d = 0; d < 64; ++d) { S[d] = a_s[d] * S[d] + k_s[d] * v; o += q_s[d] * S[d]; }
        otmp[r * 512 + 128 * h + dv] = o * 0.125f;
        __syncthreads(); }
}
__global__ void __launch_bounds__(256) n_gla_fin(const float* otmp, const bf16* zg, const float* o_norm, bf16* O) {
    const int w = blockIdx.x * 4 + (threadIdx.x >> 6), lane = threadIdx.x & 63; if (w >= M * 4) return; const int r = w >> 2, h = w & 3;
    const float a = otmp[(size_t)r * 512 + 128 * h + lane], c = otmp[(size_t)r * 512 + 128 * h + 64 + lane]; float s = a * a + c * c;
#pragma unroll
    for (int o = 1; o < 64; o <<= 1) s += __shfl_xor(s, o);
    const float rs = rsqrtf(s * (1.f / 128.f) + EPS);
    const float r0 = bf2f(zg[(size_t)r * ZG_W + ZG_R + 128 * h + lane]), r1 = bf2f(zg[(size_t)r * ZG_W + ZG_R + 128 * h + 64 + lane]);
    O[(size_t)r * 512 + 128 * h + lane] = f2bf(a * rs * o_norm[lane] * silu_f(r0)); O[(size_t)r * 512 + 128 * h + 64 + lane] = f2bf(c * rs * o_norm[64 + lane] * silu_f(r1));
}


__global__ void __launch_bounds__(256) n_gate_fin(bf16* gz, const float* bias) { const size_t i = (size_t)blockIdx.x * 256 + threadIdx.x; gz[i] = f2bf(sigmoid_f(bf2f(gz[i]) + bias[i % 3072])); }
__global__ void __launch_bounds__(256) n_flush(const float* x, float* sink) { float s = 0.f; for (size_t i = (size_t)blockIdx.x * 256 + threadIdx.x; i < (size_t)M * D; i += (size_t)gridDim.x * 256) s += x[i]; if (s == 123.456f) sink[0] = s; }
namespace pg8 {
#define PG8_LAS __attribute__((address_space(3)))
typedef unsigned short bf16_t;
typedef short bf16x8 __attribute__((ext_vector_type(8)));
typedef float f32x4 __attribute__((ext_vector_type(4)));
typedef unsigned u32x4 __attribute__((ext_vector_type(4)));
typedef unsigned u32x2 __attribute__((ext_vector_type(2)));
constexpr int BM = 256, BK = 64, HALF = 128, HTB = HALF * BK * 2  , STAGE_BYTES = 8 * HTB, NXCD = 8, WGM = 8;

__host__ __device__ __forceinline__ int lds_byte(int r, int c) { const int st = (r >> 4) * 2 + (c >> 5), rr = r & 15, cc = c & 31, ob = rr * 64 + cc * 2; return st * 1024 + (ob ^ (((ob >> 9) & 1) << 5)); }
__host__ __device__ __forceinline__ void stage_rc(int b, int& R, int& C) { const int st = b / 1024, sb = b % 1024, swz = sb ^ (((sb >> 9) & 1) << 5); R = (st >> 1) * 16 + swz / 64; C = (st & 1) * 32 + (swz % 64) / 2; }
__host__ __device__ __forceinline__ int perm32(int rho) { const int n = rho >> 4, i = rho & 15; return 8 * (i >> 2) + 4 * n + (i & 3); }

struct Unit { int pm, pn, z; };
struct Gemm { const bf16_t* A; const bf16_t* Bt; size_t zA, zB; int lda, ldb, K, pad; };

__device__ __forceinline__ void tile_of(int L, int nM, int nN, Unit& u) {
    const int nwg = nM * nN; int wgid = L; { const int q = nwg / NXCD, r = nwg % NXCD, xcd = wgid % NXCD, off = wgid / NXCD; wgid = (xcd < r ? xcd * (q + 1) : r * (q + 1) + (xcd - r) * q) + off; }
    const int nig = WGM * nN, gid = wgid / nig, fm = gid * WGM, gsz = (nM - fm) < WGM ? (nM - fm) : WGM;
    u.pm = fm + ((wgid % nig) % gsz); u.pn = (wgid % nig) / gsz;
}
struct StaticOrder {
    int nM, nN, nwg, G, c;
    __device__ void init(int M_, int N_, int G_, int c_) { nM = M_ / BM; nN = N_ / BM; nwg = nM * nN; G = G_; c = c_; }
    __device__ bool next(int i, Unit& u) const { const long L = (long)i * G + c; if (L >= nwg) return false; tile_of((int)L, nM, nN, u); u.z = 0; return true; }
    __device__ __forceinline__ void a_ready(const Unit&) const {}
    __device__ __forceinline__ void done(const Unit&) const {}
};
struct MergeOrder {
    int nM, nN, nwg, G, c;
    __device__ void init(int M_, int N_, int G_, int c_) { nM = M_ / BM; nN = N_ / BM; nwg = nM * nN; G = G_; c = c_; }
    __device__ bool next(int i, Unit& u) const { const int r = i / 3; const long L = (long)r * G + c; if (L >= nwg) return false; tile_of((int)L, nM, nN, u); u.z = i - 3 * r; return true; }
    __device__ __forceinline__ void a_ready(const Unit&) const {}
    __device__ __forceinline__ void done(const Unit&) const {}
};

typedef float f32x2_t __attribute__((ext_vector_type(2))); typedef __bf16 bf16x2_t __attribute__((ext_vector_type(2)));
__device__ __forceinline__ unsigned cvt_pk_bf16(float lo, float hi) { f32x2_t v = {lo, hi}; bf16x2_t b = __builtin_convertvector(v, bf16x2_t); return __builtin_bit_cast(unsigned, b); }
__device__ __forceinline__ float fsig(float v) { return __builtin_amdgcn_rcpf(1.f + __builtin_amdgcn_exp2f(-1.4426950408889634f * v)); }
__device__ __forceinline__ f32x4 bfx4lo(u32x2 w) { return (f32x4){__uint_as_float(w.x << 16), __uint_as_float(w.x & 0xffff0000u), __uint_as_float(w.y << 16), __uint_as_float(w.y & 0xffff0000u)}; }
__device__ __forceinline__ u32x4 pack8(f32x4 v0, f32x4 v1) { u32x4 w; w.x = cvt_pk_bf16(v0[0], v0[1]); w.y = cvt_pk_bf16(v0[2], v0[3]); w.z = cvt_pk_bf16(v1[0], v1[1]); w.w = cvt_pk_bf16(v1[2], v1[3]); return w; }

struct EpiSwiGLU {
    static constexpr bool PERM = true, AFTER_DRAIN = false; bf16_t* O; int ldc, pad;
    __device__ __forceinline__ void operator()(const f32x4 (&acc)[2][2][4][2], const Unit& u, int wr, int wc, int fr, int fq) const {
        const int row0 = u.pm * BM + wr * 64 + fr, col0 = u.pn * HALF + wc * 32 + 8 * fq;
#pragma unroll
        for (int ai = 0; ai < 2; ++ai)
#pragma unroll
            for (int m = 0; m < 4; ++m) { f32x4 v[2];
#pragma unroll
                for (int n = 0; n < 2; ++n) { const f32x4 g = acc[ai][0][m][n], up = acc[ai][1][m][n];
#pragma unroll
                    for (int e = 0; e < 4; ++e) v[n][e] = g[e] * fsig(g[e]) * up[e]; }
                *(u32x4*)(O + (size_t)(row0 + ai * HALF + m * 16) * ldc + col0) = pack8(v[0], v[1]); }
    }
};
struct EpiResid {
    static constexpr bool PERM = true, AFTER_DRAIN = false; const float* base; float* out; float sc; int pad;
    __device__ __forceinline__ void operator()(const f32x4 (&acc)[2][2][4][2], const Unit& u, int wr, int wc, int fr, int fq) const {
        const int row0 = u.pm * BM + wr * 64 + fr, col0 = u.pn * BM + wc * 32 + 8 * fq;
#pragma unroll
        for (int ai = 0; ai < 2; ++ai)
#pragma unroll
            for (int m = 0; m < 4; ++m) {
#pragma unroll
                for (int bj = 0; bj < 2; ++bj) { const size_t off = (size_t)(row0 + ai * HALF + m * 16) * D + col0 + bj * HALF;
                    const f32x4 b0 = *(const f32x4*)(base + off), b1 = *(const f32x4*)(base + off + 4);
                    *(f32x4*)(out + off) = b0 + acc[ai][bj][m][0] * sc; *(f32x4*)(out + off + 4) = b1 + acc[ai][bj][m][1] * sc; }
                asm volatile("" ::: "memory"); }
    }
};
struct EpiZ1 {
    static constexpr bool PERM = true, AFTER_DRAIN = false; bf16_t *zc, *zkv, *zg, *zxq; float *ssqq, *ssqkv;
    __device__ __forceinline__ void operator()(const f32x4 (&acc)[2][2][4][2], const Unit& u, int wr, int wc, int fr, int fq) const {
        const int pn = u.pn; bf16_t* base; int ldc, cb;
        if (pn < 2) { base = zc; ldc = ZC_W; cb = 256 * pn; } else if (pn == 2) { base = zkv; ldc = ZKV_W; cb = 0; } else if (pn < 9) { base = zg; ldc = ZG_W; cb = 256 * (pn - 3); } else { base = zxq; ldc = ZXQ_W; cb = 256 * (pn - 9); }
        const int row0 = u.pm * BM + wr * 64 + fr, col0 = cb + wc * 32 + 8 * fq;
#pragma unroll
        for (int ai = 0; ai < 2; ++ai)
#pragma unroll
            for (int m = 0; m < 4; ++m) { const int row = row0 + ai * HALF + m * 16;
#pragma unroll
                for (int bj = 0; bj < 2; ++bj) *(u32x4*)(base + (size_t)row * ldc + col0 + bj * HALF) = pack8(acc[ai][bj][m][0], acc[ai][bj][m][1]);
                if (pn <= 2) {
#pragma unroll
                    for (int bj = 0; bj < 2; ++bj) { const f32x4 a = acc[ai][bj][m][0], b = acc[ai][bj][m][1];
                        float s = (a[0] * a[0] + a[1] * a[1]) + (a[2] * a[2] + a[3] * a[3]) + (b[0] * b[0] + b[1] * b[1]) + (b[2] * b[2] + b[3] * b[3]);
                        s += __shfl_xor(s, 16); s += __shfl_xor(s, 32);
                        if (fq == 0) { if (pn == 0) ssqq[(size_t)row * 12 + 4 * bj + wc] = s; else if (pn == 1) { if (bj == 0) ssqq[(size_t)row * 12 + 8 + wc] = s; } else ssqkv[(size_t)row * 8 + 4 * bj + wc] = s; } } } }
    }
};
struct EpiPlain {
    static constexpr bool PERM = true, AFTER_DRAIN = false; bf16_t* O; int ldc, pad;
    __device__ __forceinline__ void operator()(const f32x4 (&acc)[2][2][4][2], const Unit& u, int wr, int wc, int fr, int fq) const {
        const int row0 = u.pm * BM + wr * 64 + fr, col0 = u.pn * BM + wc * 32 + 8 * fq;
#pragma unroll
        for (int ai = 0; ai < 2; ++ai)
#pragma unroll
            for (int m = 0; m < 4; ++m)
#pragma unroll
                for (int bj = 0; bj < 2; ++bj) *(u32x4*)(O + (size_t)(row0 + ai * HALF + m * 16) * ldc + col0 + bj * HALF) = pack8(acc[ai][bj][m][0], acc[ai][bj][m][1]);
    }
};
struct EpiQ {
    static constexpr bool PERM = false, AFTER_DRAIN = false; bf16_t* Q; const float *ssq, *cs, *sn;
    __device__ __forceinline__ void operator()(const f32x4 (&acc)[2][2][4][2], const Unit& u, int wr, int wc, int fr, int fq) const {
#pragma unroll
        for (int ai = 0; ai < 2; ++ai)
#pragma unroll
            for (int m = 0; m < 4; ++m) { const int row = u.pm * BM + ai * HALF + wr * 64 + m * 16 + fr;
                const f32x4 s0 = *(const f32x4*)(ssq + (size_t)row * 12), s1 = *(const f32x4*)(ssq + (size_t)row * 12 + 4), s2 = *(const f32x4*)(ssq + (size_t)row * 12 + 8);
                const float ss = ((s0[0] + s0[1]) + (s0[2] + s0[3])) + ((s1[0] + s1[1]) + (s1[2] + s1[3])) + ((s2[0] + s2[1]) + (s2[2] + s2[3]));
                const float sc = rsqrtf(ss * (1.f / 384.f) + EPS) * QSCALE;
                if (u.pn < 2) {
#pragma unroll
                    for (int bj = 0; bj < 2; ++bj)
#pragma unroll
                        for (int n = 0; n < 2; ++n) { const f32x4 v = acc[ai][bj][m][n] * sc; u32x2 w; w.x = cvt_pk_bf16(v[0], v[1]); w.y = cvt_pk_bf16(v[2], v[3]);
                            *(u32x2*)(Q + (size_t)row * QW + u.pn * BM + bj * HALF + wc * 32 + 16 * n + 4 * fq) = w; }
                } else { const f32x4 c4 = *(const f32x4*)(cs + (size_t)row * 16 + 4 * fq), s4 = *(const f32x4*)(sn + (size_t)row * 16 + 4 * fq);
#pragma unroll
                    for (int bj = 0; bj < 2; ++bj) { const f32x4 x1 = acc[ai][bj][m][0] * sc, x2 = acc[ai][bj][m][1] * sc; const f32x4 o1 = x1 * c4 - x2 * s4, o2 = x1 * s4 + x2 * c4;
                        u32x2 w1, w2; w1.x = cvt_pk_bf16(o1[0], o1[1]); w1.y = cvt_pk_bf16(o1[2], o1[3]); w2.x = cvt_pk_bf16(o2[0], o2[1]); w2.y = cvt_pk_bf16(o2[2], o2[3]);
                        bf16_t* q = Q + (size_t)row * QW + 512 + bj * HALF + wc * 32 + 4 * fq; *(u32x2*)q = w1; *(u32x2*)(q + 16) = w2; } }
                asm volatile("" ::: "memory"); }
    }
};
struct EpiKV {
    static constexpr bool PERM = true, AFTER_DRAIN = false; bf16_t* O; const float* ssq;
    __device__ __forceinline__ void operator()(const f32x4 (&acc)[2][2][4][2], const Unit& u, int wr, int wc, int fr, int fq) const {
        const int row0 = u.pm * BM + wr * 64 + fr, col0 = u.pn * BM + wc * 32 + 8 * fq;
#pragma unroll
        for (int ai = 0; ai < 2; ++ai)
#pragma unroll
            for (int m = 0; m < 4; ++m) { const int row = row0 + ai * HALF + m * 16;
                const f32x4 s0 = *(const f32x4*)(ssq + (size_t)row * 8), s1 = *(const f32x4*)(ssq + (size_t)row * 8 + 4);
                const float sc = rsqrtf((((s0[0] + s0[1]) + (s0[2] + s0[3])) + ((s1[0] + s1[1]) + (s1[2] + s1[3]))) * (1.f / 256.f) + EPS);
#pragma unroll
                for (int bj = 0; bj < 2; ++bj) *(u32x4*)(O + (size_t)row * KVW + col0 + bj * HALF) = pack8(acc[ai][bj][m][0] * sc, acc[ai][bj][m][1] * sc);
                asm volatile("" ::: "memory"); }
    }
};
struct EpiGate {
    static constexpr bool PERM = true, AFTER_DRAIN = false; bf16_t* O; const float* bias;
    __device__ __forceinline__ void operator()(const f32x4 (&acc)[2][2][4][2], const Unit& u, int wr, int wc, int fr, int fq) const {
        const int row0 = u.pm * BM + wr * 64 + fr, col0 = u.pn * BM + wc * 32 + 8 * fq;
        f32x4 bv[2][2];
#pragma unroll
        for (int bj = 0; bj < 2; ++bj)
#pragma unroll
            for (int n = 0; n < 2; ++n) bv[bj][n] = *(const f32x4*)(bias + col0 + bj * HALF + 4 * n);
#pragma unroll
        for (int ai = 0; ai < 2; ++ai)
#pragma unroll
            for (int m = 0; m < 4; ++m)
#pragma unroll
                for (int bj = 0; bj < 2; ++bj) { f32x4 v[2];
#pragma unroll
                    for (int n = 0; n < 2; ++n) { const f32x4 t = acc[ai][bj][m][n] + bv[bj][n];
#pragma unroll
                        for (int e = 0; e < 4; ++e) v[n][e] = fsig(t[e]); }
                    *(u32x4*)(O + (size_t)(row0 + ai * HALF + m * 16) * 3072 + col0 + bj * HALF) = pack8(v[0], v[1]); }
    }
};
struct EpiMerge {
    static constexpr bool PERM = true, AFTER_DRAIN = false; bf16_t* MG; const bf16_t* gz;
    __device__ __forceinline__ void operator()(const f32x4 (&acc)[2][2][4][2], const Unit& u, int wr, int wc, int fr, int fq) const {
        const int row0 = u.pm * BM + wr * 64 + fr, col0 = u.pn * BM + wc * 32 + 8 * fq;
#pragma unroll
        for (int ai = 0; ai < 2; ++ai)
#pragma unroll
            for (int m = 0; m < 4; ++m) {
#pragma unroll
                for (int bj = 0; bj < 2; ++bj) { const int row = row0 + ai * HALF + m * 16, col = col0 + bj * HALF;
                    const u32x4 gw = *(const u32x4*)(gz + (size_t)row * 3072 + 1024 * u.z + col);
                    f32x4 v0 = bfx4lo((u32x2){gw.x, gw.y}) * acc[ai][bj][m][0], v1 = bfx4lo((u32x2){gw.z, gw.w}) * acc[ai][bj][m][1];
                    bf16_t* mp = MG + (size_t)row * D + col;
                    if (u.z > 0) {
                        const unsigned long long o0 = __hip_atomic_load((const unsigned long long*)mp, __ATOMIC_RELAXED, __HIP_MEMORY_SCOPE_AGENT), o1 = __hip_atomic_load((const unsigned long long*)mp + 1, __ATOMIC_RELAXED, __HIP_MEMORY_SCOPE_AGENT);
                        v0 += bfx4lo((u32x2){(unsigned)o0, (unsigned)(o0 >> 32)}); v1 += bfx4lo((u32x2){(unsigned)o1, (unsigned)(o1 >> 32)}); }
                    *(u32x4*)mp = pack8(v0, v1); }
                asm volatile("" ::: "memory"); }
    }
};

template <class Epi, class Sched, bool ALIGN_EPI = false, bool SP2 = false>
__device__ __forceinline__ void gemm_phase(PG8_LAS unsigned char* lds, const Gemm g, const Sched& S, const Epi& E) {
    const int tid = threadIdx.x, wid = __builtin_amdgcn_readfirstlane(tid >> 6), lane = tid & 63, wr = wid >> 2, wc = wid & 3, fr = lane & 15, fq = lane >> 4;
    const int K = g.K, nt = K / BK;
    unsigned voffA[2], voffB[2];
#pragma unroll
    for (int i = 0; i < 2; ++i) { int R, C; stage_rc(tid * 16 + i * 8192, R, C); const int Rb = Epi::PERM ? ((R & ~31) + perm32(R & 31)) : R;
        voffA[i] = (unsigned)(R * g.lda + C) * 2u; voffB[i] = (unsigned)(Rb * g.ldb + C) * 2u; }
    const size_t kstep = (size_t)(BK * 2);
    const size_t hstepA = (size_t)HALF * g.lda * 2, hstepB = (size_t)HALF * g.ldb * 2;
    const size_t tstepA = 2 * hstepA, tstepB = 2 * hstepB;
    const unsigned ldsw = (unsigned)wid * 1024u;
    const int aoff = lds_byte(wr * 64 + fr, fq * 8), boff = lds_byte(wc * 32 + fr, fq * 8);
#define PG8_SA(b, h) (((b) * 2 + (h)) * HTB)
#define PG8_SB(b, h) ((4 + (b) * 2 + (h)) * HTB)
#define PG8_STAGE(bufoff, gbase, voff) do { _Pragma("unroll") for (int _i = 0; _i < 2; ++_i) \
        __builtin_amdgcn_global_load_lds((const unsigned*)((const char*)(gbase) + (voff)[_i]), (PG8_LAS unsigned*)(lds + (bufoff) + ldsw + _i * 8192), 16, 0, 0); } while (0)
#define PG8_LDA(dst, b, h) do { _Pragma("unroll") for (int m = 0; m < 4; ++m) _Pragma("unroll") for (int k = 0; k < 2; ++k) dst[m][k] = *(const PG8_LAS bf16x8*)(lds + PG8_SA(b, h) + aoff + m * 2048 + k * 1024); } while (0)
#define PG8_LDB(dst, b, h) do { _Pragma("unroll") for (int n = 0; n < 2; ++n) _Pragma("unroll") for (int k = 0; k < 2; ++k) dst[n][k] = *(const PG8_LAS bf16x8*)(lds + PG8_SB(b, h) + boff + n * 2048 + k * 1024); } while (0)
#define PG8_MMA(ai, bj, At, Bt) do { __builtin_amdgcn_s_setprio(1); _Pragma("unroll") for (int m = 0; m < 4; ++m) _Pragma("unroll") for (int n = 0; n < 2; ++n) _Pragma("unroll") for (int k = 0; k < 2; ++k) \
        acc[ai][bj][m][n] = __builtin_amdgcn_mfma_f32_16x16x32_bf16(Bt[n][k], At[m][k], acc[ai][bj][m][n], 0, 0, 0); __builtin_amdgcn_s_setprio(0); } while (0)
#define PG8_WAIT_V(n) asm volatile("s_waitcnt vmcnt(" #n ")" ::: "memory")
#define PG8_WAIT_L(n) asm volatile("s_waitcnt lgkmcnt(" #n ")" ::: "memory")
#define PG8_BAR __builtin_amdgcn_s_barrier()
#define PG8_SCHED __builtin_amdgcn_sched_barrier(0)
    Unit cur, nxt; int ui = 0;
    if (!S.next(0, cur)) return;
    f32x4 acc[2][2][4][2];
#pragma unroll
    for (int a = 0; a < 2; ++a)
#pragma unroll
        for (int b = 0; b < 2; ++b)
#pragma unroll
            for (int m = 0; m < 4; ++m)
#pragma unroll
                for (int n = 0; n < 2; ++n) acc[a][b][m][n] = (f32x4){0.f, 0.f, 0.f, 0.f};
    bf16x8 At[4][2], B0[2][2], B1[2][2];
    const char* cA = (const char*)g.A + (size_t)cur.z * g.zA + (size_t)cur.pm * tstepA; const char* cB = (const char*)g.Bt + (size_t)cur.z * g.zB + (size_t)cur.pn * tstepB;
    S.a_ready(cur);
    if constexpr (SP2) {
        PG8_STAGE(PG8_SB(0, 0), cB, voffB); PG8_STAGE(PG8_SB(0, 1), cB + hstepB, voffB); PG8_STAGE(PG8_SA(0, 0), cA, voffA); PG8_STAGE(PG8_SA(0, 1), cA + hstepA, voffA);
        if (wr == 1) PG8_BAR;
        PG8_WAIT_V(2); PG8_BAR;
        PG8_STAGE(PG8_SB(1, 0), cB + kstep, voffB); PG8_STAGE(PG8_SA(1, 0), cA + kstep, voffA); PG8_STAGE(PG8_SB(1, 1), cB + hstepB + kstep, voffB);
        PG8_WAIT_V(6); PG8_BAR;
    } else {
        PG8_STAGE(PG8_SB(0, 0), cB, voffB); PG8_STAGE(PG8_SA(0, 0), cA, voffA); PG8_STAGE(PG8_SB(0, 1), cB + hstepB, voffB); PG8_STAGE(PG8_SA(0, 1), cA + hstepA, voffA);
        if (wr == 1) PG8_BAR;
        PG8_WAIT_V(4); PG8_BAR;
        PG8_STAGE(PG8_SB(1, 0), cB + kstep, voffB); PG8_STAGE(PG8_SA(1, 0), cA + kstep, voffA); PG8_STAGE(PG8_SB(1, 1), cB + hstepB + kstep, voffB);
        PG8_WAIT_V(6); PG8_BAR;
    }
    for (;;) {
        const bool has_next = S.next(ui + 1, nxt);
        const char* nA = has_next ? (const char*)g.A + (size_t)nxt.z * g.zA + (size_t)nxt.pm * tstepA : cA; const char* nB = has_next ? (const char*)g.Bt + (size_t)nxt.z * g.zB + (size_t)nxt.pn * tstepB : cB;
#pragma unroll 1
        for (int t = 0; t < nt; t += 2) {
            const bool last = (t == nt - 2);
            const char* a1 = cA + (size_t)(t + 1) * kstep;
            const char* a2 = last ? nA : cA + (size_t)(t + 2) * kstep; const char* b2 = last ? nB : cB + (size_t)(t + 2) * kstep;
            const char* a3 = a2 + kstep; const char* b3 = b2 + kstep;
            if (last && has_next) S.a_ready(nxt);
            if constexpr (SP2) {
            PG8_LDB(B0, 0, 0); PG8_LDB(B1, 0, 1); PG8_SCHED; PG8_LDA(At, 0, 0); PG8_STAGE(PG8_SA(1, 1), a1 + hstepA, voffA);
            PG8_WAIT_V(8); PG8_WAIT_L(0); PG8_BAR; PG8_MMA(0, 0, At, B0); PG8_MMA(0, 1, At, B1); PG8_BAR; PG8_SCHED;
            PG8_LDA(At, 0, 1); PG8_STAGE(PG8_SB(0, 0), b2, voffB); PG8_STAGE(PG8_SB(0, 1), b2 + hstepB, voffB); PG8_STAGE(PG8_SA(0, 0), a2, voffA);
            PG8_WAIT_V(8); PG8_WAIT_L(0); PG8_BAR; PG8_MMA(1, 0, At, B0); PG8_MMA(1, 1, At, B1); PG8_BAR; PG8_SCHED;
            PG8_LDB(B0, 1, 0); PG8_LDB(B1, 1, 1); PG8_SCHED; PG8_LDA(At, 1, 0); PG8_STAGE(PG8_SA(0, 1), a2 + hstepA, voffA);
            PG8_WAIT_V(8); PG8_WAIT_L(0); PG8_BAR; PG8_MMA(0, 0, At, B0); PG8_MMA(0, 1, At, B1); PG8_BAR; PG8_SCHED;
            PG8_LDA(At, 1, 1); PG8_STAGE(PG8_SB(1, 0), b3, voffB); PG8_STAGE(PG8_SB(1, 1), b3 + hstepB, voffB); PG8_STAGE(PG8_SA(1, 0), a3, voffA);
            PG8_WAIT_V(8); PG8_WAIT_L(0); PG8_BAR; PG8_MMA(1, 0, At, B0); PG8_MMA(1, 1, At, B1); PG8_BAR; PG8_SCHED;
            } else {
            PG8_LDB(B0, 0, 0); PG8_SCHED; PG8_LDA(At, 0, 0); PG8_STAGE(PG8_SA(1, 1), a1 + hstepA, voffA);
            PG8_WAIT_L(8); PG8_BAR; PG8_WAIT_L(0); PG8_MMA(0, 0, At, B0); PG8_BAR; PG8_SCHED;
            PG8_LDB(B1, 0, 1); PG8_STAGE(PG8_SB(0, 0), b2, voffB);
            PG8_BAR; PG8_WAIT_L(0); PG8_MMA(0, 1, At, B1); PG8_BAR;
            PG8_LDA(At, 0, 1); PG8_STAGE(PG8_SA(0, 0), a2, voffA);
            PG8_BAR; PG8_WAIT_L(0); PG8_MMA(1, 0, At, B0); PG8_BAR; PG8_SCHED;
            PG8_STAGE(PG8_SB(0, 1), b2 + hstepB, voffB);
            PG8_WAIT_V(6); PG8_BAR; PG8_MMA(1, 1, At, B1); PG8_BAR;
            PG8_LDB(B0, 1, 0); PG8_SCHED; PG8_LDA(At, 1, 0); PG8_STAGE(PG8_SA(0, 1), a2 + hstepA, voffA);
            PG8_WAIT_L(8); PG8_BAR; PG8_WAIT_L(0); PG8_MMA(0, 0, At, B0); PG8_BAR; PG8_SCHED;
            PG8_LDB(B1, 1, 1); PG8_STAGE(PG8_SB(1, 0), b3, voffB);
            PG8_BAR; PG8_WAIT_L(0); PG8_MMA(0, 1, At, B1); PG8_BAR;
            PG8_LDA(At, 1, 1); PG8_STAGE(PG8_SA(1, 0), a3, voffA);
            PG8_BAR; PG8_WAIT_L(0); PG8_MMA(1, 0, At, B0); PG8_BAR; PG8_SCHED;
            PG8_STAGE(PG8_SB(1, 1), b3 + hstepB, voffB);
            PG8_WAIT_V(6); PG8_BAR; PG8_MMA(1, 1, At, B1); PG8_BAR;
            }
        }
        if constexpr (ALIGN_EPI) { if (wr == 0) PG8_BAR; }
        if constexpr (!Epi::AFTER_DRAIN) { E(acc, cur, wr, wc, fr, fq); S.done(cur); }
        if (!has_next) break;
#pragma unroll
        for (int a = 0; a < 2; ++a)
#pragma unroll
            for (int b = 0; b < 2; ++b)
#pragma unroll
                for (int m = 0; m < 4; ++m)
#pragma unroll
                    for (int n = 0; n < 2; ++n) acc[a][b][m][n] = (f32x4){0.f, 0.f, 0.f, 0.f};
        cur = nxt; cA = nA; cB = nB; ++ui;
        if constexpr (ALIGN_EPI) { if (wr == 1) PG8_BAR; }
    }
    PG8_WAIT_V(0);
    if constexpr (!ALIGN_EPI) { if (wr == 0) PG8_BAR; }
    PG8_BAR;
    if constexpr (Epi::AFTER_DRAIN) { E.fused(acc, cur, wr, wc, fr, fq, lds, wid, lane); S.done(cur); }
#undef PG8_SA
#undef PG8_SB
#undef PG8_STAGE
#undef PG8_LDA
#undef PG8_LDB
#undef PG8_MMA
#undef PG8_WAIT_V
#undef PG8_WAIT_L
#undef PG8_BAR
#undef PG8_SCHED
}
}


namespace att {
typedef short bf16x8 __attribute__((ext_vector_type(8)));
typedef short bf16x4 __attribute__((ext_vector_type(4)));
typedef float f32x16 __attribute__((ext_vector_type(16)));
typedef unsigned u32x4 __attribute__((ext_vector_type(4)));
#define ALAS __attribute__((address_space(3)))
__device__ __forceinline__ int crow(int r, int hi) { return (r & 3) + 8 * (r >> 2) + 4 * hi; }
__device__ __forceinline__ unsigned pk(float lo, float hi) { return pg8::cvt_pk_bf16(lo, hi); }
__device__ __forceinline__ float swap_max(float v) { auto rr = __builtin_amdgcn_permlane32_swap(__float_as_uint(v), __float_as_uint(v), false, false); return fmaxf(__uint_as_float(rr[0]), __uint_as_float(rr[1])); }
__device__ __forceinline__ float swap_add(float v) { auto rr = __builtin_amdgcn_permlane32_swap(__float_as_uint(v), __float_as_uint(v), false, false); return __uint_as_float(rr[0]) + __uint_as_float(rr[1]); }
__device__ __forceinline__ bf16x8 pack8r(const f32x16& p, int b) {
    u32x4 w; w.x = pk(p[b], p[b + 1]); w.y = pk(p[b + 2], p[b + 3]); w.z = pk(p[b + 4], p[b + 5]); w.w = pk(p[b + 6], p[b + 7]); return __builtin_bit_cast(bf16x8, w); }

template <class T> __device__ __forceinline__ void attn_unit(ALAS unsigned char* lds, const T& t, int b, int qb) {
    constexpr int NDS = T::NDS, NDH = T::NDH, KP = NDS * 32 + 16, VP = 136, KB = 64 * KP, VB = NDH * 32 * VP, NKC = NDS * 2, NVC = NDH * 4;
    const int tid = threadIdx.x, lane = tid & 63, r = lane & 31, h = lane >> 5, w = __builtin_amdgcn_readfirstlane(tid >> 6);
    ALAS unsigned char* Kl = lds; ALAS unsigned char* Vl = lds + 2 * KB; ALAS float* wsc = (ALAS float*)(lds + 2 * KB + 2 * VB) + 32 * w;
    const int q0 = qb * 256; const size_t qrow = (size_t)b * SEQ + q0 + 32 * w + r;
    bf16x8 qf[NDS];
#pragma unroll
    for (int d0 = 0; d0 < NDS; ++d0) qf[d0] = *(const bf16x8*)t.qptr(qrow, d0, h);
    const int NT = T::CAUSAL ? 4 * qb + 4 : T::NKV / 64; const int my_last = T::CAUSAL ? 4 * qb + (w >> 1) : NT - 1;
    const size_t kvrow0 = (size_t)b * (T::CAUSAL ? SEQ : T::NKV) + lane;
    f32x16 o[NDH];
#pragma unroll
    for (int dh = 0; dh < NDH; ++dh)
#pragma unroll
        for (int i = 0; i < 16; ++i) o[dh][i] = 0.f;
    float m = -1e30f, l = 0.f;
    u32x4 kreg[2], vreg[2];
#define ATT_LOAD(tile) do { const size_t kr_ = kvrow0 + (size_t)(tile) * 64; \
        _Pragma("unroll") for (int i_ = 0; i_ < 2; ++i_) { if (w + 8 * i_ < NKC) kreg[i_] = *(const u32x4*)t.kchunk(kr_, w + 8 * i_); if (w + 8 * i_ < NVC) vreg[i_] = *(const u32x4*)t.vchunk(kr_, w + 8 * i_); } } while (0)
#define ATT_WRITE(buf) do { ALAS unsigned char* kb_ = Kl + (buf) * KB; ALAS unsigned char* vb_ = Vl + (buf) * VB; \
        _Pragma("unroll") for (int i_ = 0; i_ < 2; ++i_) { if (w + 8 * i_ < NKC) *(ALAS u32x4*)(kb_ + lane * KP + (w + 8 * i_) * 16) = kreg[i_]; \
            if (w + 8 * i_ < NVC) { const u32x4 v_ = vreg[i_]; ALAS unsigned short* vp_ = (ALAS unsigned short*)(vb_ + (8 * (w + 8 * i_)) * VP + lane * 2); \
                vp_[0 * (VP / 2)] = (unsigned short)(v_.x & 0xffff); vp_[1 * (VP / 2)] = (unsigned short)(v_.x >> 16); vp_[2 * (VP / 2)] = (unsigned short)(v_.y & 0xffff); vp_[3 * (VP / 2)] = (unsigned short)(v_.y >> 16); \
                vp_[4 * (VP / 2)] = (unsigned short)(v_.z & 0xffff); vp_[5 * (VP / 2)] = (unsigned short)(v_.z >> 16); vp_[6 * (VP / 2)] = (unsigned short)(v_.w & 0xffff); vp_[7 * (VP / 2)] = (unsigned short)(v_.w >> 16); } } } while (0)
    ATT_LOAD(0); ATT_WRITE(0); __syncthreads();
    for (int tile = 0; tile < NT; ++tile) {
        const bool more = tile + 1 < NT;
        if (more) ATT_LOAD(tile + 1);
        if (tile <= my_last) {
            const ALAS unsigned char* Kb = Kl + (tile & 1) * KB; const ALAS unsigned char* Vb = Vl + (tile & 1) * VB;
            f32x16 p0, p1;
#pragma unroll
            for (int i = 0; i < 16; ++i) { p0[i] = 0.f; p1[i] = 0.f; }
#pragma unroll
            for (int d0 = 0; d0 < NDS; ++d0) { const bf16x8 a0 = *(const ALAS bf16x8*)(Kb + r * KP + (16 * d0 + 8 * h) * 2), a1 = *(const ALAS bf16x8*)(Kb + (32 + r) * KP + (16 * d0 + 8 * h) * 2);
                p0 = __builtin_amdgcn_mfma_f32_32x32x16_bf16(a0, qf[d0], p0, 0, 0, 0); p1 = __builtin_amdgcn_mfma_f32_32x32x16_bf16(a1, qf[d0], p1, 0, 0, 0); }
            if (T::SCALE != 1.0f) {
#pragma unroll
                for (int i = 0; i < 16; ++i) { p0[i] *= T::SCALE; p1[i] *= T::SCALE; } }
            if (T::CAUSAL && tile >= 4 * qb) { const int qi = q0 + 32 * w + r, kb0 = 64 * tile;
#pragma unroll
                for (int i = 0; i < 16; ++i) { const int kv = kb0 + crow(i, h); if (kv > qi) p0[i] = -1e30f; if (kv + 32 > qi) p1[i] = -1e30f; } }
            float mx = fmaxf(p0[0], p1[0]);
#pragma unroll
            for (int i = 1; i < 16; ++i) mx = fmaxf(mx, fmaxf(p0[i], p1[i]));
            mx = swap_max(mx);
            const float mn = fmaxf(m, mx);
            if (__any(mn > m)) { const float alpha = __builtin_amdgcn_exp2f(m - mn); l *= alpha; m = mn;
                if (h == 0) wsc[r] = alpha;
#pragma unroll
                for (int i = 0; i < 16; ++i) { const float f = wsc[crow(i, h)];
#pragma unroll
                    for (int dh = 0; dh < NDH; ++dh) o[dh][i] *= f; } }
            float ls = 0.f;
#pragma unroll
            for (int i = 0; i < 16; ++i) { p0[i] = __builtin_amdgcn_exp2f(p0[i] - m); p1[i] = __builtin_amdgcn_exp2f(p1[i] - m); ls += p0[i] + p1[i]; }
            l += ls;
            bf16x8 pa[4]; pa[0] = pack8r(p0, 0); pa[1] = pack8r(p0, 8); pa[2] = pack8r(p1, 0); pa[3] = pack8r(p1, 8);
#pragma unroll
            for (int dh = 0; dh < NDH; ++dh)
#pragma unroll
                for (int ks = 0; ks < 4; ++ks) { const ALAS unsigned char* vp = Vb + (32 * dh + r) * VP + (16 * ks + 4 * h) * 2;
                    const bf16x4 lo = *(const ALAS bf16x4*)vp, hi = *(const ALAS bf16x4*)(vp + 16);
                    const bf16x8 vb = {lo[0], lo[1], lo[2], lo[3], hi[0], hi[1], hi[2], hi[3]};
                    o[dh] = __builtin_amdgcn_mfma_f32_32x32x16_bf16(pa[ks], vb, o[dh], 0, 0, 0); }
        }
        if (more) ATT_WRITE((tile + 1) & 1);
        __syncthreads();
    }
#undef ATT_LOAD
#undef ATT_WRITE
    l = swap_add(l);
    if (h == 0) wsc[r] = 1.f / l;
#pragma unroll
    for (int i = 0; i < 16; ++i) { const float f = wsc[crow(i, h)]; bf16* op = t.optr((size_t)b * SEQ + q0 + 32 * w + crow(i, h));
#pragma unroll
        for (int dh = 0; dh < NDH; ++dh) op[32 * dh + r] = f2bf(o[dh][i] * f); }
}
struct MlaT { static constexpr int NDS = 6, NDH = 2, NKV = SEQ; static constexpr bool CAUSAL = true; static constexpr float SCALE = 1.0f;
    const bf16 *Q, *KV, *KR; bf16* O; int head, pad;
    __device__ __forceinline__ const bf16* qptr(size_t row, int d0, int h) const { return d0 < 4 ? Q + row * QW + 64 * head + 16 * d0 + 8 * h : Q + row * QW + 512 + 32 * head + 16 * (d0 - 4) + 8 * h; }
    __device__ __forceinline__ const bf16* kchunk(size_t row, int c) const { return c < 8 ? KV + row * KVW + 64 * head + 8 * c : KR + row * 32 + 8 * (c - 8); }
    __device__ __forceinline__ const bf16* vchunk(size_t row, int c) const { return KV + row * KVW + 512 + 64 * head + 8 * c; }
    __device__ __forceinline__ bf16* optr(size_t row) const { return O + row * 512 + 64 * head; } };
struct CrossT { static constexpr int NDS = 8, NDH = 4, NKV = NMEM; static constexpr bool CAUSAL = false; static constexpr float SCALE = XSCALE;
    const bf16 *Q, *KV; bf16* O; int head, pad;
    __device__ __forceinline__ const bf16* qptr(size_t row, int d0, int h) const { return Q + row * ZXQ_W + 128 * head + 16 * d0 + 8 * h; }
    __device__ __forceinline__ const bf16* kchunk(size_t row, int c) const { return KV + row * 1024 + 128 * head + 8 * c; }
    __device__ __forceinline__ const bf16* vchunk(size_t row, int c) const { return KV + row * 1024 + 512 + 128 * head + 8 * c; }
    __device__ __forceinline__ bf16* optr(size_t row) const { return O + row * 512 + 128 * head; } };

constexpr int G_W = 0, G_B = 4096, G_LA = 4352, G_SEG = G_LA + 64 * 65 * 4, G_QT = G_SEG + 8 * 64 * 4, G_KT = G_QT + 64 * 144, G_VT = G_KT + 64 * 144, G_OT = G_VT + 128 * 144, G_END = G_OT + 64 * 132 * 4;
static_assert(G_END <= 131072 && (G_QT % 16) == 0 && (G_OT % 16) == 0, "gla lds map");
__device__ __forceinline__ void gla_load_w(ALAS unsigned char* lds, const float* w_a2, const float* b_a, int h) {
    ALAS float* W = (ALAS float*)(lds + G_W); ALAS float* Bv = (ALAS float*)(lds + G_B); const int tid = threadIdx.x;
    for (int i = tid; i < 1024; i += 512) W[i] = w_a2[(i >> 6) * 256 + 64 * h + (i & 63)];
    if (tid < 64) Bv[tid] = b_a[64 * h + tid];
}
__device__ __forceinline__ void gla_bcum(ALAS unsigned char* lds, const bf16* zc, size_t row0) {
    const ALAS float* W = (const ALAS float*)(lds + G_W); const ALAS float* Bv = (const ALAS float*)(lds + G_B); ALAS float* LA = (ALAS float*)(lds + G_LA); ALAS float* SEGS = (ALAS float*)(lds + G_SEG);
    const int tid = threadIdx.x; { const int t = tid >> 3, db = tid & 7;
        const u32x4 g0 = *(const u32x4*)(zc + (row0 + t) * ZC_W + ZC_GA), g1 = *(const u32x4*)(zc + (row0 + t) * ZC_W + ZC_GA + 8);
        float ga[16]; ga[0] = __uint_as_float(g0.x << 16); ga[1] = __uint_as_float(g0.x & 0xffff0000u); ga[2] = __uint_as_float(g0.y << 16); ga[3] = __uint_as_float(g0.y & 0xffff0000u);
        ga[4] = __uint_as_float(g0.z << 16); ga[5] = __uint_as_float(g0.z & 0xffff0000u); ga[6] = __uint_as_float(g0.w << 16); ga[7] = __uint_as_float(g0.w & 0xffff0000u);
        ga[8] = __uint_as_float(g1.x << 16); ga[9] = __uint_as_float(g1.x & 0xffff0000u); ga[10] = __uint_as_float(g1.y << 16); ga[11] = __uint_as_float(g1.y & 0xffff0000u);
        ga[12] = __uint_as_float(g1.z << 16); ga[13] = __uint_as_float(g1.z & 0xffff0000u); ga[14] = __uint_as_float(g1.w << 16); ga[15] = __uint_as_float(g1.w & 0xffff0000u);
#pragma unroll
        for (int e = 0; e < 8; ++e) { const int d = 8 * db + e; float pre = Bv[d];
#pragma unroll
            for (int j = 0; j < 16; ++j) pre += ga[j] * W[j * 64 + d];
            LA[t * 65 + d] = (fminf(pre, 0.f) - __logf(1.f + __expf(-fabsf(pre)))) * (1.f / 16.f); } }
    __syncthreads();
    const int d = tid & 63, sg = tid >> 6; float v[8];
#pragma unroll
    for (int i = 0; i < 8; ++i) v[i] = LA[(8 * sg + i) * 65 + d];
#pragma unroll
    for (int i = 1; i < 8; ++i) v[i] += v[i - 1];
    SEGS[sg * 64 + d] = v[7];
    __syncthreads();
    float off = 0.f;
#pragma unroll
    for (int s2 = 0; s2 < 7; ++s2) off += (s2 < sg) ? SEGS[s2 * 64 + d] : 0.f;
#pragma unroll
    for (int i = 0; i < 8; ++i) LA[(8 * sg + i) * 65 + d] = v[i] + off;
    __syncthreads();
}
__device__ __forceinline__ void gla_stage_vt(ALAS unsigned char* lds, const bf16* zg, size_t row0, int h) {
    const int tid = threadIdx.x, lane = tid & 63, w = tid >> 6;
#pragma unroll
    for (int i = 0; i < 2; ++i) { const int c = w + 8 * i; const u32x4 v = *(const u32x4*)(zg + (row0 + lane) * ZG_W + ZG_V + 128 * h + 8 * c);
        ALAS unsigned short* vp = (ALAS unsigned short*)(lds + G_VT + (8 * c) * 144 + lane * 2);
        vp[0 * 72] = (unsigned short)(v.x & 0xffff); vp[1 * 72] = (unsigned short)(v.x >> 16); vp[2 * 72] = (unsigned short)(v.y & 0xffff); vp[3 * 72] = (unsigned short)(v.y >> 16);
        vp[4 * 72] = (unsigned short)(v.z & 0xffff); vp[5 * 72] = (unsigned short)(v.z >> 16); vp[6 * 72] = (unsigned short)(v.w & 0xffff); vp[7 * 72] = (unsigned short)(v.w >> 16); }
}
__device__ __forceinline__ void gla_pass_a(ALAS unsigned char* lds, const bf16* zc, const bf16* zg, float* DS, float* DEC, int b, int h, int n) {
    const int tid = threadIdx.x, lane = tid & 63, r = lane & 31, hh = lane >> 5, w = __builtin_amdgcn_readfirstlane(tid >> 6); const size_t row0 = (size_t)b * SEQ + 64 * n;
    gla_bcum(lds, zc, row0);
    const ALAS float* LA = (const ALAS float*)(lds + G_LA);
    { const int t = tid >> 3, db = tid & 7; const u32x4 kk = *(const u32x4*)(zg + (row0 + t) * ZG_W + ZG_K + 64 * h + 8 * db);
      float kf[8]; kf[0] = __uint_as_float(kk.x << 16); kf[1] = __uint_as_float(kk.x & 0xffff0000u); kf[2] = __uint_as_float(kk.y << 16); kf[3] = __uint_as_float(kk.y & 0xffff0000u);
      kf[4] = __uint_as_float(kk.z << 16); kf[5] = __uint_as_float(kk.z & 0xffff0000u); kf[6] = __uint_as_float(kk.w << 16); kf[7] = __uint_as_float(kk.w & 0xffff0000u);
#pragma unroll
      for (int e = 0; e < 8; ++e) { const int d = 8 * db + e; const float kd = kf[e] * __expf(LA[63 * 65 + d] - LA[t * 65 + d]); *(ALAS unsigned short*)(lds + G_KT + d * 144 + t * 2) = f2bf(kd); } }
    gla_stage_vt(lds, zg, row0, h);
    __syncthreads();
    const int dvt = w >> 1, dt = w & 1; f32x16 acc;
#pragma unroll
    for (int i = 0; i < 16; ++i) acc[i] = 0.f;
#pragma unroll
    for (int ks = 0; ks < 4; ++ks) { const bf16x8 a = *(const ALAS bf16x8*)(lds + G_VT + (32 * dvt + r) * 144 + (16 * ks + 8 * hh) * 2), bb = *(const ALAS bf16x8*)(lds + G_KT + (32 * dt + r) * 144 + (16 * ks + 8 * hh) * 2);
        acc = __builtin_amdgcn_mfma_f32_32x32x16_bf16(a, bb, acc, 0, 0, 0); }
    float* dsp = DS + ((size_t)((b * 4 + h) * GLA_N + n) * 128) * 64;
#pragma unroll
    for (int i = 0; i < 16; ++i) dsp[(32 * dvt + crow(i, hh)) * 64 + 32 * dt + r] = acc[i];
    if (tid < 64) DEC[(size_t)((b * 4 + h) * GLA_N + n) * 64 + tid] = __expf(LA[63 * 65 + tid]);
    __syncthreads();
}
__device__ __forceinline__ void gla_pass_c(ALAS unsigned char* lds, const bf16* zc, const bf16* zg, const bf16* SPREV, const float* o_norm, bf16* OG, int b, int h, int n) {
    const int tid = threadIdx.x, lane = tid & 63, r = lane & 31, hh = lane >> 5, w = __builtin_amdgcn_readfirstlane(tid >> 6); const size_t row0 = (size_t)b * SEQ + 64 * n;
    gla_bcum(lds, zc, row0);
    const ALAS float* LA = (const ALAS float*)(lds + G_LA);
    { const int t = tid >> 3, db = tid & 7; const u32x4 qq = *(const u32x4*)(zg + (row0 + t) * ZG_W + ZG_Q + 64 * h + 8 * db), kk = *(const u32x4*)(zg + (row0 + t) * ZG_W + ZG_K + 64 * h + 8 * db);
      const unsigned qw[4] = {qq.x, qq.y, qq.z, qq.w}, kw[4] = {kk.x, kk.y, kk.z, kk.w}; unsigned qo[4], ko[4];
#pragma unroll
      for (int e = 0; e < 4; ++e) { const float b0 = LA[t * 65 + 8 * db + 2 * e], b1 = LA[t * 65 + 8 * db + 2 * e + 1]; const float e0 = __expf(b0), e1 = __expf(b1), i0 = __expf(-b0), i1 = __expf(-b1);
          qo[e] = pk(__uint_as_float(qw[e] << 16) * 0.125f * e0, __uint_as_float(qw[e] & 0xffff0000u) * 0.125f * e1); ko[e] = pk(__uint_as_float(kw[e] << 16) * i0, __uint_as_float(kw[e] & 0xffff0000u) * i1); }
      *(ALAS u32x4*)(lds + G_QT + t * 144 + db * 16) = (u32x4){qo[0], qo[1], qo[2], qo[3]}; *(ALAS u32x4*)(lds + G_KT + t * 144 + db * 16) = (u32x4){ko[0], ko[1], ko[2], ko[3]}; }
    gla_stage_vt(lds, zg, row0, h);
    __syncthreads();
    const int ci = w >> 2, vi = w & 3; bf16x8 pa[4];
#pragma unroll
    for (int jh = 0; jh < 2; ++jh) { if (jh <= ci) { f32x16 pj;
#pragma unroll
            for (int i = 0; i < 16; ++i) pj[i] = 0.f;
#pragma unroll
            for (int ks = 0; ks < 4; ++ks) { const bf16x8 a = *(const ALAS bf16x8*)(lds + G_KT + (32 * jh + r) * 144 + (16 * ks + 8 * hh) * 2), bb = *(const ALAS bf16x8*)(lds + G_QT + (32 * ci + r) * 144 + (16 * ks + 8 * hh) * 2);
                pj = __builtin_amdgcn_mfma_f32_32x32x16_bf16(a, bb, pj, 0, 0, 0); }
#pragma unroll
            for (int i = 0; i < 16; ++i) if (32 * jh + crow(i, hh) > 32 * ci + r) pj[i] = 0.f;
            pa[2 * jh] = pack8r(pj, 0); pa[2 * jh + 1] = pack8r(pj, 8); } else { pa[2 * jh] = (bf16x8){0, 0, 0, 0, 0, 0, 0, 0}; pa[2 * jh + 1] = pa[2 * jh]; } }
    f32x16 acc;
#pragma unroll
    for (int i = 0; i < 16; ++i) acc[i] = 0.f;
#pragma unroll
    for (int ks = 0; ks < 4; ++ks) { if ((ks >> 1) <= ci) { const ALAS unsigned char* vp = lds + G_VT + (32 * vi + r) * 144 + (16 * ks + 4 * hh) * 2;
            const bf16x4 lo = *(const ALAS bf16x4*)vp, hi = *(const ALAS bf16x4*)(vp + 16); const bf16x8 vb = {lo[0], lo[1], lo[2], lo[3], hi[0], hi[1], hi[2], hi[3]};
            acc = __builtin_amdgcn_mfma_f32_32x32x16_bf16(pa[ks], vb, acc, 0, 0, 0); } }
    const bf16* sp = SPREV + ((size_t)((b * 4 + h) * GLA_N + n) * 128) * 64;
#pragma unroll
    for (int ks = 0; ks < 4; ++ks) { const bf16x8 a = *(const ALAS bf16x8*)(lds + G_QT + (32 * ci + r) * 144 + (16 * ks + 8 * hh) * 2), bb = *(const bf16x8*)(sp + (32 * vi + r) * 64 + 16 * ks + 8 * hh);
        acc = __builtin_amdgcn_mfma_f32_32x32x16_bf16(a, bb, acc, 0, 0, 0); }
    ALAS float* OT = (ALAS float*)(lds + G_OT);
#pragma unroll
    for (int i = 0; i < 16; ++i) OT[(32 * ci + crow(i, hh)) * 132 + 32 * vi + r] = acc[i];
    __syncthreads();
    { const int c = tid >> 3, part = tid & 7; float v[16]; float ss = 0.f;
#pragma unroll
      for (int e = 0; e < 16; ++e) { v[e] = OT[c * 132 + 16 * part + e]; ss += v[e] * v[e]; }
      ss += __shfl_xor(ss, 1); ss += __shfl_xor(ss, 2); ss += __shfl_xor(ss, 4);
      const float rs = rsqrtf(ss * (1.f / 128.f) + EPS);
      const u32x4 g0 = *(const u32x4*)(zg + (row0 + c) * ZG_W + ZG_R + 128 * h + 16 * part), g1 = *(const u32x4*)(zg + (row0 + c) * ZG_W + ZG_R + 128 * h + 16 * part + 8);
      const unsigned gw[8] = {g0.x, g0.y, g0.z, g0.w, g1.x, g1.y, g1.z, g1.w}; unsigned ow[8];
#pragma unroll
      for (int e = 0; e < 8; ++e) { const float r0 = __uint_as_float(gw[e] << 16), r1 = __uint_as_float(gw[e] & 0xffff0000u);
          ow[e] = pk(v[2 * e] * rs * o_norm[16 * part + 2 * e] * (r0 * pg8::fsig(r0)), v[2 * e + 1] * rs * o_norm[16 * part + 2 * e + 1] * (r1 * pg8::fsig(r1))); }
      bf16* op = OG + (row0 + c) * 512 + 128 * h + 16 * part; *(u32x4*)op = (u32x4){ow[0], ow[1], ow[2], ow[3]}; *(u32x4*)(op + 8) = (u32x4){ow[4], ow[5], ow[6], ow[7]}; }
    __syncthreads();
}
#undef ALAS
}
constexpr int NWAVES = 8;
constexpr int RING_OFF = 0, RING_BYTES = 131072;
constexpr int LDSCTL_OFF = RING_BYTES, MISC_OFF = LDSCTL_OFF + 320;
constexpr int LDS_BYTES = 147456;
constexpr int CW_TMO = 0, CW_CODE = 1, CW_BAR = 4096;
constexpr size_t CTL_ZERO_BYTES = 1 * MiB;
constexpr int NPH = 18;
#define GAS __attribute__((address_space(1)))
#define LAS __attribute__((address_space(3)))
typedef unsigned short bf16;
typedef unsigned v4u __attribute__((ext_vector_type(4)));
typedef float f32x4 __attribute__((ext_vector_type(4)));
typedef short bf16x8 __attribute__((ext_vector_type(8)));
typedef GAS unsigned gu32;
typedef GAS unsigned long long gu64;
#define RLX_AGENT __ATOMIC_RELAXED, __HIP_MEMORY_SCOPE_AGENT
#define LDS_WAIT() asm volatile("s_waitcnt lgkmcnt(0)" ::: "memory")
#define VM_WAIT() asm volatile("s_waitcnt vmcnt(0)" ::: "memory")
__device__ __forceinline__ unsigned long long rt() { return __builtin_amdgcn_s_memrealtime(); }
__device__ __forceinline__ unsigned f2bfu(float f) { unsigned u = __builtin_bit_cast(unsigned, f); return (u + 0x7fffu + ((u >> 16) & 1u)) >> 16; }
__device__ __forceinline__ unsigned pk2(float lo, float hi) { return pg8::cvt_pk_bf16(lo, hi); }

#define XB_TMO      128
#define XB_XCNT(j)  (256  + 64 * (j))
#define XB_XSUB(j)  (1280 + 64 * (j))
#define XB_XGEN(j)  (2304 + 64 * (j))
#define XB_TOP      3328
#define XB_TOPGEN   3392
#define XCD_BAR_WORDS 3456
#define XB_SPIN_CAP (1u << 18)

__device__ __forceinline__ unsigned xb_ld(unsigned* p)              { return __hip_atomic_load(p, __ATOMIC_RELAXED, __HIP_MEMORY_SCOPE_AGENT); }
__device__ __forceinline__ unsigned xb_add(unsigned* p, unsigned v) { return __hip_atomic_fetch_add(p, v, __ATOMIC_RELAXED, __HIP_MEMORY_SCOPE_AGENT); }
__device__ __forceinline__ unsigned xb_xcc_id() { return (unsigned)__builtin_amdgcn_s_getreg((3 << 11) | 20) & 0xFu; }
#define XB_SPIN(cond, bar) do { unsigned _sp = 0; while (cond) { __builtin_amdgcn_s_sleep(1); \
    if ((++_sp & 255u) == 0u) { if (xb_ld(&(bar)[XB_TMO])) break; if (_sp > XB_SPIN_CAP) { atomicAdd(&(bar)[XB_TMO], 1u); break; } } } } while (0)

struct XcdBarrier {
    unsigned* bar; unsigned x;
    volatile LAS unsigned* st;
};

__device__ __forceinline__ XcdBarrier xcd_barrier_post(unsigned* bar, volatile LAS unsigned* st) {
    XcdBarrier b; b.bar = bar; b.x = xb_xcc_id(); b.st = st;
    if (threadIdx.x == 0) (void)xb_add(&bar[XB_XCNT(b.x)], 1u);
    return b;
}
__device__ __forceinline__ void xcd_barrier_complete(unsigned* bar, unsigned x, unsigned& nloc, unsigned& nx) {
    const unsigned G = gridDim.x * gridDim.y * gridDim.z;
    unsigned sum, cnt, mine, sp = 0u;
    for (;;) {
        sum = 0u; cnt = 0u; mine = 0u;
#pragma unroll
        for (unsigned j = 0; j < 16; ++j) { const unsigned c = xb_ld(&bar[XB_XCNT(j)]); sum += c; cnt += (c > 0u) ? 1u : 0u; mine = (j == x) ? c : mine; }
        if (sum == G) break;
        __builtin_amdgcn_s_sleep(1);
        if ((++sp & 255u) == 0u) { if (xb_ld(&bar[XB_TMO])) break; if (sp > XB_SPIN_CAP) { atomicAdd(&bar[XB_TMO], 1u); break; } }
    }
    nloc = mine > 0u ? mine : 1u; nx = cnt > 0u ? cnt : 1u;
}

__device__ __forceinline__ void xcd_barrier(const XcdBarrier& b) {
    asm volatile("s_waitcnt vmcnt(0)" ::: "memory");
    __syncthreads();
    if (threadIdx.x == 0) {
        unsigned* bar = b.bar;
        __builtin_amdgcn_s_waitcnt(0);
        unsigned nloc = b.st[0], nx = b.st[1];
        if (nloc == 0u) { xcd_barrier_complete(bar, b.x, nloc, nx); b.st[0] = nloc; b.st[1] = nx; }
        const unsigned old = xb_add(&bar[XB_XSUB(b.x)], 1u);
        const unsigned gen = old / nloc;
        if (old + 1u == (gen + 1u) * nloc) {
            __builtin_amdgcn_fence(__ATOMIC_RELEASE, "agent");
            asm volatile("s_waitcnt vmcnt(0)" ::: "memory");
            const unsigned og = xb_add(&bar[XB_TOP], 1u);
            const unsigned tg = og / nx;
            if (og + 1u == (tg + 1u) * nx) xb_add(&bar[XB_TOPGEN], 1u);
            else XB_SPIN(xb_ld(&bar[XB_TOPGEN]) == tg, bar);
            __builtin_amdgcn_fence(__ATOMIC_ACQUIRE, "agent");
            xb_add(&bar[XB_XGEN(b.x)], 1u);
            asm volatile("s_waitcnt vmcnt(0)" ::: "memory");
        } else {
            XB_SPIN(xb_ld(&bar[XB_XGEN(b.x)]) == gen, bar);
            __builtin_amdgcn_fence(__ATOMIC_ACQUIRE, "agent");
            asm volatile("s_waitcnt vmcnt(0)" ::: "memory");
        }
    }
    __syncthreads();
}

__device__ __forceinline__ float wave_sum(float v) {
#pragma unroll
    for (int o = 1; o < 64; o <<= 1) v += __shfl_xor(v, o);
    return v;
}
struct ConvJob { const float* W; const float* gain; bf16* WT; int ldw, col0, nvalid, K, k0, drow0; };
__device__ __forceinline__ void conv_item(const ConvJob& j, int lane) {
    const int n4 = lane & 7, kg = lane >> 3; f32x4 v[8];
    const bool valid = 4 * n4 < j.nvalid;
#pragma unroll
    for (int i = 0; i < 8; ++i) v[i] = valid ? *(const GAS f32x4*)(j.W + (size_t)(j.k0 + 8 * kg + i) * j.ldw + j.col0 + 4 * n4) : (f32x4){0.f, 0.f, 0.f, 0.f};
    if (j.gain) {
#pragma unroll
        for (int i = 0; i < 8; ++i) v[i] = v[i] * j.gain[j.k0 + 8 * kg + i]; }
#pragma unroll
    for (int e = 0; e < 4; ++e) { v4u o; o.x = pk2(v[0][e], v[1][e]); o.y = pk2(v[2][e], v[3][e]); o.z = pk2(v[4][e], v[5][e]); o.w = pk2(v[6][e], v[7][e]);
        *(GAS v4u*)(j.WT + (size_t)(j.drow0 + 4 * n4 + e) * j.K + j.k0 + 8 * kg) = o; }
}
__device__ __forceinline__ void rms_row_to_bf16(const float* xrow, const float* g, bf16* orow, int lane) {
    const GAS f32x4* xr = (const GAS f32x4*)xrow + lane; const GAS f32x4* gr = (const GAS f32x4*)g + lane;
    f32x4 v[4]; float s = 0.f;
#pragma unroll
    for (int j = 0; j < 4; ++j) { v[j] = xr[64 * j]; s += (v[j].x * v[j].x + v[j].y * v[j].y) + (v[j].z * v[j].z + v[j].w * v[j].w); }
    const float rs = rsqrtf(wave_sum(s) * (1.f / D) + EPS);
    GAS unsigned long long* o8 = (GAS unsigned long long*)orow + lane;
#pragma unroll
    for (int j = 0; j < 4; ++j) { const f32x4 gg = gr[64 * j]; o8[64 * j] = (unsigned long long)pk2(v[j].x * rs * gg.x, v[j].y * rs * gg.y) | ((unsigned long long)pk2(v[j].z * rs * gg.z, v[j].w * rs * gg.w) << 32); }
}
__device__ __forceinline__ void rms_row_to_f32(float* xrow, const float* g, int lane) {
    GAS f32x4* xr = (GAS f32x4*)xrow + lane; const GAS f32x4* gr = (const GAS f32x4*)g + lane;
    f32x4 v[4]; float s = 0.f;
#pragma unroll
    for (int j = 0; j < 4; ++j) { v[j] = xr[64 * j]; s += (v[j].x * v[j].x + v[j].y * v[j].y) + (v[j].z * v[j].z + v[j].w * v[j].w); }
    const float rs = rsqrtf(wave_sum(s) * (1.f / D) + EPS);
#pragma unroll
    for (int j = 0; j < 4; ++j) { const f32x4 gg = gr[64 * j]; xr[64 * j] = v[j] * rs * gg; }
}

struct Args { P p; int ph_lo, ph_hi, li, pad; };
__global__ void __launch_bounds__(NWAVES * 64, 2) mega(Args args) {
    extern __shared__ __attribute__((aligned(16))) unsigned char lds_raw[];
    LAS unsigned char* lds = (LAS unsigned char*)lds_raw;
    volatile LAS unsigned* MISC = (volatile LAS unsigned*)(lds + MISC_OFF);
    const int tid = threadIdx.x, lane = tid & 63, wave = __builtin_amdgcn_readfirstlane(tid >> 6);
    const int G = gridDim.x; const int bx = blockIdx.x; const int vcu = (G % 8 == 0) ? (bx % 8) * (G / 8) + bx / 8 : bx;
    const P& p = args.p; unsigned char* ws = p.ws;
    gu32* ctl = (gu32*)(ws + WS_CTL);
    for (int u = tid; u < (LDS_BYTES - LDSCTL_OFF) / 4; u += NWAVES * 64) ((LAS unsigned*)(lds + LDSCTL_OFF))[u] = 0u;
#ifdef LDSPOISON
    for (int u = tid; u < RING_BYTES / 16; u += NWAVES * 64) ((LAS v4u*)lds)[u] = (v4u){0x7fc07fc0u, 0x7fc07fc0u, 0x7fc07fc0u, 0x7fc07fc0u};
#endif
    __syncthreads();
    XcdBarrier bar = xcd_barrier_post((unsigned*)(ctl + CW_BAR) + args.li * XCD_BAR_WORDS, MISC + 8);
    const int lo = args.ph_lo, hi = args.ph_hi;
#ifndef PHMASK
#define PHMASK 0x3ffff
#endif
#define IN(k) (((PHMASK >> (k)) & 1) && lo <= (k) && (k) < hi)
#define SEAM(k) do { if (IN(k) && IN((k) + 1)) xcd_barrier(bar); } while (0)
    float *cs = (float*)(ws + WS_COS), *sn = (float*)(ws + WS_SIN), *ssqq = (float*)(ws + WS_SSQQ), *ssqkv = (float*)(ws + WS_SSQKV);
    bf16 *XN = (bf16*)(ws + WS_XN), *MEMN = (bf16*)(ws + WS_MEMN), *ACT = (bf16*)(ws + SC_ACT), *OMLA = (bf16*)(ws + SC_OMLA), *OX = (bf16*)(ws + SC_OX), *KVX = (bf16*)(ws + SC_KVX),
         *GZ = (bf16*)(ws + SC_GZ), *ZC = (bf16*)(ws + SC_ZC), *ZKV = (bf16*)(ws + SC_ZKV), *ZG = (bf16*)(ws + SC_ZG), *ZXQ = OX, *Q = (bf16*)(ws + SC_Q), *KVM = (bf16*)(ws + SC_KVM), *KR = (bf16*)(ws + SC_KR),
         *MERGED = (bf16*)(ws + SC_MERGED);
    const int gw = vcu * NWAVES + wave, NGW = G * NWAVES;

    if (IN(0)) {
        constexpr int I_GU = 16 * 176, I_D = 44 * 32, I_IN1 = 16 * 88, I_GZ = 16 * 96, I_UQ = 6 * 24, I_UKV = 4 * 32, I_O = 8 * 32, I_SQ = 16 * 32;
        constexpr int NITEMS = 2 * I_GU + 2 * I_D + I_IN1 + I_GZ + I_UQ + I_UKV + 3 * I_O + 2 * I_SQ;
        for (int it = gw; it < NITEMS; it += NGW) {
            int r = it; ConvJob j; j.gain = nullptr; j.nvalid = 32;
            if (r < 2 * I_GU) { const int second = r >= I_GU; if (second) r -= I_GU; const int kb = r / 176, rb = r % 176, tile = rb >> 3, sub = rb & 7;
                j.W = sub < 4 ? (second ? p.ffn2_wg : p.ffn1_wg) : (second ? p.ffn2_wu : p.ffn1_wu); j.ldw = FF; j.col0 = 128 * tile + 32 * (sub & 3); j.K = D; j.k0 = 64 * kb; j.WT = (bf16*)(ws + (second ? WS_WGU2 : WS_WGU1)); j.drow0 = 32 * rb; }
            else if ((r -= 2 * I_GU) < 2 * I_D) { const int second = r >= I_D; if (second) r -= I_D; const int kb = r / 32, rb = r % 32;
                j.W = second ? p.ffn2_wd : p.ffn1_wd; j.ldw = D; j.col0 = 32 * rb; j.K = FF; j.k0 = 64 * kb; j.WT = (bf16*)(ws + (second ? WS_WD2 : WS_WD1)); j.drow0 = 32 * rb; }
            else if ((r -= 2 * I_D) < I_IN1) { const int kb = r / 88, rb = r % 88; const int s = e1_src(32 * rb);
                j.W = p.w_in; j.ldw = DIN; j.col0 = s < 0 ? 0 : s; j.nvalid = s < 0 ? 0 : (32 * rb == ZC_GA ? 16 : 32); j.K = D; j.k0 = 64 * kb; j.WT = (bf16*)(ws + WS_WIN1); j.drow0 = 32 * rb; }
            else if ((r -= I_IN1) < I_GZ) { const int kb = r / 96, rb = r % 96;
                j.W = p.w_in; j.ldw = DIN; j.col0 = 2736 + 32 * rb; j.K = D; j.k0 = 64 * kb; j.WT = (bf16*)(ws + WS_WGZ); j.drow0 = 32 * rb; }
            else if ((r -= I_GZ) < I_UQ) { const int kb = r / 24, rb = r % 24, r0 = 32 * rb;
                j.W = p.w_uq; j.ldw = 768; j.col0 = r0 < 512 ? 96 * (r0 >> 6) + (r0 & 63) : 96 * ((r0 - 512) >> 5) + 64; j.gain = p.q_norm; j.K = 384; j.k0 = 64 * kb; j.WT = (bf16*)(ws + WS_WUQ); j.drow0 = r0; }
            else if ((r -= I_UQ) < I_UKV) { const int kb = r / 32, rb = r % 32, r0 = 32 * rb;
                j.W = p.w_ukv; j.ldw = 1024; j.col0 = r0 < 512 ? 128 * (r0 >> 6) + (r0 & 63) : 128 * ((r0 - 512) >> 6) + 64 + (r0 & 63); j.gain = p.kv_norm; j.K = 256; j.k0 = 64 * kb; j.WT = (bf16*)(ws + WS_WUKV); j.drow0 = r0; }
            else if ((r -= I_UKV) < 3 * I_O) { const int which = r / I_O; r -= which * I_O; const int kb = r / 32, rb = r % 32;
                j.W = which == 0 ? p.w_o_mla : which == 1 ? p.w_o_gla : p.x_w_o; j.ldw = D; j.col0 = 32 * rb; j.K = 512; j.k0 = 64 * kb; j.WT = (bf16*)(ws + WS_WOM + (size_t)which * MiB); j.drow0 = 32 * rb; }
            else { r -= 3 * I_O; const int which = r / I_SQ; r -= which * I_SQ; const int kb = r / 32, rb = r % 32;
                j.W = which == 0 ? p.x_w_kv : p.w_out; j.ldw = D; j.col0 = 32 * rb; j.K = D; j.k0 = 64 * kb; j.WT = (bf16*)(ws + (which == 0 ? WS_WXKV : WS_WOUT)); j.drow0 = 32 * rb; }
            conv_item(j, lane);
        }
        for (int m = gw; m < M; m += NGW) rms_row_to_bf16(p.x + (size_t)m * D, p.ffn1_norm, XN + (size_t)m * D, lane);
        for (int m = gw; m < MMEM; m += NGW) rms_row_to_bf16(p.mem + (size_t)m * D, p.mem_norm, MEMN + (size_t)m * D, lane);
        for (int i = vcu * NWAVES * 64 + tid; i < M * 16; i += G * NWAVES * 64) { const int m = i >> 4, jj = i & 15;
            const float inv = powf(10000.f, -(float)jj / 16.f); const float ang = (float)p.pos[m] * inv; cs[i] = cosf(ang); sn[i] = sinf(ang); }
    }
    SEAM(0);
#define GEMM_PHASE(EPI, ORDER, g, S, E) pg8::gemm_phase<EPI, ORDER, true, true>(lds + RING_OFF, g, S, E)
    if (IN(1)) { pg8::Gemm g{XN, (const bf16*)(ws + WS_WGU1), 0, 0, D, D, D, 0}; pg8::StaticOrder S; S.init(M, 2 * FF, G, bx); pg8::EpiSwiGLU E{ACT, FF, 0}; GEMM_PHASE(pg8::EpiSwiGLU, pg8::StaticOrder, g, S, E); }
    SEAM(1);
    if (IN(2)) { pg8::Gemm g{ACT, (const bf16*)(ws + WS_WD1), 0, 0, FF, FF, FF, 0}; pg8::StaticOrder S; S.init(M, D, G, bx); pg8::EpiResid E{p.x, p.out, 0.5f, 0}; GEMM_PHASE(pg8::EpiResid, pg8::StaticOrder, g, S, E); }
    SEAM(2);
    if (IN(3)) { for (int m = gw; m < M; m += NGW) rms_row_to_bf16(p.out + (size_t)m * D, p.mix_norm, XN + (size_t)m * D, lane); }
    SEAM(3);
    if (IN(4)) {
        { pg8::Gemm g{XN, (const bf16*)(ws + WS_WIN1), 0, 0, D, D, D, 0}; pg8::StaticOrder S; S.init(M, Z1_W, G, bx); pg8::EpiZ1 E{ZC, ZKV, ZG, ZXQ, ssqq, ssqkv}; GEMM_PHASE(pg8::EpiZ1, pg8::StaticOrder, g, S, E); }
        { pg8::Gemm g{MEMN, (const bf16*)(ws + WS_WXKV), 0, 0, D, D, D, 0}; pg8::StaticOrder S; S.init(MMEM, 1024, G, (bx + 64) % G); pg8::EpiPlain E{KVX, 1024, 0}; GEMM_PHASE(pg8::EpiPlain, pg8::StaticOrder, g, S, E); }
    }
    SEAM(4);
    float* DSb = (float*)(ws + SC_DS); float* DECb = (float*)(ws + SC_DEC); bf16* SPREV = (bf16*)(ws + SC_SPREV); bf16* OGLA = (bf16*)(ws + SC_OGLA);
    if (IN(5)) { int lasth = -1;
        for (int u = vcu; u < NB * 4 * GLA_N; u += G) { const int n = u & 31, h = (u >> 5) & 3, b = u >> 7;
            if (h != lasth) { __syncthreads(); att::gla_load_w(lds, p.w_a2, p.b_a, h); __syncthreads(); lasth = h; }
            att::gla_pass_a(lds, ZC, ZG, DSb, DECb, b, h, n); } }
    SEAM(5);
    if (IN(6)) { for (int gid = vcu * NWAVES * 64 + tid; gid < NB * 4 * 4096; gid += G * NWAVES * 64) { const int bh = gid >> 12, e2 = gid & 4095, dv = e2 >> 5, d = 2 * (e2 & 31); float s0 = 0.f, s1 = 0.f;
            const float* dsp = DSb + ((size_t)bh * GLA_N * 128 + dv) * 64 + d; const float* dcp = DECb + (size_t)bh * GLA_N * 64 + d; bf16* spp = SPREV + ((size_t)bh * GLA_N * 128 + dv) * 64 + d;
#pragma unroll 4
            for (int n = 0; n < GLA_N; ++n) { *(unsigned*)(spp + (size_t)n * 8192) = pk2(s0, s1); const float2 ds = *(const float2*)(dsp + (size_t)n * 8192), dc = *(const float2*)(dcp + n * 64); s0 = dc.x * s0 + ds.x; s1 = dc.y * s1 + ds.y; } } }
    SEAM(6);
    if (IN(7)) { int lasth = -1;
        for (int u = vcu; u < NB * 4 * GLA_N; u += G) { const int n = u & 31, h = (u >> 5) & 3, b = u >> 7;
            if (h != lasth) { __syncthreads(); att::gla_load_w(lds, p.w_a2, p.b_a, h); __syncthreads(); lasth = h; }
            att::gla_pass_c(lds, ZC, ZG, SPREV, p.o_norm, OGLA, b, h, n); } }
    SEAM(7);
    if (IN(8)) {
        for (int i = vcu * NWAVES * 64 + tid; i < M * 16; i += G * NWAVES * 64) { const int r = i >> 4, jj = i & 15; const float c = cs[i], s = sn[i];
            const bf16* z = ZC + (size_t)r * ZC_W + ZC_KROPE; const float x1 = bf2f(z[jj]), x2 = bf2f(z[jj + 16]); KR[(size_t)r * 32 + jj] = f2bf(x1 * c - x2 * s); KR[(size_t)r * 32 + jj + 16] = f2bf(x1 * s + x2 * c); }
        { pg8::Gemm g{ZC, (const bf16*)(ws + WS_WUQ), 0, 0, ZC_W, 384, 384, 0}; pg8::StaticOrder S; S.init(M, QW, G, bx); pg8::EpiQ E{Q, ssqq, cs, sn}; GEMM_PHASE(pg8::EpiQ, pg8::StaticOrder, g, S, E); }
        { pg8::Gemm g{ZKV, (const bf16*)(ws + WS_WUKV), 0, 0, ZKV_W, 256, 256, 0}; pg8::StaticOrder S; S.init(M, KVW, G, (bx + 192) % G); pg8::EpiKV E{KVM, ssqkv}; GEMM_PHASE(pg8::EpiKV, pg8::StaticOrder, g, S, E); }
    }
    SEAM(8);
    if (IN(9)) { for (int it = vcu; it < NB * 8 * 4; it += G) { const int s4 = it & 3, hd = (it >> 2) & 7, b = it >> 5; att::MlaT T{Q, KVM, KR, OMLA, hd, 0};
            att::attn_unit<att::MlaT>(lds, T, b, 7 - s4); att::attn_unit<att::MlaT>(lds, T, b, s4); } }
    SEAM(9);
    if (IN(10)) { for (int it = vcu; it < NB * 4 * 8; it += G) { const int qb = it & 7, hd = (it >> 3) & 3, b = it >> 5; att::CrossT T{ZXQ, KVX, OX, hd, 0}; att::attn_unit<att::CrossT>(lds, T, b, qb); } }
    SEAM(10);
    if (IN(11)) { pg8::Gemm g{XN, (const bf16*)(ws + WS_WGZ), 0, 0, D, D, D, 0}; pg8::StaticOrder S; S.init(M, 3072, G, bx);
#ifdef X3
        pg8::EpiPlain E{GZ, 3072, 0}; GEMM_PHASE(pg8::EpiPlain, pg8::StaticOrder, g, S, E);
#else
        pg8::EpiGate E{GZ, p.gate_bias}; GEMM_PHASE(pg8::EpiGate, pg8::StaticOrder, g, S, E);
#endif
    }
    SEAM(11);
    if (IN(12)) { pg8::Gemm g{OMLA, (const bf16*)(ws + WS_WOM), (size_t)16 * MiB, (size_t)1 * MiB, 512, 512, 512, 0}; pg8::MergeOrder S; S.init(M, D, G, bx); pg8::EpiMerge E{MERGED, GZ}; GEMM_PHASE(pg8::EpiMerge, pg8::MergeOrder, g, S, E); }
    SEAM(12);
    if (IN(13)) { pg8::Gemm g{MERGED, (const bf16*)(ws + WS_WOUT), 0, 0, D, D, D, 0}; pg8::StaticOrder S; S.init(M, D, G, bx); pg8::EpiResid E{p.out, p.out, 1.0f, 0}; GEMM_PHASE(pg8::EpiResid, pg8::StaticOrder, g, S, E); }
    SEAM(13);
    if (IN(14)) { for (int m = gw; m < M; m += NGW) rms_row_to_bf16(p.out + (size_t)m * D, p.ffn2_norm, XN + (size_t)m * D, lane); }
    SEAM(14);
    if (IN(15)) { pg8::Gemm g{XN, (const bf16*)(ws + WS_WGU2), 0, 0, D, D, D, 0}; pg8::StaticOrder S; S.init(M, 2 * FF, G, bx); pg8::EpiSwiGLU E{ACT, FF, 0}; GEMM_PHASE(pg8::EpiSwiGLU, pg8::StaticOrder, g, S, E); }
    SEAM(15);
    if (IN(16)) { pg8::Gemm g{ACT, (const bf16*)(ws + WS_WD2), 0, 0, FF, FF, FF, 0}; pg8::StaticOrder S; S.init(M, D, G, bx); pg8::EpiResid E{p.out, p.out, 0.5f, 0}; GEMM_PHASE(pg8::EpiResid, pg8::StaticOrder, g, S, E); }
    SEAM(16);
    if (IN(17)) { for (int m = gw; m < M; m += NGW) rms_row_to_f32(p.out + (size_t)m * D, p.final_norm, lane); }
#undef IN
#undef SEAM
}

#ifndef FASTMASK
#define FASTMASK 0x3FFFFu
#endif
extern "C" void kernel_launch(void* const* d_in, const int* in_sizes, int n_in, void* d_out, int out_size, void* d_ws, size_t ws_size, hipStream_t stream) {
    if (n_in != 28 || in_sizes[0] != M * D || out_size != M * D || ws_size < WS_END) { fprintf(stderr, "kernel_launch: unexpected shapes (n_in %d, in0 %d, out %d, ws %zu)\n", n_in, n_in > 0 ? in_sizes[0] : -1, out_size, ws_size); return; }
    static int grid = 0;
    if (grid == 0) {
        int dev = 0, cus = 0;
        if (hipGetDevice(&dev) != hipSuccess || hipDeviceGetAttribute(&cus, hipDeviceAttributeMultiprocessorCount, dev) != hipSuccess) { fprintf(stderr, "kernel_launch: device query failed\n"); grid = -1; return; }
        if (hipFuncSetAttribute((const void*)mega, hipFuncAttributeMaxDynamicSharedMemorySize, LDS_BYTES) != hipSuccess) { fprintf(stderr, "kernel_launch: hipFuncSetAttribute failed\n"); grid = -1; return; }
        int per_cu = 0; if (hipOccupancyMaxActiveBlocksPerMultiprocessor(&per_cu, (const void*)mega, NWAVES * 64, LDS_BYTES) != hipSuccess || per_cu < 1) fprintf(stderr, "kernel_launch: occupancy query says %d\n", per_cu);
        (void)hipGetLastError();
        grid = cus;
    }
    if (grid < 0) return;
    P p{};
    p.x = (const float*)d_in[0]; p.mem = (const float*)d_in[1]; p.pos = (const int*)d_in[2];
    p.ffn1_norm = (const float*)d_in[3]; p.ffn1_wg = (const float*)d_in[4]; p.ffn1_wu = (const float*)d_in[5]; p.ffn1_wd = (const float*)d_in[6]; p.mix_norm = (const float*)d_in[7]; p.mem_norm = (const float*)d_in[8];
    p.w_in = (const float*)d_in[9]; p.gate_bias = (const float*)d_in[10]; p.q_norm = (const float*)d_in[11]; p.w_uq = (const float*)d_in[12]; p.kv_norm = (const float*)d_in[13]; p.w_ukv = (const float*)d_in[14];
    p.w_o_mla = (const float*)d_in[15]; p.w_a2 = (const float*)d_in[16]; p.b_a = (const float*)d_in[17]; p.o_norm = (const float*)d_in[18]; p.w_o_gla = (const float*)d_in[19]; p.x_w_kv = (const float*)d_in[20];
    p.x_w_o = (const float*)d_in[21]; p.w_out = (const float*)d_in[22]; p.ffn2_norm = (const float*)d_in[23]; p.ffn2_wg = (const float*)d_in[24]; p.ffn2_wu = (const float*)d_in[25]; p.ffn2_wd = (const float*)d_in[26];
    p.final_norm = (const float*)d_in[27]; p.out = (float*)d_out; p.ws = (unsigned char*)d_ws;
    unsigned char* ws = p.ws;
    float *cs = (float*)(ws + WS_COS), *sn = (float*)(ws + WS_SIN), *ssqq = (float*)(ws + WS_SSQQ), *ssqkv = (float*)(ws + WS_SSQKV);
    bf16 *XN = (bf16*)(ws + WS_XN), *MEMN = (bf16*)(ws + WS_MEMN), *ACT = (bf16*)(ws + SC_ACT), *OMLA = (bf16*)(ws + SC_OMLA), *OGLA = (bf16*)(ws + SC_OGLA), *OX = (bf16*)(ws + SC_OX), *KVX = (bf16*)(ws + SC_KVX),
         *GZ = (bf16*)(ws + SC_GZ), *ZC = (bf16*)(ws + SC_ZC), *ZKV = (bf16*)(ws + SC_ZKV), *ZG = (bf16*)(ws + SC_ZG), *ZXQ = OX, *Q = (bf16*)(ws + SC_Q), *KVM = (bf16*)(ws + SC_KVM), *KR = (bf16*)(ws + SC_KR),
         *MERGED = (bf16*)(ws + SC_MERGED);
    float* OTMP = (float*)(ws + SC_DS);
    (void)hipMemsetAsync((char*)d_ws + WS_CTL, 0, CTL_ZERO_BYTES, stream);
    const unsigned mask = FASTMASK; int li = 0;
    for (int ph = 0; ph < NPH; ) {
        const bool fast = (mask >> (ph >= 5 && ph <= 7 ? 5 : ph)) & 1u;
        if (fast) { int e = ph + 1; while (e < NPH && ((mask >> (e >= 5 && e <= 7 ? 5 : e)) & 1u)) ++e;
            Args a{}; a.p = p; a.ph_lo = ph; a.ph_hi = e; a.li = li++; a.pad = 0;
            hipLaunchKernelGGL(mega, dim3(grid), dim3(NWAVES * 64), LDS_BYTES, stream, a);
#ifdef X3
            if (ph == 11) n_gate_fin<<<M * 3072 / 256, 256, 0, stream>>>(GZ, p.gate_bias);
#endif
#ifdef X2
            if (ph == 11) n_gemm<1, DGate><<<dim3(3072 / 64, M / 64), 256, 0, stream>>>(DGate{XN, p.w_in, p.gate_bias, GZ, M, 3072, D, 0});
#endif
            ph = e; continue; }
        switch (ph) {
        case 0: n_rope_tab<<<M * 16 / 256, 256, 0, stream>>>(p.pos, cs, sn); n_rmsnorm<false><<<M / 4, 256, 0, stream>>>(p.x, p.ffn1_norm, XN, nullptr, M); n_rmsnorm<false><<<MMEM / 4, 256, 0, stream>>>(p.mem, p.mem_norm, MEMN, nullptr, MMEM); break;
        case 1: n_gemm<2, DUp><<<dim3(FF / 64, M / 64), 256, 0, stream>>>(DUp{XN, p.ffn1_wg, p.ffn1_wu, ACT, M, FF, D, 0}); break;
        case 2: n_gemm<1, DRes><<<dim3(D / 64, M / 64), 256, 0, stream>>>(DRes{ACT, p.ffn1_wd, p.x, p.out, M, D, FF, FF, 0.5f, 0}); break;
        case 3: n_rmsnorm<false><<<M / 4, 256, 0, stream>>>(p.out, p.mix_norm, XN, nullptr, M); break;
        case 4: n_gemm<1, DE1><<<dim3(Z1_W / 64, M / 64), 256, 0, stream>>>(DE1{XN, p.w_in, ZC, ZKV, ZG, ZXQ, M, Z1_W, D, 0});
                n_gemm<1, DPlain><<<dim3(1024 / 64, MMEM / 64), 256, 0, stream>>>(DPlain{MEMN, p.x_w_kv, KVX, MMEM, 1024, D, D, 1024, 1024});
                n_ssq<<<(M * 20 + 255) / 256, 256, 0, stream>>>(ZC, ZKV, ssqq, ssqkv); break;
        case 5: n_gla_rec<<<NB * 4, 128, 0, stream>>>(ZC, ZG, p.w_a2, p.b_a, OTMP); n_gla_fin<<<M * 4 / 4, 256, 0, stream>>>(OTMP, ZG, p.o_norm, OGLA); break;
        case 6: case 7: break;
        case 8: n_gemm<1, DQ><<<dim3(QW / 64, M / 64), 256, 0, stream>>>(DQ{ZC, p.w_uq, p.q_norm, ssqq, Q, M, QW, 384, 0});
                n_gemm<1, DKV><<<dim3(KVW / 64, M / 64), 256, 0, stream>>>(DKV{ZKV, p.w_ukv, p.kv_norm, ssqkv, KVM, M, KVW, 256, 0});
                n_rope<<<(M * 144 + 255) / 256, 256, 0, stream>>>(Q, ZC, KR, cs, sn); break;
        case 9: n_mla_attn<<<NB * 8 * SEQ * 4 / 256, 256, 0, stream>>>(Q, KVM, KR, OMLA); break;
        case 10: { bf16* OXT = (bf16*)(ws + SC_DS); n_cross_attn<<<NB * 4 * SEQ * 4 / 256, 256, 0, stream>>>(ZXQ, KVX, OXT); (void)hipMemcpyAsync(OX, OXT, (size_t)M * 512 * 2, hipMemcpyDeviceToDevice, stream); } break;
        case 11: n_gemm<1, DGate><<<dim3(3072 / 64, M / 64), 256, 0, stream>>>(DGate{XN, p.w_in, p.gate_bias, GZ, M, 3072, D, 0}); break;
        case 12: n_gemm<3, DMerge><<<dim3(D / 64, M / 64), 256, 0, stream>>>(DMerge{OMLA, p.w_o_mla, p.w_o_gla, p.x_w_o, GZ, MERGED, M, D, 512, 0}); break;
        case 13: n_gemm<1, DRes><<<dim3(D / 64, M / 64), 256, 0, stream>>>(DRes{MERGED, p.w_out, p.out, p.out, M, D, D, D, 1.0f, 0}); break;
        case 14: n_rmsnorm<false><<<M / 4, 256, 0, stream>>>(p.out, p.ffn2_norm, XN, nullptr, M); break;
        case 15: n_gemm<2, DUp><<<dim3(FF / 64, M / 64), 256, 0, stream>>>(DUp{XN, p.ffn2_wg, p.ffn2_wu, ACT, M, FF, D, 0}); break;
        case 16: n_gemm<1, DRes><<<dim3(D / 64, M / 64), 256, 0, stream>>>(DRes{ACT, p.ffn2_wd, p.out, p.out, M, D, FF, FF, 0.5f, 0}); break;
        case 17: n_rmsnorm<true><<<M / 4, 256, 0, stream>>>(p.out, p.final_norm, nullptr, p.out, M); break;
        }
        ++ph;
    }
}
```

```cpp
#include <hip/hip_runtime.h>
#include <cstdint>
#include <cstdio>


typedef unsigned short bf16;
__device__ __forceinline__ float bf2f(bf16 v) { return __uint_as_float((unsigned)v << 16); }
__device__ __forceinline__ bf16 f2bf(float f) { unsigned u = __float_as_uint(f); return (bf16)((u + 0x7fffu + ((u >> 16) & 1u)) >> 16); }

constexpr int NB = 8, SEQ = 2048, D = 1024, M = NB * SEQ, NMEM = 256, MMEM = NB * NMEM, FF = 2816, DIN = 5808;
constexpr float EPS = 1e-6f;
constexpr int ZC_W = 512, ZKV_W = 256, ZG_W = 1536, ZXQ_W = 512, Z1_W = 2816;
constexpr int ZC_KROPE = 384, ZC_GA = 416;
constexpr int ZG_Q = 0, ZG_K = 256, ZG_V = 512, ZG_R = 1024;
constexpr int QW = 768, KVW = 1024;
constexpr float QSCALE = 0.10206207261596577f * 1.4426950408889634f;
constexpr float XSCALE = 0.08838834764831845f * 1.4426950408889634f;
constexpr int GLA_N = SEQ / 64;

constexpr size_t MiB = 1u << 20;
constexpr size_t WS_CTL = 0, WS_COS = 1 * MiB, WS_SIN = 2 * MiB, WS_SSQQ = 3 * MiB, WS_SSQKV = 4 * MiB;
constexpr size_t WS_WGU1 = 5 * MiB, WS_WD1 = 16 * MiB, WS_WIN1 = 21 * MiB + 512 * 1024, WS_WGZ = 27 * MiB, WS_WUQ = 33 * MiB, WS_WUKV = 34 * MiB, WS_WOM = 35 * MiB, WS_WOG = 36 * MiB,
                 WS_WOX = 37 * MiB, WS_WXKV = 38 * MiB, WS_WOUT = 40 * MiB, WS_WGU2 = 42 * MiB, WS_WD2 = 53 * MiB;
constexpr size_t WS_MEMN = 59 * MiB, WS_XN = 63 * MiB, WS_SCR = 95 * MiB;
constexpr size_t SC_ACT = WS_SCR, SC_OMLA = WS_SCR, SC_OGLA = WS_SCR + 16 * MiB, SC_OX = WS_SCR + 32 * MiB, SC_KVX = WS_SCR + 48 * MiB, SC_GZ = WS_SCR + 52 * MiB,
                 SC_ZC = WS_SCR + 52 * MiB, SC_ZKV = WS_SCR + 68 * MiB, SC_ZG = WS_SCR + 76 * MiB, SC_DS = WS_SCR + 124 * MiB, SC_DEC = WS_SCR + 156 * MiB, SC_SPREV = WS_SCR,
                 SC_Q = WS_SCR + 76 * MiB, SC_KVM = WS_SCR + 100 * MiB, SC_KR = WS_SCR + 132 * MiB, SC_MERGED = WS_XN;
constexpr size_t WS_SS2 = WS_CTL + 512 * 1024, WS_SS3 = WS_CTL + 576 * 1024, WS_SS1 = WS_CTL + 640 * 1024;
constexpr size_t WS_SSF = WS_CTL + 704 * 1024, WS_FCNT = WS_CTL + 768 * 1024;
constexpr size_t SC_XN3 = WS_SCR + 96 * MiB;
constexpr size_t WS_END = 256 * MiB;
static_assert(SC_DEC + MiB <= WS_END && SC_GZ + 96 * MiB <= WS_END, "ws map");

struct P {
    const float *x, *mem; const int* pos;
    const float *ffn1_norm, *ffn1_wg, *ffn1_wu, *ffn1_wd, *mix_norm, *mem_norm, *w_in, *gate_bias, *q_norm, *w_uq, *kv_norm, *w_ukv, *w_o_mla, *w_a2, *b_a, *o_norm, *w_o_gla,
        *x_w_kv, *x_w_o, *w_out, *ffn2_norm, *ffn2_wg, *ffn2_wu, *ffn2_wd, *final_norm;
    float* out; unsigned char* ws;
};

template <bool F32OUT> __global__ void __launch_bounds__(256) n_rmsnorm(const float* in, const float* g, bf16* outb, float* outf, int rows) {
    const int row = blockIdx.x * 4 + (threadIdx.x >> 6), lane = threadIdx.x & 63; if (row >= rows) return;
    const float* r = in + (size_t)row * D; float v[16]; float s = 0.f;
#pragma unroll
    for (int j = 0; j < 16; ++j) { v[j] = r[lane + 64 * j]; s += v[j] * v[j]; }
#pragma unroll
    for (int o = 1; o < 64; o <<= 1) s += __shfl_xor(s, o);
    const float rs = rsqrtf(s * (1.f / D) + EPS);
#pragma unroll
    for (int j = 0; j < 16; ++j) { const float y = v[j] * rs * g[lane + 64 * j]; if (F32OUT) outf[(size_t)row * D + lane + 64 * j] = y; else outb[(size_t)row * D + lane + 64 * j] = f2bf(y); }
}
__global__ void __launch_bounds__(256) n_rope_tab(const int* pos, float* cs, float* sn) {
    const int i = blockIdx.x * 256 + threadIdx.x; if (i >= M * 16) return; const int m = i >> 4, j = i & 15;
    const float inv = powf(10000.f, -(float)j / 16.f); const float ang = (float)pos[m] * inv; cs[i] = cosf(ang); sn[i] = sinf(ang);
}
template <int NACC, class Desc> __global__ void __launch_bounds__(256) n_gemm(Desc d) {
    __shared__ float As[NACC][16][65], Bs[NACC][16][65];
    const int tid = threadIdx.x, tx = tid & 15, ty = tid >> 4, row0 = blockIdx.y * 64, col0 = blockIdx.x * 64;
    float acc[NACC][4][4];
#pragma unroll
    for (int s = 0; s < NACC; ++s)
#pragma unroll
        for (int i = 0; i < 4; ++i)
#pragma unroll
            for (int j = 0; j < 4; ++j) acc[s][i][j] = 0.f;
    for (int k0 = 0; k0 < d.K; k0 += 16) {
#pragma unroll
        for (int s = 0; s < NACC; ++s) {
            const int ar = tid >> 2, ak = (tid & 3) * 4;
#pragma unroll
            for (int e = 0; e < 4; ++e) As[s][ak + e][ar] = d.a(s, row0 + ar, k0 + ak + e);
            const int bk = tid >> 4, bc = (tid & 15) * 4;
#pragma unroll
            for (int e = 0; e < 4; ++e) Bs[s][bk][bc + e] = d.b(s, k0 + bk, col0 + bc + e);
        }
        __syncthreads();
#pragma unroll
        for (int k = 0; k < 16; ++k)
#pragma unroll
            for (int s = 0; s < NACC; ++s) {
                float av[4], bv[4];
#pragma unroll
                for (int i = 0; i < 4; ++i) { av[i] = As[s][k][ty * 4 + i]; bv[i] = Bs[s][k][tx * 4 + i]; }
#pragma unroll
                for (int i = 0; i < 4; ++i)
#pragma unroll
                    for (int j = 0; j < 4; ++j) acc[s][i][j] += av[i] * bv[j];
            }
        __syncthreads();
    }
#pragma unroll
    for (int i = 0; i < 4; ++i)
#pragma unroll
        for (int j = 0; j < 4; ++j) { float a[NACC];
#pragma unroll
            for (int s = 0; s < NACC; ++s) a[s] = acc[s][i][j];
            d.epi(row0 + ty * 4 + i, col0 + tx * 4 + j, a); }
}
__device__ __forceinline__ float silu_f(float v) { return v / (1.f + __expf(-v)); }
__device__ __forceinline__ float sigmoid_f(float v) { return 1.f / (1.f + __expf(-v)); }

struct DUp { const bf16* A; const float *wg, *wu; bf16* act; int M, N, K, pad;
    __device__ float a(int, int r, int k) const { return bf2f(A[(size_t)r * D + k]); }
    __device__ float b(int s, int k, int c) const { return (s == 0 ? wg : wu)[(size_t)k * FF + c]; }
    __device__ void epi(int r, int c, const float (&a)[2]) const { act[(size_t)r * FF + c] = f2bf(silu_f(a[0]) * a[1]); } };
struct DRes { const bf16* A; const float* W; const float* base; float* out; int M, N, K, lda; float sc; int pad;
    __device__ float a(int, int r, int k) const { return bf2f(A[(size_t)r * lda + k]); }
    __device__ float b(int, int k, int c) const { return W[(size_t)k * D + c]; }
    __device__ void epi(int r, int c, const float (&a)[1]) const { out[(size_t)r * D + c] = base[(size_t)r * D + c] + sc * a[0]; } };
__device__ __forceinline__ int e1_src(int c) {
    if (c < 384) return c; if (c < 416) return 640 + (c - 384); if (c < 432) return 1696 + (c - 416); if (c < 512) return -1; if (c < 768) return 384 + (c - 512);
    if (c < 1024) return 672 + (c - 768); if (c < 1280) return 928 + (c - 1024); if (c < 1792) return 1184 + (c - 1280); if (c < 2304) return 1712 + (c - 1792); return 2224 + (c - 2304); }
struct DE1 { const bf16* A; const float* W; bf16 *zc, *zkv, *zg, *zxq; int M, N, K, pad;
    __device__ float a(int, int r, int k) const { return bf2f(A[(size_t)r * D + k]); }
    __device__ float b(int, int k, int c) const { const int s = e1_src(c); return s < 0 ? 0.f : W[(size_t)k * DIN + s]; }
    __device__ void epi(int r, int c, const float (&a)[1]) const { const bf16 v = f2bf(a[0]);
        if (c < 512) zc[(size_t)r * ZC_W + c] = v; else if (c < 768) zkv[(size_t)r * ZKV_W + c - 512] = v; else if (c < 2304) zg[(size_t)r * ZG_W + c - 768] = v; else zxq[(size_t)r * ZXQ_W + c - 2304] = v; } };
struct DPlain { const bf16* A; const float* W; bf16* O; int M, N, K, lda, ldw, ldo;
    __device__ float a(int, int r, int k) const { return bf2f(A[(size_t)r * lda + k]); }
    __device__ float b(int, int k, int c) const { return W[(size_t)k * ldw + c]; }
    __device__ void epi(int r, int c, const float (&a)[1]) const { O[(size_t)r * ldo + c] = f2bf(a[0]); } };
struct DQ { const bf16* zc; const float *W, *g, *ssq; bf16* Q; int M, N, K, pad;
    __device__ float a(int, int r, int k) const { return bf2f(zc[(size_t)r * ZC_W + k]); }
    __device__ float b(int, int k, int c) const { const int s = c < 512 ? 96 * (c >> 6) + (c & 63) : 96 * ((c - 512) >> 5) + 64 + (c & 31); return g[k] * W[(size_t)k * 768 + s]; }
    __device__ void epi(int r, int c, const float (&a)[1]) const { float s = 0.f; for (int j = 0; j < 12; ++j) s += ssq[(size_t)r * 12 + j]; Q[(size_t)r * QW + c] = f2bf(a[0] * rsqrtf(s * (1.f / 384.f) + EPS) * QSCALE); } };
struct DKV { const bf16* zkv; const float *W, *g, *ssq; bf16* KV; int M, N, K, pad;
    __device__ float a(int, int r, int k) const { return bf2f(zkv[(size_t)r * ZKV_W + k]); }
    __device__ float b(int, int k, int c) const { const int s = c < 512 ? 128 * (c >> 6) + (c & 63) : 128 * ((c - 512) >> 6) + 64 + (c & 63); return g[k] * W[(size_t)k * 1024 + s]; }
    __device__ void epi(int r, int c, const float (&a)[1]) const { float s = 0.f; for (int j = 0; j < 8; ++j) s += ssq[(size_t)r * 8 + j]; KV[(size_t)r * KVW + c] = f2bf(a[0] * rsqrtf(s * (1.f / 256.f) + EPS)); } };
struct DGate { const bf16* A; const float *W, *bias; bf16* gz; int M, N, K, pad;
    __device__ float a(int, int r, int k) const { return bf2f(A[(size_t)r * D + k]); }
    __device__ float b(int, int k, int c) const { return W[(size_t)k * DIN + 2736 + c]; }
    __device__ void epi(int r, int c, const float (&a)[1]) const { gz[(size_t)r * 3072 + c] = f2bf(sigmoid_f(a[0] + bias[c])); } };
struct DMerge { const bf16* O0; const float *W0, *W1, *W2; const bf16* gz; bf16* mg; int M, N, K, pad;
    __device__ float a(int s, int r, int k) const { return bf2f(O0[(size_t)s * M * 512 + (size_t)r * 512 + k]); }
    __device__ float b(int s, int k, int c) const { return (s == 0 ? W0 : s == 1 ? W1 : W2)[(size_t)k * D + c]; }
    __device__ void epi(int r, int c, const float (&a)[3]) const { const bf16* gp = gz + (size_t)r * 3072 + c; const float v = bf2f(gp[0]) * a[0] + bf2f(gp[1024]) * a[1] + bf2f(gp[2048]) * a[2]; mg[(size_t)r * D + c] = f2bf(v); } };

__global__ void __launch_bounds__(256) n_ssq(const bf16* zc, const bf16* zkv, float* sq, float* skv) {
    const int i = blockIdx.x * 256 + threadIdx.x; if (i >= M * 20) return; const int r = i / 20, j = i % 20; float s = 0.f;
    if (j < 12) { for (int c = 0; c < 32; ++c) { const float v = bf2f(zc[(size_t)r * ZC_W + 32 * j + c]); s += v * v; } sq[(size_t)r * 12 + j] = s; }
    else { for (int c = 0; c < 32; ++c) { const float v = bf2f(zkv[(size_t)r * ZKV_W + 32 * (j - 12) + c]); s += v * v; } skv[(size_t)r * 8 + (j - 12)] = s; }
}
__global__ void __launch_bounds__(256) n_rope(bf16* Q, const bf16* zc, bf16* KR, const float* cs, const float* sn) {
    const int i = blockIdx.x * 256 + threadIdx.x; if (i >= M * 9 * 16) return; const int r = i / 144, h = (i % 144) / 16, j = i & 15;
    const float c = cs[r * 16 + j], s = sn[r * 16 + j];
    if (h < 8) { bf16* q = Q + (size_t)r * QW + 512 + 32 * h; const float x1 = bf2f(q[j]), x2 = bf2f(q[j + 16]); q[j] = f2bf(x1 * c - x2 * s); q[j + 16] = f2bf(x1 * s + x2 * c); }
    else { const bf16* z = zc + (size_t)r * ZC_W + ZC_KROPE; const float x1 = bf2f(z[j]), x2 = bf2f(z[j + 16]); KR[(size_t)r * 32 + j] = f2bf(x1 * c - x2 * s); KR[(size_t)r * 32 + j + 16] = f2bf(x1 * s + x2 * c); }
}
__global__ void __launch_bounds__(256) n_mla_attn(const bf16* Q, const bf16* KV, const bf16* KR, bf16* O) {
    const int i = blockIdx.x * 256 + threadIdx.x; const int sl = i & 3, q = (i >> 2) % SEQ, h = (i >> 2) / SEQ % 8, b = (i >> 2) / SEQ / 8; if (b >= NB) return;
    const size_t r = (size_t)b * SEQ + q; float qv[96];
#pragma unroll
    for (int d = 0; d < 64; ++d) qv[d] = bf2f(Q[r * QW + 64 * h + d]);
#pragma unroll
    for (int d = 0; d < 32; ++d) qv[64 + d] = bf2f(Q[r * QW + 512 + 32 * h + d]);
    float m = -INFINITY, l = 0.f, acc[16];
#pragma unroll
    for (int d = 0; d < 16; ++d) acc[d] = 0.f;
    for (int k = 0; k <= q; ++k) { const size_t kr = (size_t)b * SEQ + k; float s = 0.f;
#pragma unroll
        for (int d = 0; d < 64; ++d) s += qv[d] * bf2f(KV[kr * KVW + 64 * h + d]);
#pragma unroll
        for (int d = 0; d < 32; ++d) s += qv[64 + d] * bf2f(KR[kr * 32 + d]);
        const float mn = fmaxf(m, s), f = exp2f(m - mn), p = exp2f(s - mn); m = mn; l = l * f + p;
#pragma unroll
        for (int d = 0; d < 16; ++d) acc[d] = acc[d] * f + p * bf2f(KV[kr * KVW + 512 + 64 * h + 16 * sl + d]); }
    const float il = 1.f / l;
#pragma unroll
    for (int d = 0; d < 16; ++d) O[r * 512 + 64 * h + 16 * sl + d] = f2bf(acc[d] * il);
}
__global__ void __launch_bounds__(256) n_cross_attn(const bf16* XQ, const bf16* KVX, bf16* O) {
    const int i = blockIdx.x * 256 + threadIdx.x; const int sl = i & 3, q = (i >> 2) % SEQ, h = (i >> 2) / SEQ % 4, b = (i >> 2) / SEQ / 4; if (b >= NB) return;
    const size_t r = (size_t)b * SEQ + q; float qv[128];
#pragma unroll
    for (int d = 0; d < 128; ++d) qv[d] = bf2f(XQ[r * ZXQ_W + 128 * h + d]) * XSCALE;
    float m = -INFINITY, l = 0.f, acc[32];
#pragma unroll
    for (int d = 0; d < 32; ++d) acc[d] = 0.f;
    for (int k = 0; k < NMEM; ++k) { const size_t kr = (size_t)b * NMEM + k; float s = 0.f;
#pragma unroll
        for (int d = 0; d < 128; ++d) s += qv[d] * bf2f(KVX[kr * 1024 + 128 * h + d]);
        const float mn = fmaxf(m, s), f = exp2f(m - mn), p = exp2f(s - mn); m = mn; l = l * f + p;
#pragma unroll
        for (int d = 0; d < 32; ++d) acc[d] = acc[d] * f + p * bf2f(KVX[kr * 1024 + 512 + 128 * h + 32 * sl + d]); }
    const float il = 1.f / l;
#pragma unroll
    for (int d = 0; d < 32; ++d) O[r * 512 + 128 * h + 32 * sl + d] = f2bf(acc[d] * il);
}
__global__ void __launch_bounds__(128) n_gla_rec(const bf16* zc, const bf16* zg, const float* w_a2, const float* b_a, float* otmp) {
    __shared__ float a_s[64], k_s[64], q_s[64];
    const int b = blockIdx.x >> 2, h = blockIdx.x & 3, dv = threadIdx.x; float S[64];
#pragma unroll
    for (int d = 0; d < 64; ++d) S[d] = 0.f;
    for (int t = 0; t < SEQ; ++t) { const size_t r = (size_t)b * SEQ + t;
        if (dv < 64) { float pre = b_a[64 * h + dv];
            for (int j = 0; j < 16; ++j) pre += bf2f(zc[r * ZC_W + ZC_GA + j]) * w_a2[j * 256 + 64 * h + dv];
            const float ls = fminf(pre, 0.f) - log1pf(__expf(-fabsf(pre)));
            a_s[dv] = __expf(ls * (1.f / 16.f)); k_s[dv] = bf2f(zg[r * ZG_W + ZG_K + 64 * h + dv]); q_s[dv] = bf2f(zg[r * ZG_W + ZG_Q + 64 * h + dv]); }
        __syncthreads();
        const float v = bf2f(zg[r * ZG_W + ZG_V + 128 * h + dv]); float o = 0.f;
#pragma unroll
        for (int d = 0; d < 64; ++d) { S[d] = a_s[d] * S[d] + k_s[d] * v; o += q_s[d] * S[d]; }
        otmp[r * 512 + 128 * h + dv] = o * 0.125f;
        __syncthreads(); }
}
__global__ void __launch_bounds__(256) n_gla_fin(const float* otmp, const bf16* zg, const float* o_norm, bf16* O) {
    const int w = blockIdx.x * 4 + (threadIdx.x >> 6), lane = threadIdx.x & 63; if (w >= M * 4) return; const int r = w >> 2, h = w & 3;
    const float a = otmp[(size_t)r * 512 + 128 * h + lane], c = otmp[(size_t)r * 512 + 128 * h + 64 + lane]; float s = a * a + c * c;
#pragma unroll
    for (int o = 1; o < 64; o <<= 1) s += __shfl_xor(s, o);
    const float rs = rsqrtf(s * (1.f / 128.f) + EPS);
    const float r0 = bf2f(zg[(size_t)r * ZG_W + ZG_R + 128 * h + lane]), r1 = bf2f(zg[(size_t)r * ZG_W + ZG_R + 128 * h + 64 + lane]);
    O[(size_t)r * 512 + 128 * h + lane] = f2bf(a * rs * o_norm[lane] * silu_f(r0)); O[(size_t)r * 512 + 128 * h + 64 + lane] = f2bf(c * rs * o_norm[64 + lane] * silu_f(r1));
}


__global__ void __launch_bounds__(256) n_gate_fin(bf16* gz, const float* bias) { const size_t i = (size_t)blockIdx.x * 256 + threadIdx.x; gz[i] = f2bf(sigmoid_f(bf2f(gz[i]) + bias[i % 3072])); }
__global__ void __launch_bounds__(256) n_flush(const float* x, float* sink) { float s = 0.f; for (size_t i = (size_t)blockIdx.x * 256 + threadIdx.x; i < (size_t)M * D; i += (size_t)gridDim.x * 256) s += x[i]; if (s == 123.456f) sink[0] = s; }
namespace pg8 {
#define PG8_LAS __attribute__((address_space(3)))
typedef unsigned short bf16_t;
typedef short bf16x8 __attribute__((ext_vector_type(8)));
typedef float f32x4 __attribute__((ext_vector_type(4)));
typedef unsigned u32x4 __attribute__((ext_vector_type(4)));
typedef unsigned u32x2 __attribute__((ext_vector_type(2)));
constexpr int BM = 256, BK = 64, HALF = 128, HTB = HALF * BK * 2  , STAGE_BYTES = 8 * HTB, NXCD = 8, WGM = 8;

__host__ __device__ __forceinline__ int lds_byte(int r, int c) { const int st = (r >> 4) * 2 + (c >> 5), rr = r & 15, cc = c & 31, ob = rr * 64 + cc * 2; return st * 1024 + (ob ^ (((ob >> 9) & 1) << 5)); }
__host__ __device__ __forceinline__ void stage_rc(int b, int& R, int& C) { const int st = b / 1024, sb = b % 1024, swz = sb ^ (((sb >> 9) & 1) << 5); R = (st >> 1) * 16 + swz / 64; C = (st & 1) * 32 + (swz % 64) / 2; }
__host__ __device__ __forceinline__ int perm32(int rho) { const int n = rho >> 4, i = rho & 15; return 8 * (i >> 2) + 4 * n + (i & 3); }

struct Unit { int pm, pn, z; };
struct Gemm { const bf16_t* A; const bf16_t* Bt; size_t zA, zB; int lda, ldb, K, pad; };

__device__ __forceinline__ void tile_of(int L, int nM, int nN, Unit& u) {
    const int nwg = nM * nN; int wgid = L; { const int q = nwg / NXCD, r = nwg % NXCD, xcd = wgid % NXCD, off = wgid / NXCD; wgid = (xcd < r ? xcd * (q + 1) : r * (q + 1) + (xcd - r) * q) + off; }
    const int nig = WGM * nN, gid = wgid / nig, fm = gid * WGM, gsz = (nM - fm) < WGM ? (nM - fm) : WGM;
    u.pm = fm + ((wgid % nig) % gsz); u.pn = (wgid % nig) / gsz;
}
struct StaticOrder {
    int nM, nN, nwg, G, c;
    __device__ void init(int M_, int N_, int G_, int c_) { nM = M_ / BM; nN = N_ / BM; nwg = nM * nN; G = G_; c = c_; }
    __device__ bool next(int i, Unit& u) const { const long L = (long)i * G + c; if (L >= nwg) return false; tile_of((int)L, nM, nN, u); u.z = 0; return true; }
    __device__ __forceinline__ void a_ready(const Unit&) const {}
    __device__ __forceinline__ void done(const Unit&) const {}
};
struct MergeOrder {
    int nM, nN, nwg, G, c;
    __device__ void init(int M_, int N_, int G_, int c_) { nM = M_ / BM; nN = N_ / BM; nwg = nM * nN; G = G_; c = c_; }
    __device__ bool next(int i, Unit& u) const { const int r = i / 3; const long L = (long)r * G + c; if (L >= nwg) return false; tile_of((int)L, nM, nN, u); u.z = i - 3 * r; return true; }
    __device__ __forceinline__ void a_ready(const Unit&) const {}
    __device__ __forceinline__ void done(const Unit&) const {}
};

typedef float f32x2_t __attribute__((ext_vector_type(2))); typedef __bf16 bf16x2_t __attribute__((ext_vector_type(2)));
__device__ __forceinline__ unsigned cvt_pk_bf16(float lo, float hi) { f32x2_t v = {lo, hi}; bf16x2_t b = __builtin_convertvector(v, bf16x2_t); return __builtin_bit_cast(unsigned, b); }
__device__ __forceinline__ float fsig(float v) { return __builtin_amdgcn_rcpf(1.f + __builtin_amdgcn_exp2f(-1.4426950408889634f * v)); }
__device__ __forceinline__ f32x4 bfx4lo(u32x2 w) { return (f32x4){__uint_as_float(w.x << 16), __uint_as_float(w.x & 0xffff0000u), __uint_as_float(w.y << 16), __uint_as_float(w.y & 0xffff0000u)}; }
__device__ __forceinline__ u32x4 pack8(f32x4 v0, f32x4 v1) { u32x4 w; w.x = cvt_pk_bf16(v0[0], v0[1]); w.y = cvt_pk_bf16(v0[2], v0[3]); w.z = cvt_pk_bf16(v1[0], v1[1]); w.w = cvt_pk_bf16(v1[2], v1[3]); return w; }

struct EpiSwiGLU {
    static constexpr bool PERM = true, AFTER_DRAIN = false; bf16_t* O; const float* ss; int ldc, pad;
    __device__ __forceinline__ void operator()(const f32x4 (&acc)[2][2][4][2], const Unit& u, int wr, int wc, int fr, int fq) const {
        const int row0 = u.pm * BM + wr * 64 + fr, col0 = u.pn * HALF + wc * 32 + 8 * fq;
#pragma unroll
        for (int ai = 0; ai < 2; ++ai)
#pragma unroll
            for (int m = 0; m < 4; ++m) { f32x4 v[2]; const float rs = rsqrtf(ss[row0 + ai * HALF + m * 16] * (1.f / D) + EPS);
#pragma unroll
                for (int n = 0; n < 2; ++n) { const f32x4 g = acc[ai][0][m][n] * rs, up = acc[ai][1][m][n] * rs;
#pragma unroll
                    for (int e = 0; e < 4; ++e) v[n][e] = g[e] * fsig(g[e]) * up[e]; }
                *(u32x4*)(O + (size_t)(row0 + ai * HALF + m * 16) * ldc + col0) = pack8(v[0], v[1]); }
    }
};
struct EpiResid {
    static constexpr bool PERM = true, AFTER_DRAIN = false; const float* base; float* out; bf16_t* xb; float* ssq; float sc; int pad;
    __device__ __forceinline__ void operator()(const f32x4 (&acc)[2][2][4][2], const Unit& u, int wr, int wc, int fr, int fq) const {
        const int row0 = u.pm * BM + wr * 64 + fr, col0 = u.pn * BM + wc * 32 + 8 * fq;
#pragma unroll
        for (int ai = 0; ai < 2; ++ai)
#pragma unroll
            for (int m = 0; m < 4; ++m) { float s = 0.f; const int row = row0 + ai * HALF + m * 16;
#pragma unroll
                for (int bj = 0; bj < 2; ++bj) { const size_t off = (size_t)row * D + col0 + bj * HALF;
                    const f32x4 b0 = *(const f32x4*)(base + off), b1 = *(const f32x4*)(base + off + 4);
                    const f32x4 o0 = b0 + acc[ai][bj][m][0] * sc, o1 = b1 + acc[ai][bj][m][1] * sc;
                    *(f32x4*)(out + off) = o0; *(f32x4*)(out + off + 4) = o1;
                    if (xb) { *(u32x4*)(xb + off) = pack8(o0, o1); s += ((o0[0] * o0[0] + o0[1] * o0[1]) + (o0[2] * o0[2] + o0[3] * o0[3])) + ((o1[0] * o1[0] + o1[1] * o1[1]) + (o1[2] * o1[2] + o1[3] * o1[3])); } }
                if (xb) { s += __shfl_xor(s, 16); s += __shfl_xor(s, 32); if (fq == 0) atomicAdd(ssq + row, s); }
                asm volatile("" ::: "memory"); }
    }
};
struct EpiFinal {
    static constexpr bool PERM = true, AFTER_DRAIN = true; const float* base; float* out; const float* gain; float* ssf; unsigned* cnt; float sc; int pad;
    __device__ __forceinline__ void operator()(const f32x4 (&)[2][2][4][2], const Unit&, int, int, int, int) const {}
    __device__ __forceinline__ void fused(f32x4 (&acc)[2][2][4][2], const Unit& u, int wr, int wc, int fr, int fq, PG8_LAS unsigned char* lds, int wid, int lane) const {
        const int row0 = u.pm * BM + wr * 64 + fr, col0 = u.pn * BM + wc * 32 + 8 * fq;
#pragma unroll
        for (int ai = 0; ai < 2; ++ai)
#pragma unroll
            for (int m = 0; m < 4; ++m) { float s = 0.f; const int row = row0 + ai * HALF + m * 16;
#pragma unroll
                for (int bj = 0; bj < 2; ++bj) { const size_t off = (size_t)row * D + col0 + bj * HALF;
                    const f32x4 b0 = *(const f32x4*)(base + off), b1 = *(const f32x4*)(base + off + 4);
                    const f32x4 o0 = b0 + acc[ai][bj][m][0] * sc, o1 = b1 + acc[ai][bj][m][1] * sc; acc[ai][bj][m][0] = o0; acc[ai][bj][m][1] = o1;
                    s += ((o0[0] * o0[0] + o0[1] * o0[1]) + (o0[2] * o0[2] + o0[3] * o0[3])) + ((o1[0] * o1[0] + o1[1] * o1[1]) + (o1[2] * o1[2] + o1[3] * o1[3])); }
                s += __shfl_xor(s, 16); s += __shfl_xor(s, 32); if (fq == 0) atomicAdd(ssf + row, s);
                asm volatile("" ::: "memory"); }
        asm volatile("s_waitcnt vmcnt(0)" ::: "memory");
        __syncthreads();
        if (threadIdx.x == 0) { unsigned* c = cnt + 64 * u.pm; __hip_atomic_fetch_add(c, 1u, __ATOMIC_RELAXED, __HIP_MEMORY_SCOPE_AGENT);
            unsigned sp = 0; while (__hip_atomic_load(c, __ATOMIC_RELAXED, __HIP_MEMORY_SCOPE_AGENT) < 4u) { __builtin_amdgcn_s_sleep(1); if (++sp > (1u << 22)) break; } }
        __syncthreads();
        f32x4 gv[2][2];
#pragma unroll
        for (int bj = 0; bj < 2; ++bj)
#pragma unroll
            for (int n = 0; n < 2; ++n) gv[bj][n] = *(const f32x4*)(gain + col0 + bj * HALF + 4 * n);
#pragma unroll
        for (int ai = 0; ai < 2; ++ai)
#pragma unroll
            for (int m = 0; m < 4; ++m) { const int row = row0 + ai * HALF + m * 16;
                const float rs = rsqrtf(__hip_atomic_load(ssf + row, __ATOMIC_RELAXED, __HIP_MEMORY_SCOPE_AGENT) * (1.f / D) + EPS);
#pragma unroll
                for (int bj = 0; bj < 2; ++bj) { const size_t off = (size_t)row * D + col0 + bj * HALF;
                    *(f32x4*)(out + off) = acc[ai][bj][m][0] * rs * gv[bj][0]; *(f32x4*)(out + off + 4) = acc[ai][bj][m][1] * rs * gv[bj][1]; } }
    }
};
struct EpiZ1 {
    static constexpr bool PERM = true, AFTER_DRAIN = false; bf16_t *zc, *zkv, *zg, *zxq; float *ssqq, *ssqkv; const float* ss;
    __device__ __forceinline__ void operator()(const f32x4 (&acc)[2][2][4][2], const Unit& u, int wr, int wc, int fr, int fq) const {
        const int pn = u.pn; bf16_t* base; int ldc, cb;
        if (pn < 2) { base = zc; ldc = ZC_W; cb = 256 * pn; } else if (pn == 2) { base = zkv; ldc = ZKV_W; cb = 0; } else if (pn < 9) { base = zg; ldc = ZG_W; cb = 256 * (pn - 3); } else { base = zxq; ldc = ZXQ_W; cb = 256 * (pn - 9); }
        const int row0 = u.pm * BM + wr * 64 + fr, col0 = cb + wc * 32 + 8 * fq;
#pragma unroll
        for (int ai = 0; ai < 2; ++ai)
#pragma unroll
            for (int m = 0; m < 4; ++m) { const int row = row0 + ai * HALF + m * 16; const float rs = rsqrtf(ss[row] * (1.f / D) + EPS);
#pragma unroll
                for (int bj = 0; bj < 2; ++bj) *(u32x4*)(base + (size_t)row * ldc + col0 + bj * HALF) = pack8(acc[ai][bj][m][0] * rs, acc[ai][bj][m][1] * rs);
                if (pn <= 2) {
#pragma unroll
                    for (int bj = 0; bj < 2; ++bj) { const f32x4 a = acc[ai][bj][m][0] * rs, b = acc[ai][bj][m][1] * rs;
                        float s = (a[0] * a[0] + a[1] * a[1]) + (a[2] * a[2] + a[3] * a[3]) + (b[0] * b[0] + b[1] * b[1]) + (b[2] * b[2] + b[3] * b[3]);
                        s += __shfl_xor(s, 16); s += __shfl_xor(s, 32);
                        if (fq == 0) { if (pn == 0) ssqq[(size_t)row * 12 + 4 * bj + wc] = s; else if (pn == 1) { if (bj == 0) ssqq[(size_t)row * 12 + 8 + wc] = s; } else ssqkv[(size_t)row * 8 + 4 * bj + wc] = s; } } } }
    }
};
struct EpiPlain {
    static constexpr bool PERM = true, AFTER_DRAIN = false; bf16_t* O; int ldc, pad;
    __device__ __forceinline__ void operator()(const f32x4 (&acc)[2][2][4][2], const Unit& u, int wr, int wc, int fr, int fq) const {
        const int row0 = u.pm * BM + wr * 64 + fr, col0 = u.pn * BM + wc * 32 + 8 * fq;
#pragma unroll
        for (int ai = 0; ai < 2; ++ai)
#pragma unroll
            for (int m = 0; m < 4; ++m)
#pragma unroll
                for (int bj = 0; bj < 2; ++bj) *(u32x4*)(O + (size_t)(row0 + ai * HALF + m * 16) * ldc + col0 + bj * HALF) = pack8(acc[ai][bj][m][0], acc[ai][bj][m][1]);
    }
};
struct EpiQ {
    static constexpr bool PERM = false, AFTER_DRAIN = false; bf16_t* Q; const float *ssq, *cs, *sn;
    __device__ __forceinline__ void operator()(const f32x4 (&acc)[2][2][4][2], const Unit& u, int wr, int wc, int fr, int fq) const {
#pragma unroll
        for (int ai = 0; ai < 2; ++ai)
#pragma unroll
            for (int m = 0; m < 4; ++m) { const int row = u.pm * BM + ai * HALF + wr * 64 + m * 16 + fr;
                const f32x4 s0 = *(const f32x4*)(ssq + (size_t)row * 12), s1 = *(const f32x4*)(ssq + (size_t)row * 12 + 4), s2 = *(const f32x4*)(ssq + (size_t)row * 12 + 8);
                const float ss = ((s0[0] + s0[1]) + (s0[2] + s0[3])) + ((s1[0] + s1[1]) + (s1[2] + s1[3])) + ((s2[0] + s2[1]) + (s2[2] + s2[3]));
                const float sc = rsqrtf(ss * (1.f / 384.f) + EPS) * QSCALE;
                if (u.pn < 2) {
#pragma unroll
                    for (int bj = 0; bj < 2; ++bj)
#pragma unroll
                        for (int n = 0; n < 2; ++n) { const f32x4 v = acc[ai][bj][m][n] * sc; u32x2 w; w.x = cvt_pk_bf16(v[0], v[1]); w.y = cvt_pk_bf16(v[2], v[3]);
                            *(u32x2*)(Q + (size_t)row * QW + u.pn * BM + bj * HALF + wc * 32 + 16 * n + 4 * fq) = w; }
                } else { const f32x4 c4 = *(const f32x4*)(cs + (size_t)row * 16 + 4 * fq), s4 = *(const f32x4*)(sn + (size_t)row * 16 + 4 * fq);
#pragma unroll
                    for (int bj = 0; bj < 2; ++bj) { const f32x4 x1 = acc[ai][bj][m][0] * sc, x2 = acc[ai][bj][m][1] * sc; const f32x4 o1 = x1 * c4 - x2 * s4, o2 = x1 * s4 + x2 * c4;
                        u32x2 w1, w2; w1.x = cvt_pk_bf16(o1[0], o1[1]); w1.y = cvt_pk_bf16(o1[2], o1[3]); w2.x = cvt_pk_bf16(o2[0], o2[1]); w2.y = cvt_pk_bf16(o2[2], o2[3]);
                        bf16_t* q = Q + (size_t)row * QW + 512 + bj * HALF + wc * 32 + 4 * fq; *(u32x2*)q = w1; *(u32x2*)(q + 16) = w2; } }
                asm volatile("" ::: "memory"); }
    }
};
struct EpiKV {
    static constexpr bool PERM = true, AFTER_DRAIN = false; bf16_t* O; const float* ssq;
    __device__ __forceinline__ void operator()(const f32x4 (&acc)[2][2][4][2], const Unit& u, int wr, int wc, int fr, int fq) const {
        const int row0 = u.pm * BM + wr * 64 + fr, col0 = u.pn * BM + wc * 32 + 8 * fq;
#pragma unroll
        for (int ai = 0; ai < 2; ++ai)
#pragma unroll
            for (int m = 0; m < 4; ++m) { const int row = row0 + ai * HALF + m * 16;
                const f32x4 s0 = *(const f32x4*)(ssq + (size_t)row * 8), s1 = *(const f32x4*)(ssq + (size_t)row * 8 + 4);
                const float sc = rsqrtf((((s0[0] + s0[1]) + (s0[2] + s0[3])) + ((s1[0] + s1[1]) + (s1[2] + s1[3]))) * (1.f / 256.f) + EPS);
#pragma unroll
                for (int bj = 0; bj < 2; ++bj) *(u32x4*)(O + (size_t)row * KVW + col0 + bj * HALF) = pack8(acc[ai][bj][m][0] * sc, acc[ai][bj][m][1] * sc);
                asm volatile("" ::: "memory"); }
    }
};
struct EpiGate {
    static constexpr bool PERM = true, AFTER_DRAIN = false; bf16_t* O; const float* bias; const float* ss;
    __device__ __forceinline__ void operator()(const f32x4 (&acc)[2][2][4][2], const Unit& u, int wr, int wc, int fr, int fq) const {
        const int row0 = u.pm * BM + wr * 64 + fr, col0 = u.pn * BM + wc * 32 + 8 * fq;
        f32x4 bv[2][2];
#pragma unroll
        for (int bj = 0; bj < 2; ++bj)
#pragma unroll
            for (int n = 0; n < 2; ++n) bv[bj][n] = *(const f32x4*)(bias + col0 + bj * HALF + 4 * n);
#pragma unroll
        for (int ai = 0; ai < 2; ++ai)
#pragma unroll
            for (int m = 0; m < 4; ++m) { const float rs = rsqrtf(ss[row0 + ai * HALF + m * 16] * (1.f / D) + EPS);
#pragma unroll
                for (int bj = 0; bj < 2; ++bj) { f32x4 v[2];
#pragma unroll
                    for (int n = 0; n < 2; ++n) { const f32x4 t = acc[ai][bj][m][n] * rs + bv[bj][n];
#pragma unroll
                        for (int e = 0; e < 4; ++e) v[n][e] = fsig(t[e]); }
                    *(u32x4*)(O + (size_t)(row0 + ai * HALF + m * 16) * 3072 + col0 + bj * HALF) = pack8(v[0], v[1]); } }
    }
};
struct EpiMerge {
    static constexpr bool PERM = true, AFTER_DRAIN = false; bf16_t* MG; const bf16_t* gz;
    __device__ __forceinline__ void operator()(const f32x4 (&acc)[2][2][4][2], const Unit& u, int wr, int wc, int fr, int fq) const {
        const int row0 = u.pm * BM + wr * 64 + fr, col0 = u.pn * BM + wc * 32 + 8 * fq;
#pragma unroll
        for (int ai = 0; ai < 2; ++ai)
#pragma unroll
            for (int m = 0; m < 4; ++m) {
#pragma unroll
                for (int bj = 0; bj < 2; ++bj) { const int row = row0 + ai * HALF + m * 16, col = col0 + bj * HALF;
                    const u32x4 gw = *(const u32x4*)(gz + (size_t)row * 3072 + 1024 * u.z + col);
                    f32x4 v0 = bfx4lo((u32x2){gw.x, gw.y}) * acc[ai][bj][m][0], v1 = bfx4lo((u32x2){gw.z, gw.w}) * acc[ai][bj][m][1];
                    bf16_t* mp = MG + (size_t)row * D + col;
                    if (u.z > 0) {
                        const unsigned long long o0 = __hip_atomic_load((const unsigned long long*)mp, __ATOMIC_RELAXED, __HIP_MEMORY_SCOPE_AGENT), o1 = __hip_atomic_load((const unsigned long long*)mp + 1, __ATOMIC_RELAXED, __HIP_MEMORY_SCOPE_AGENT);
                        v0 += bfx4lo((u32x2){(unsigned)o0, (unsigned)(o0 >> 32)}); v1 += bfx4lo((u32x2){(unsigned)o1, (unsigned)(o1 >> 32)}); }
                    *(u32x4*)mp = pack8(v0, v1); }
                asm volatile("" ::: "memory"); }
    }
};

template <class Epi, class Sched, bool ALIGN_EPI = false, bool SP2 = false>
__device__ __forceinline__ void gemm_phase(PG8_LAS unsigned char* lds, const Gemm g, const Sched& S, const Epi& E) {
    const int tid = threadIdx.x, wid = __builtin_amdgcn_readfirstlane(tid >> 6), lane = tid & 63, wr = wid >> 2, wc = wid & 3, fr = lane & 15, fq = lane >> 4;
    const int K = g.K, nt = K / BK;
    unsigned voffA[2], voffB[2];
#pragma unroll
    for (int i = 0; i < 2; ++i) { int R, C; stage_rc(tid * 16 + i * 8192, R, C); const int Rb = Epi::PERM ? ((R & ~31) + perm32(R & 31)) : R;
        voffA[i] = (unsigned)(R * g.lda + C) * 2u; voffB[i] = (unsigned)(Rb * g.ldb + C) * 2u; }
    const size_t kstep = (size_t)(BK * 2);
    const size_t hstepA = (size_t)HALF * g.lda * 2, hstepB = (size_t)HALF * g.ldb * 2;
    const size_t tstepA = 2 * hstepA, tstepB = 2 * hstepB;
    const unsigned ldsw = (unsigned)wid * 1024u;
    const int aoff = lds_byte(wr * 64 + fr, fq * 8), boff = lds_byte(wc * 32 + fr, fq * 8);
#define PG8_SA(b, h) (((b) * 2 + (h)) * HTB)
#define PG8_SB(b, h) ((4 + (b) * 2 + (h)) * HTB)
#define PG8_STAGE(bufoff, gbase, voff) do { _Pragma("unroll") for (int _i = 0; _i < 2; ++_i) \
        __builtin_amdgcn_global_load_lds((const unsigned*)((const char*)(gbase) + (voff)[_i]), (PG8_LAS unsigned*)(lds + (bufoff) + ldsw + _i * 8192), 16, 0, 0); } while (0)
#define PG8_LDA(dst, b, h) do { _Pragma("unroll") for (int m = 0; m < 4; ++m) _Pragma("unroll") for (int k = 0; k < 2; ++k) dst[m][k] = *(const PG8_LAS bf16x8*)(lds + PG8_SA(b, h) + aoff + m * 2048 + k * 1024); } while (0)
#define PG8_LDB(dst, b, h) do { _Pragma("unroll") for (int n = 0; n < 2; ++n) _Pragma("unroll") for (int k = 0; k < 2; ++k) dst[n][k] = *(const PG8_LAS bf16x8*)(lds + PG8_SB(b, h) + boff + n * 2048 + k * 1024); } while (0)
#define PG8_MMA(ai, bj, At, Bt) do { __builtin_amdgcn_s_setprio(1); _Pragma("unroll") for (int m = 0; m < 4; ++m) _Pragma("unroll") for (int n = 0; n < 2; ++n) _Pragma("unroll") for (int k = 0; k < 2; ++k) \
        acc[ai][bj][m][n] = __builtin_amdgcn_mfma_f32_16x16x32_bf16(Bt[n][k], At[m][k], acc[ai][bj][m][n], 0, 0, 0); __builtin_amdgcn_s_setprio(0); } while (0)
#define PG8_WAIT_V(n) asm volatile("s_waitcnt vmcnt(" #n ")" ::: "memory")
#define PG8_WAIT_L(n) asm volatile("s_waitcnt lgkmcnt(" #n ")" ::: "memory")
#define PG8_BAR __builtin_amdgcn_s_barrier()
#define PG8_SCHED __builtin_amdgcn_sched_barrier(0)
    Unit cur, nxt; int ui = 0;
    if (!S.next(0, cur)) return;
    f32x4 acc[2][2][4][2];
#pragma unroll
    for (int a = 0; a < 2; ++a)
#pragma unroll
        for (int b = 0; b < 2; ++b)
#pragma unroll
            for (int m = 0; m < 4; ++m)
#pragma unroll
                for (int n = 0; n < 2; ++n) acc[a][b][m][n] = (f32x4){0.f, 0.f, 0.f, 0.f};
    bf16x8 At[4][2], B0[2][2], B1[2][2];
    const char* cA = (const char*)g.A + (size_t)cur.z * g.zA + (size_t)cur.pm * tstepA; const char* cB = (const char*)g.Bt + (size_t)cur.z * g.zB + (size_t)cur.pn * tstepB;
    S.a_ready(cur);
    if constexpr (SP2) {
        PG8_STAGE(PG8_SB(0, 0), cB, voffB); PG8_STAGE(PG8_SB(0, 1), cB + hstepB, voffB); PG8_STAGE(PG8_SA(0, 0), cA, voffA); PG8_STAGE(PG8_SA(0, 1), cA + hstepA, voffA);
        if (wr == 1) PG8_BAR;
        PG8_WAIT_V(2); PG8_BAR;
        PG8_STAGE(PG8_SB(1, 0), cB + kstep, voffB); PG8_STAGE(PG8_SA(1, 0), cA + kstep, voffA); PG8_STAGE(PG8_SB(1, 1), cB + hstepB + kstep, voffB);
        PG8_WAIT_V(6); PG8_BAR;
    } else {
        PG8_STAGE(PG8_SB(0, 0), cB, voffB); PG8_STAGE(PG8_SA(0, 0), cA, voffA); PG8_STAGE(PG8_SB(0, 1), cB + hstepB, voffB); PG8_STAGE(PG8_SA(0, 1), cA + hstepA, voffA);
        if (wr == 1) PG8_BAR;
        PG8_WAIT_V(4); PG8_BAR;
        PG8_STAGE(PG8_SB(1, 0), cB + kstep, voffB); PG8_STAGE(PG8_SA(1, 0), cA + kstep, voffA); PG8_STAGE(PG8_SB(1, 1), cB + hstepB + kstep, voffB);
        PG8_WAIT_V(6); PG8_BAR;
    }
    for (;;) {
        const bool has_next = S.next(ui + 1, nxt);
        const char* nA = has_next ? (const char*)g.A + (size_t)nxt.z * g.zA + (size_t)nxt.pm * tstepA : cA; const char* nB = has_next ? (const char*)g.Bt + (size_t)nxt.z * g.zB + (size_t)nxt.pn * tstepB : cB;
#pragma unroll 1
        for (int t = 0; t < nt; t += 2) {
            const bool last = (t == nt - 2);
            const char* a1 = cA + (size_t)(t + 1) * kstep;
            const char* a2 = last ? nA : cA + (size_t)(t + 2) * kstep; const char* b2 = last ? nB : cB + (size_t)(t + 2) * kstep;
            const char* a3 = a2 + kstep; const char* b3 = b2 + kstep;
            if (last && has_next) S.a_ready(nxt);
            if constexpr (SP2) {
            PG8_LDB(B0, 0, 0); PG8_LDB(B1, 0, 1); PG8_SCHED; PG8_LDA(At, 0, 0); PG8_STAGE(PG8_SA(1, 1), a1 + hstepA, voffA);
            PG8_WAIT_V(8); PG8_WAIT_L(0); PG8_BAR; PG8_MMA(0, 0, At, B0); PG8_MMA(0, 1, At, B1); PG8_BAR; PG8_SCHED;
            PG8_LDA(At, 0, 1); PG8_STAGE(PG8_SB(0, 0), b2, voffB); PG8_STAGE(PG8_SB(0, 1), b2 + hstepB, voffB); PG8_STAGE(PG8_SA(0, 0), a2, voffA);
            PG8_WAIT_V(8); PG8_WAIT_L(0); PG8_BAR; PG8_MMA(1, 0, At, B0); PG8_MMA(1, 1, At, B1); PG8_BAR; PG8_SCHED;
            PG8_LDB(B0, 1, 0); PG8_LDB(B1, 1, 1); PG8_SCHED; PG8_LDA(At, 1, 0); PG8_STAGE(PG8_SA(0, 1), a2 + hstepA, voffA);
            PG8_WAIT_V(8); PG8_WAIT_L(0); PG8_BAR; PG8_MMA(0, 0, At, B0); PG8_MMA(0, 1, At, B1); PG8_BAR; PG8_SCHED;
            PG8_LDA(At, 1, 1); PG8_STAGE(PG8_SB(1, 0), b3, voffB); PG8_STAGE(PG8_SB(1, 1), b3 + hstepB, voffB); PG8_STAGE(PG8_SA(1, 0), a3, voffA);
            PG8_WAIT_V(8); PG8_WAIT_L(0); PG8_BAR; PG8_MMA(1, 0, At, B0); PG8_MMA(1, 1, At, B1); PG8_BAR; PG8_SCHED;
            } else {
            PG8_LDB(B0, 0, 0); PG8_SCHED; PG8_LDA(At, 0, 0); PG8_STAGE(PG8_SA(1, 1), a1 + hstepA, voffA);
            PG8_WAIT_L(8); PG8_BAR; PG8_WAIT_L(0); PG8_MMA(0, 0, At, B0); PG8_BAR; PG8_SCHED;
            PG8_LDB(B1, 0, 1); PG8_STAGE(PG8_SB(0, 0), b2, voffB);
            PG8_BAR; PG8_WAIT_L(0); PG8_MMA(0, 1, At, B1); PG8_BAR;
            PG8_LDA(At, 0, 1); PG8_STAGE(PG8_SA(0, 0), a2, voffA);
            PG8_BAR; PG8_WAIT_L(0); PG8_MMA(1, 0, At, B0); PG8_BAR; PG8_SCHED;
            PG8_STAGE(PG8_SB(0, 1), b2 + hstepB, voffB);
            PG8_WAIT_V(6); PG8_BAR; PG8_MMA(1, 1, At, B1); PG8_BAR;
            PG8_LDB(B0, 1, 0); PG8_SCHED; PG8_LDA(At, 1, 0); PG8_STAGE(PG8_SA(0, 1), a2 + hstepA, voffA);
            PG8_WAIT_L(8); PG8_BAR; PG8_WAIT_L(0); PG8_MMA(0, 0, At, B0); PG8_BAR; PG8_SCHED;
            PG8_LDB(B1, 1, 1); PG8_STAGE(PG8_SB(1, 0), b3, voffB);
            PG8_BAR; PG8_WAIT_L(0); PG8_MMA(0, 1, At, B1); PG8_BAR;
            PG8_LDA(At, 1, 1); PG8_STAGE(PG8_SA(1, 0), a3, voffA);
            PG8_BAR; PG8_WAIT_L(0); PG8_MMA(1, 0, At, B0); PG8_BAR; PG8_SCHED;
            PG8_STAGE(PG8_SB(1, 1), b3 + hstepB, voffB);
            PG8_WAIT_V(6); PG8_BAR; PG8_MMA(1, 1, At, B1); PG8_BAR;
            }
        }
        if constexpr (ALIGN_EPI) { if (wr == 0) PG8_BAR; }
        if constexpr (!Epi::AFTER_DRAIN) { E(acc, cur, wr, wc, fr, fq); S.done(cur); }
        if (!has_next) break;
#pragma unroll
        for (int a = 0; a < 2; ++a)
#pragma unroll
            for (int b = 0; b < 2; ++b)
#pragma unroll
                for (int m = 0; m < 4; ++m)
#pragma unroll
                    for (int n = 0; n < 2; ++n) acc[a][b][m][n] = (f32x4){0.f, 0.f, 0.f, 0.f};
        cur = nxt; cA = nA; cB = nB; ++ui;
        if constexpr (ALIGN_EPI) { if (wr == 1) PG8_BAR; }
    }
    PG8_WAIT_V(0);
    if constexpr (!ALIGN_EPI) { if (wr == 0) PG8_BAR; }
    PG8_BAR;
    if constexpr (Epi::AFTER_DRAIN) { E.fused(acc, cur, wr, wc, fr, fq, lds, wid, lane); S.done(cur); }
#undef PG8_SA
#undef PG8_SB
#undef PG8_STAGE
#undef PG8_LDA
#undef PG8_LDB
#undef PG8_MMA
#undef PG8_WAIT_V
#undef PG8_WAIT_L
#undef PG8_BAR
#undef PG8_SCHED
}
}


namespace att {
typedef short bf16x8 __attribute__((ext_vector_type(8)));
typedef short bf16x4 __attribute__((ext_vector_type(4)));
typedef float f32x16 __attribute__((ext_vector_type(16)));
typedef unsigned u32x4 __attribute__((ext_vector_type(4)));
#define ALAS __attribute__((address_space(3)))
__device__ __forceinline__ int crow(int r, int hi) { return (r & 3) + 8 * (r >> 2) + 4 * hi; }
__device__ __forceinline__ unsigned pk(float lo, float hi) { return pg8::cvt_pk_bf16(lo, hi); }
__device__ __forceinline__ float swap_max(float v) { auto rr = __builtin_amdgcn_permlane32_swap(__float_as_uint(v), __float_as_uint(v), false, false); return fmaxf(__uint_as_float(rr[0]), __uint_as_float(rr[1])); }
__device__ __forceinline__ float swap_add(float v) { auto rr = __builtin_amdgcn_permlane32_swap(__float_as_uint(v), __float_as_uint(v), false, false); return __uint_as_float(rr[0]) + __uint_as_float(rr[1]); }
__device__ __forceinline__ bf16x8 pack8r(const f32x16& p, int b) {
    u32x4 w; w.x = pk(p[b], p[b + 1]); w.y = pk(p[b + 2], p[b + 3]); w.z = pk(p[b + 4], p[b + 5]); w.w = pk(p[b + 6], p[b + 7]); return __builtin_bit_cast(bf16x8, w); }

template <class T> __device__ __forceinline__ void attn_unit(ALAS unsigned char* lds, const T& t, int b, int qb) {
    constexpr int NDS = T::NDS, NDH = T::NDH, KP = NDS * 32 + 16, VP = 136, KB = 64 * KP, VB = NDH * 32 * VP, NKC = NDS * 2, NVC = NDH * 4;
    const int tid = threadIdx.x, lane = tid & 63, r = lane & 31, h = lane >> 5, w = __builtin_amdgcn_readfirstlane(tid >> 6);
    ALAS unsigned char* Kl = lds; ALAS unsigned char* Vl = lds + 2 * KB; ALAS float* wsc = (ALAS float*)(lds + 2 * KB + 2 * VB) + 32 * w;
    const int q0 = qb * 256; const size_t qrow = (size_t)b * SEQ + q0 + 32 * w + r;
    bf16x8 qf[NDS];
#pragma unroll
    for (int d0 = 0; d0 < NDS; ++d0) qf[d0] = *(const bf16x8*)t.qptr(qrow, d0, h);
    const int NT = T::CAUSAL ? 4 * qb + 4 : T::NKV / 64; const int my_last = T::CAUSAL ? 4 * qb + (w >> 1) : NT - 1;
    const size_t kvrow0 = (size_t)b * (T::CAUSAL ? SEQ : T::NKV) + lane;
    f32x16 o[NDH];
#pragma unroll
    for (int dh = 0; dh < NDH; ++dh)
#pragma unroll
        for (int i = 0; i < 16; ++i) o[dh][i] = 0.f;
    float m = -1e30f, l = 0.f;
    u32x4 kreg[2], vreg[2];
#define ATT_LOAD(tile) do { const size_t kr_ = kvrow0 + (size_t)(tile) * 64; \
        _Pragma("unroll") for (int i_ = 0; i_ < 2; ++i_) { if (w + 8 * i_ < NKC) kreg[i_] = *(const u32x4*)t.kchunk(kr_, w + 8 * i_); if (w + 8 * i_ < NVC) vreg[i_] = *(const u32x4*)t.vchunk(kr_, w + 8 * i_); } } while (0)
#define ATT_WRITE(buf) do { ALAS unsigned char* kb_ = Kl + (buf) * KB; ALAS unsigned char* vb_ = Vl + (buf) * VB; \
        _Pragma("unroll") for (int i_ = 0; i_ < 2; ++i_) { if (w + 8 * i_ < NKC) *(ALAS u32x4*)(kb_ + lane * KP + (w + 8 * i_) * 16) = kreg[i_]; \
            if (w + 8 * i_ < NVC) { const u32x4 v_ = vreg[i_]; ALAS unsigned short* vp_ = (ALAS unsigned short*)(vb_ + (8 * (w + 8 * i_)) * VP + lane * 2); \
                vp_[0 * (VP / 2)] = (unsigned short)(v_.x & 0xffff); vp_[1 * (VP / 2)] = (unsigned short)(v_.x >> 16); vp_[2 * (VP / 2)] = (unsigned short)(v_.y & 0xffff); vp_[3 * (VP / 2)] = (unsigned short)(v_.y >> 16); \
                vp_[4 * (VP / 2)] = (unsigned short)(v_.z & 0xffff); vp_[5 * (VP / 2)] = (unsigned short)(v_.z >> 16); vp_[6 * (VP / 2)] = (unsigned short)(v_.w & 0xffff); vp_[7 * (VP / 2)] = (unsigned short)(v_.w >> 16); } } } while (0)
    ATT_LOAD(0); ATT_WRITE(0); __syncthreads();
    for (int tile = 0; tile < NT; ++tile) {
        const bool more = tile + 1 < NT;
        if (more) ATT_LOAD(tile + 1);
        if (tile <= my_last) {
            const ALAS unsigned char* Kb = Kl + (tile & 1) * KB; const ALAS unsigned char* Vb = Vl + (tile & 1) * VB;
            f32x16 p0, p1;
#pragma unroll
            for (int i = 0; i < 16; ++i) { p0[i] = 0.f; p1[i] = 0.f; }
#pragma unroll
            for (int d0 = 0; d0 < NDS; ++d0) { const bf16x8 a0 = *(const ALAS bf16x8*)(Kb + r * KP + (16 * d0 + 8 * h) * 2), a1 = *(const ALAS bf16x8*)(Kb + (32 + r) * KP + (16 * d0 + 8 * h) * 2);
                p0 = __builtin_amdgcn_mfma_f32_32x32x16_bf16(a0, qf[d0], p0, 0, 0, 0); p1 = __builtin_amdgcn_mfma_f32_32x32x16_bf16(a1, qf[d0], p1, 0, 0, 0); }
            if (T::SCALE != 1.0f) {
#pragma unroll
                for (int i = 0; i < 16; ++i) { p0[i] *= T::SCALE; p1[i] *= T::SCALE; } }
            if (T::CAUSAL && tile >= 4 * qb) { const int qi = q0 + 32 * w + r, kb0 = 64 * tile;
#pragma unroll
                for (int i = 0; i < 16; ++i) { const int kv = kb0 + crow(i, h); if (kv > qi) p0[i] = -1e30f; if (kv + 32 > qi) p1[i] = -1e30f; } }
            float mx = fmaxf(p0[0], p1[0]);
#pragma unroll
            for (int i = 1; i < 16; ++i) mx = fmaxf(mx, fmaxf(p0[i], p1[i]));
            mx = swap_max(mx);
            const float mn = fmaxf(m, mx);
            if (__any(mn > m)) { const float alpha = __builtin_amdgcn_exp2f(m - mn); l *= alpha; m = mn;
                if (h == 0) wsc[r] = alpha;
#pragma unroll
                for (int i = 0; i < 16; ++i) { const float f = wsc[crow(i, h)];
#pragma unroll
                    for (int dh = 0; dh < NDH; ++dh) o[dh][i] *= f; } }
            float ls = 0.f;
#pragma unroll
            for (int i = 0; i < 16; ++i) { p0[i] = __builtin_amdgcn_exp2f(p0[i] - m); p1[i] = __builtin_amdgcn_exp2f(p1[i] - m); ls += p0[i] + p1[i]; }
            l += ls;
            bf16x8 pa[4]; pa[0] = pack8r(p0, 0); pa[1] = pack8r(p0, 8); pa[2] = pack8r(p1, 0); pa[3] = pack8r(p1, 8);
#pragma unroll
            for (int dh = 0; dh < NDH; ++dh)
#pragma unroll
                for (int ks = 0; ks < 4; ++ks) { const ALAS unsigned char* vp = Vb + (32 * dh + r) * VP + (16 * ks + 4 * h) * 2;
                    const bf16x4 lo = *(const ALAS bf16x4*)vp, hi = *(const ALAS bf16x4*)(vp + 16);
                    const bf16x8 vb = {lo[0], lo[1], lo[2], lo[3], hi[0], hi[1], hi[2], hi[3]};
                    o[dh] = __builtin_amdgcn_mfma_f32_32x32x16_bf16(pa[ks], vb, o[dh], 0, 0, 0); }
        }
        if (more) ATT_WRITE((tile + 1) & 1);
        __syncthreads();
    }
#undef ATT_LOAD
#undef ATT_WRITE
    l = swap_add(l);
    if (h == 0) wsc[r] = 1.f / l;
#pragma unroll
    for (int i = 0; i < 16; ++i) { const float f = wsc[crow(i, h)]; bf16* op = t.optr((size_t)b * SEQ + q0 + 32 * w + crow(i, h));
#pragma unroll
        for (int dh = 0; dh < NDH; ++dh) op[32 * dh + r] = f2bf(o[dh][i] * f); }
}
struct MlaT { static constexpr int NDS = 6, NDH = 2, NKV = SEQ; static constexpr bool CAUSAL = true; static constexpr float SCALE = 1.0f;
    const bf16 *Q, *KV, *KR; bf16* O; int head, pad;
    __device__ __forceinline__ const bf16* qptr(size_t row, int d0, int h) const { return d0 < 4 ? Q + row * QW + 64 * head + 16 * d0 + 8 * h : Q + row * QW + 512 + 32 * head + 16 * (d0 - 4) + 8 * h; }
    __device__ __forceinline__ const bf16* kchunk(size_t row, int c) const { return c < 8 ? KV + row * KVW + 64 * head + 8 * c : KR + row * 32 + 8 * (c - 8); }
    __device__ __forceinline__ const bf16* vchunk(size_t row, int c) const { return KV + row * KVW + 512 + 64 * head + 8 * c; }
    __device__ __forceinline__ bf16* optr(size_t row) const { return O + row * 512 + 64 * head; } };
struct CrossT { static constexpr int NDS = 8, NDH = 4, NKV = NMEM; static constexpr bool CAUSAL = false; static constexpr float SCALE = XSCALE;
    const bf16 *Q, *KV; bf16* O; int head, pad;
    __device__ __forceinline__ const bf16* qptr(size_t row, int d0, int h) const { return Q + row * ZXQ_W + 128 * head + 16 * d0 + 8 * h; }
    __device__ __forceinline__ const bf16* kchunk(size_t row, int c) const { return KV + row * 1024 + 128 * head + 8 * c; }
    __device__ __forceinline__ const bf16* vchunk(size_t row, int c) const { return KV + row * 1024 + 512 + 128 * head + 8 * c; }
    __device__ __forceinline__ bf16* optr(size_t row) const { return O + row * 512 + 128 * head; } };

constexpr int G_W = 0, G_B = 4096, G_LA = 4352, G_SEG = G_LA + 64 * 65 * 4, G_QT = G_SEG + 8 * 64 * 4, G_KT = G_QT + 64 * 144, G_VT = G_KT + 64 * 144, G_OT = G_VT + 128 * 144, G_END = G_OT + 64 * 132 * 4;
static_assert(G_END <= 131072 && (G_QT % 16) == 0 && (G_OT % 16) == 0, "gla lds map");
__device__ __forceinline__ void gla_load_w(ALAS unsigned char* lds, const float* w_a2, const float* b_a, int h) {
    ALAS float* W = (ALAS float*)(lds + G_W); ALAS float* Bv = (ALAS float*)(lds + G_B); const int tid = threadIdx.x;
    for (int i = tid; i < 1024; i += 512) W[i] = w_a2[(i >> 6) * 256 + 64 * h + (i & 63)];
    if (tid < 64) Bv[tid] = b_a[64 * h + tid];
}
__device__ __forceinline__ void gla_bcum(ALAS unsigned char* lds, const bf16* zc, size_t row0) {
    const ALAS float* W = (const ALAS float*)(lds + G_W); const ALAS float* Bv = (const ALAS float*)(lds + G_B); ALAS float* LA = (ALAS float*)(lds + G_LA); ALAS float* SEGS = (ALAS float*)(lds + G_SEG);
    const int tid = threadIdx.x; { const int t = tid >> 3, db = tid & 7;
        const u32x4 g0 = *(const u32x4*)(zc + (row0 + t) * ZC_W + ZC_GA), g1 = *(const u32x4*)(zc + (row0 + t) * ZC_W + ZC_GA + 8);
        float ga[16]; ga[0] = __uint_as_float(g0.x << 16); ga[1] = __uint_as_float(g0.x & 0xffff0000u); ga[2] = __uint_as_float(g0.y << 16); ga[3] = __uint_as_float(g0.y & 0xffff0000u);
        ga[4] = __uint_as_float(g0.z << 16); ga[5] = __uint_as_float(g0.z & 0xffff0000u); ga[6] = __uint_as_float(g0.w << 16); ga[7] = __uint_as_float(g0.w & 0xffff0000u);
        ga[8] = __uint_as_float(g1.x << 16); ga[9] = __uint_as_float(g1.x & 0xffff0000u); ga[10] = __uint_as_float(g1.y << 16); ga[11] = __uint_as_float(g1.y & 0xffff0000u);
        ga[12] = __uint_as_float(g1.z << 16); ga[13] = __uint_as_float(g1.z & 0xffff0000u); ga[14] = __uint_as_float(g1.w << 16); ga[15] = __uint_as_float(g1.w & 0xffff0000u);
#pragma unroll
        for (int e = 0; e < 8; ++e) { const int d = 8 * db + e; float pre = Bv[d];
#pragma unroll
            for (int j = 0; j < 16; ++j) pre += ga[j] * W[j * 64 + d];
            LA[t * 65 + d] = (fminf(pre, 0.f) - __logf(1.f + __expf(-fabsf(pre)))) * (1.f / 16.f); } }
    __syncthreads();
    const int d = tid & 63, sg = tid >> 6; float v[8];
#pragma unroll
    for (int i = 0; i < 8; ++i) v[i] = LA[(8 * sg + i) * 65 + d];
#pragma unroll
    for (int i = 1; i < 8; ++i) v[i] += v[i - 1];
    SEGS[sg * 64 + d] = v[7];
    __syncthreads();
    float off = 0.f;
#pragma unroll
    for (int s2 = 0; s2 < 7; ++s2) off += (s2 < sg) ? SEGS[s2 * 64 + d] : 0.f;
#pragma unroll
    for (int i = 0; i < 8; ++i) LA[(8 * sg + i) * 65 + d] = v[i] + off;
    __syncthreads();
}
__device__ __forceinline__ void gla_stage_vt(ALAS unsigned char* lds, const bf16* zg, size_t row0, int h) {
    const int tid = threadIdx.x, lane = tid & 63, w = tid >> 6;
#pragma unroll
    for (int i = 0; i < 2; ++i) { const int c = w + 8 * i; const u32x4 v = *(const u32x4*)(zg + (row0 + lane) * ZG_W + ZG_V + 128 * h + 8 * c);
        ALAS unsigned short* vp = (ALAS unsigned short*)(lds + G_VT + (8 * c) * 144 + lane * 2);
        vp[0 * 72] = (unsigned short)(v.x & 0xffff); vp[1 * 72] = (unsigned short)(v.x >> 16); vp[2 * 72] = (unsigned short)(v.y & 0xffff); vp[3 * 72] = (unsigned short)(v.y >> 16);
        vp[4 * 72] = (unsigned short)(v.z & 0xffff); vp[5 * 72] = (unsigned short)(v.z >> 16); vp[6 * 72] = (unsigned short)(v.w & 0xffff); vp[7 * 72] = (unsigned short)(v.w >> 16); }
}
__device__ __forceinline__ void gla_pass_a(ALAS unsigned char* lds, const bf16* zc, const bf16* zg, float* DS, float* DEC, int b, int h, int n) {
    const int tid = threadIdx.x, lane = tid & 63, r = lane & 31, hh = lane >> 5, w = __builtin_amdgcn_readfirstlane(tid >> 6); const size_t row0 = (size_t)b * SEQ + 64 * n;
    gla_bcum(lds, zc, row0);
    const ALAS float* LA = (const ALAS float*)(lds + G_LA);
    { const int t = tid >> 3, db = tid & 7; const u32x4 kk = *(const u32x4*)(zg + (row0 + t) * ZG_W + ZG_K + 64 * h + 8 * db);
      float kf[8]; kf[0] = __uint_as_float(kk.x << 16); kf[1] = __uint_as_float(kk.x & 0xffff0000u); kf[2] = __uint_as_float(kk.y << 16); kf[3] = __uint_as_float(kk.y & 0xffff0000u);
      kf[4] = __uint_as_float(kk.z << 16); kf[5] = __uint_as_float(kk.z & 0xffff0000u); kf[6] = __uint_as_float(kk.w << 16); kf[7] = __uint_as_float(kk.w & 0xffff0000u);
#pragma unroll
      for (int e = 0; e < 8; ++e) { const int d = 8 * db + e; const float kd = kf[e] * __expf(LA[63 * 65 + d] - LA[t * 65 + d]); *(ALAS unsigned short*)(lds + G_KT + d * 144 + t * 2) = f2bf(kd); } }
    gla_stage_vt(lds, zg, row0, h);
    __syncthreads();
    const int dvt = w >> 1, dt = w & 1; f32x16 acc;
#pragma unroll
    for (int i = 0; i < 16; ++i) acc[i] = 0.f;
#pragma unroll
    for (int ks = 0; ks < 4; ++ks) { const bf16x8 a = *(const ALAS bf16x8*)(lds + G_VT + (32 * dvt + r) * 144 + (16 * ks + 8 * hh) * 2), bb = *(const ALAS bf16x8*)(lds + G_KT + (32 * dt + r) * 144 + (16 * ks + 8 * hh) * 2);
        acc = __builtin_amdgcn_mfma_f32_32x32x16_bf16(a, bb, acc, 0, 0, 0); }
    float* dsp = DS + ((size_t)((b * 4 + h) * GLA_N + n) * 128) * 64;
#pragma unroll
    for (int i = 0; i < 16; ++i) dsp[(32 * dvt + crow(i, hh)) * 64 + 32 * dt + r] = acc[i];
    if (tid < 64) DEC[(size_t)((b * 4 + h) * GLA_N + n) * 64 + tid] = __expf(LA[63 * 65 + tid]);
    __syncthreads();
}
__device__ __forceinline__ void gla_pass_c(ALAS unsigned char* lds, const bf16* zc, const bf16* zg, const bf16* SPREV, const float* o_norm, bf16* OG, int b, int h, int n) {
    const int tid = threadIdx.x, lane = tid & 63, r = lane & 31, hh = lane >> 5, w = __builtin_amdgcn_readfirstlane(tid >> 6); const size_t row0 = (size_t)b * SEQ + 64 * n;
    gla_bcum(lds, zc, row0);
    const ALAS float* LA = (const ALAS float*)(lds + G_LA);
    { const int t = tid >> 3, db = tid & 7; const u32x4 qq = *(const u32x4*)(zg + (row0 + t) * ZG_W + ZG_Q + 64 * h + 8 * db), kk = *(const u32x4*)(zg + (row0 + t) * ZG_W + ZG_K + 64 * h + 8 * db);
      const unsigned qw[4] = {qq.x, qq.y, qq.z, qq.w}, kw[4] = {kk.x, kk.y, kk.z, kk.w}; unsigned qo[4], ko[4];
#pragma unroll
      for (int e = 0; e < 4; ++e) { const float b0 = LA[t * 65 + 8 * db + 2 * e], b1 = LA[t * 65 + 8 * db + 2 * e + 1]; const float e0 = __expf(b0), e1 = __expf(b1), i0 = __expf(-b0), i1 = __expf(-b1);
          qo[e] = pk(__uint_as_float(qw[e] << 16) * 0.125f * e0, __uint_as_float(qw[e] & 0xffff0000u) * 0.125f * e1); ko[e] = pk(__uint_as_float(kw[e] << 16) * i0, __uint_as_float(kw[e] & 0xffff0000u) * i1); }
      *(ALAS u32x4*)(lds + G_QT + t * 144 + db * 16) = (u32x4){qo[0], qo[1], qo[2], qo[3]}; *(ALAS u32x4*)(lds + G_KT + t * 144 + db * 16) = (u32x4){ko[0], ko[1], ko[2], ko[3]}; }
    gla_stage_vt(lds, zg, row0, h);
    __syncthreads();
    const int ci = w >> 2, vi = w & 3; bf16x8 pa[4];
#pragma unroll
    for (int jh = 0; jh < 2; ++jh) { if (jh <= ci) { f32x16 pj;
#pragma unroll
            for (int i = 0; i < 16; ++i) pj[i] = 0.f;
#pragma unroll
            for (int ks = 0; ks < 4; ++ks) { const bf16x8 a = *(const ALAS bf16x8*)(lds + G_KT + (32 * jh + r) * 144 + (16 * ks + 8 * hh) * 2), bb = *(const ALAS bf16x8*)(lds + G_QT + (32 * ci + r) * 144 + (16 * ks + 8 * hh) * 2);
                pj = __builtin_amdgcn_mfma_f32_32x32x16_bf16(a, bb, pj, 0, 0, 0); }
#pragma unroll
            for (int i = 0; i < 16; ++i) if (32 * jh + crow(i, hh) > 32 * ci + r) pj[i] = 0.f;
            pa[2 * jh] = pack8r(pj, 0); pa[2 * jh + 1] = pack8r(pj, 8); } else { pa[2 * jh] = (bf16x8){0, 0, 0, 0, 0, 0, 0, 0}; pa[2 * jh + 1] = pa[2 * jh]; } }
    f32x16 acc;
#pragma unroll
    for (int i = 0; i < 16; ++i) acc[i] = 0.f;
#pragma unroll
    for (int ks = 0; ks < 4; ++ks) { if ((ks >> 1) <= ci) { const ALAS unsigned char* vp = lds + G_VT + (32 * vi + r) * 144 + (16 * ks + 4 * hh) * 2;
            const bf16x4 lo = *(const ALAS bf16x4*)vp, hi = *(const ALAS bf16x4*)(vp + 16); const bf16x8 vb = {lo[0], lo[1], lo[2], lo[3], hi[0], hi[1], hi[2], hi[3]};
            acc = __builtin_amdgcn_mfma_f32_32x32x16_bf16(pa[ks], vb, acc, 0, 0, 0); } }
    const bf16* sp = SPREV + ((size_t)((b * 4 + h) * GLA_N + n) * 128) * 64;
#pragma unroll
    for (int ks = 0; ks < 4; ++ks) { const bf16x8 a = *(const ALAS bf16x8*)(lds + G_QT + (32 * ci + r) * 144 + (16 * ks + 8 * hh) * 2), bb = *(const bf16x8*)(sp + (32 * vi + r) * 64 + 16 * ks + 8 * hh);
        acc = __builtin_amdgcn_mfma_f32_32x32x16_bf16(a, bb, acc, 0, 0, 0); }
    ALAS float* OT = (ALAS float*)(lds + G_OT);
#pragma unroll
    for (int i = 0; i < 16; ++i) OT[(32 * ci + crow(i, hh)) * 132 + 32 * vi + r] = acc[i];
    __syncthreads();
    { const int c = tid >> 3, part = tid & 7; float v[16]; float ss = 0.f;
#pragma unroll
      for (int e = 0; e < 16; ++e) { v[e] = OT[c * 132 + 16 * part + e]; ss += v[e] * v[e]; }
      ss += __shfl_xor(ss, 1); ss += __shfl_xor(ss, 2); ss += __shfl_xor(ss, 4);
      const float rs = rsqrtf(ss * (1.f / 128.f) + EPS);
      const u32x4 g0 = *(const u32x4*)(zg + (row0 + c) * ZG_W + ZG_R + 128 * h + 16 * part), g1 = *(const u32x4*)(zg + (row0 + c) * ZG_W + ZG_R + 128 * h + 16 * part + 8);
      const unsigned gw[8] = {g0.x, g0.y, g0.z, g0.w, g1.x, g1.y, g1.z, g1.w}; unsigned ow[8];
#pragma unroll
      for (int e = 0; e < 8; ++e) { const float r0 = __uint_as_float(gw[e] << 16), r1 = __uint_as_float(gw[e] & 0xffff0000u);
          ow[e] = pk(v[2 * e] * rs * o_norm[16 * part + 2 * e] * (r0 * pg8::fsig(r0)), v[2 * e + 1] * rs * o_norm[16 * part + 2 * e + 1] * (r1 * pg8::fsig(r1))); }
      bf16* op = OG + (row0 + c) * 512 + 128 * h + 16 * part; *(u32x4*)op = (u32x4){ow[0], ow[1], ow[2], ow[3]}; *(u32x4*)(op + 8) = (u32x4){ow[4], ow[5], ow[6], ow[7]}; }
    __syncthreads();
}
#undef ALAS
}
constexpr int NWAVES = 8;
constexpr int RING_OFF = 0, RING_BYTES = 131072;
constexpr int LDSCTL_OFF = RING_BYTES, MISC_OFF = LDSCTL_OFF + 320;
constexpr int LDS_BYTES = 147456;
constexpr int CW_TMO = 0, CW_CODE = 1, CW_BAR = 4096;
constexpr size_t CTL_ZERO_BYTES = 1 * MiB;
constexpr int NPH = 18;
#define GAS __attribute__((address_space(1)))
#define LAS __attribute__((address_space(3)))
typedef unsigned short bf16;
typedef unsigned v4u __attribute__((ext_vector_type(4)));
typedef float f32x4 __attribute__((ext_vector_type(4)));
typedef short bf16x8 __attribute__((ext_vector_type(8)));
typedef GAS unsigned gu32;
typedef GAS unsigned long long gu64;
#define RLX_AGENT __ATOMIC_RELAXED, __HIP_MEMORY_SCOPE_AGENT
#define LDS_WAIT() asm volatile("s_waitcnt lgkmcnt(0)" ::: "memory")
#define VM_WAIT() asm volatile("s_waitcnt vmcnt(0)" ::: "memory")
__device__ __forceinline__ unsigned long long rt() { return __builtin_amdgcn_s_memrealtime(); }
__device__ __forceinline__ unsigned f2bfu(float f) { unsigned u = __builtin_bit_cast(unsigned, f); return (u + 0x7fffu + ((u >> 16) & 1u)) >> 16; }
__device__ __forceinline__ unsigned pk2(float lo, float hi) { return pg8::cvt_pk_bf16(lo, hi); }

#define XB_TMO      128
#define XB_XCNT(j)  (256  + 64 * (j))
#define XB_XSUB(j)  (1280 + 64 * (j))
#define XB_XGEN(j)  (2304 + 64 * (j))
#define XB_TOP      3328
#define XB_TOPGEN   3392
#define XCD_BAR_WORDS 3456
#define XB_SPIN_CAP (1u << 18)

__device__ __forceinline__ unsigned xb_ld(unsigned* p)              { return __hip_atomic_load(p, __ATOMIC_RELAXED, __HIP_MEMORY_SCOPE_AGENT); }
__device__ __forceinline__ unsigned xb_add(unsigned* p, unsigned v) { return __hip_atomic_fetch_add(p, v, __ATOMIC_RELAXED, __HIP_MEMORY_SCOPE_AGENT); }
__device__ __forceinline__ unsigned xb_xcc_id() { return (unsigned)__builtin_amdgcn_s_getreg((3 << 11) | 20) & 0xFu; }
#define XB_SPIN(cond, bar) do { unsigned _sp = 0; while (cond) { __builtin_amdgcn_s_sleep(1); \
    if ((++_sp & 255u) == 0u) { if (xb_ld(&(bar)[XB_TMO])) break; if (_sp > XB_SPIN_CAP) { atomicAdd(&(bar)[XB_TMO], 1u); break; } } } } while (0)

struct XcdBarrier {
    unsigned* bar; unsigned x;
    volatile LAS unsigned* st;
};

__device__ __forceinline__ XcdBarrier xcd_barrier_post(unsigned* bar, volatile LAS unsigned* st) {
    XcdBarrier b; b.bar = bar; b.x = xb_xcc_id(); b.st = st;
    if (threadIdx.x == 0) (void)xb_add(&bar[XB_XCNT(b.x)], 1u);
    return b;
}
__device__ __forceinline__ void xcd_barrier_complete(unsigned* bar, unsigned x, unsigned& nloc, unsigned& nx) {
    const unsigned G = gridDim.x * gridDim.y * gridDim.z;
    unsigned sum, cnt, mine, sp = 0u;
    for (;;) {
        sum = 0u; cnt = 0u; mine = 0u;
#pragma unroll
        for (unsigned j = 0; j < 16; ++j) { const unsigned c = xb_ld(&bar[XB_XCNT(j)]); sum += c; cnt += (c > 0u) ? 1u : 0u; mine = (j == x) ? c : mine; }
        if (sum == G) break;
        __builtin_amdgcn_s_sleep(1);
        if ((++sp & 255u) == 0u) { if (xb_ld(&bar[XB_TMO])) break; if (sp > XB_SPIN_CAP) { atomicAdd(&bar[XB_TMO], 1u); break; } }
    }
    nloc = mine > 0u ? mine : 1u; nx = cnt > 0u ? cnt : 1u;
}

__device__ __forceinline__ void xcd_barrier(const XcdBarrier& b) {
    asm volatile("s_waitcnt vmcnt(0)" ::: "memory");
    __syncthreads();
    if (threadIdx.x == 0) {
        unsigned* bar = b.bar;
        __builtin_amdgcn_s_waitcnt(0);
        unsigned nloc = b.st[0], nx = b.st[1];
        if (nloc == 0u) { xcd_barrier_complete(bar, b.x, nloc, nx); b.st[0] = nloc; b.st[1] = nx; }
        const unsigned old = xb_add(&bar[XB_XSUB(b.x)], 1u);
        const unsigned gen = old / nloc;
        if (old + 1u == (gen + 1u) * nloc) {
            __builtin_amdgcn_fence(__ATOMIC_RELEASE, "agent");
            asm volatile("s_waitcnt vmcnt(0)" ::: "memory");
            const unsigned og = xb_add(&bar[XB_TOP], 1u);
            const unsigned tg = og / nx;
            if (og + 1u == (tg + 1u) * nx) xb_add(&bar[XB_TOPGEN], 1u);
            else XB_SPIN(xb_ld(&bar[XB_TOPGEN]) == tg, bar);
            __builtin_amdgcn_fence(__ATOMIC_ACQUIRE, "agent");
            xb_add(&bar[XB_XGEN(b.x)], 1u);
            asm volatile("s_waitcnt vmcnt(0)" ::: "memory");
        } else {
            XB_SPIN(xb_ld(&bar[XB_XGEN(b.x)]) == gen, bar);
            __builtin_amdgcn_fence(__ATOMIC_ACQUIRE, "agent");
            asm volatile("s_waitcnt vmcnt(0)" ::: "memory");
        }
    }
    __syncthreads();
}

__device__ __forceinline__ float wave_sum(float v) {
#pragma unroll
    for (int o = 1; o < 64; o <<= 1) v += __shfl_xor(v, o);
    return v;
}
struct ConvJob { const float* W; const float* gain; bf16* WT; int ldw, col0, nvalid, K, k0, drow0; };
__device__ __forceinline__ void conv_item(const ConvJob& j, int lane) {
    const int n4 = lane & 7, kg = lane >> 3; f32x4 v[8];
    const bool valid = 4 * n4 < j.nvalid;
#pragma unroll
    for (int i = 0; i < 8; ++i) v[i] = valid ? *(const GAS f32x4*)(j.W + (size_t)(j.k0 + 8 * kg + i) * j.ldw + j.col0 + 4 * n4) : (f32x4){0.f, 0.f, 0.f, 0.f};
    if (j.gain) {
#pragma unroll
        for (int i = 0; i < 8; ++i) v[i] = v[i] * j.gain[j.k0 + 8 * kg + i]; }
#pragma unroll
    for (int e = 0; e < 4; ++e) { v4u o; o.x = pk2(v[0][e], v[1][e]); o.y = pk2(v[2][e], v[3][e]); o.z = pk2(v[4][e], v[5][e]); o.w = pk2(v[6][e], v[7][e]);
        *(GAS v4u*)(j.WT + (size_t)(j.drow0 + 4 * n4 + e) * j.K + j.k0 + 8 * kg) = o; }
}
__device__ __forceinline__ void cvt_row_ss(const float* xrow, bf16* orow, float* ssrow, int lane) {
    const GAS f32x4* xr = (const GAS f32x4*)xrow + lane; f32x4 v[4]; float s = 0.f;
#pragma unroll
    for (int j = 0; j < 4; ++j) { v[j] = xr[64 * j]; s += (v[j].x * v[j].x + v[j].y * v[j].y) + (v[j].z * v[j].z + v[j].w * v[j].w); }
    s = wave_sum(s); if (lane == 0) *ssrow = s;
    GAS unsigned long long* o8 = (GAS unsigned long long*)orow + lane;
#pragma unroll
    for (int j = 0; j < 4; ++j) o8[64 * j] = (unsigned long long)pk2(v[j].x, v[j].y) | ((unsigned long long)pk2(v[j].z, v[j].w) << 32);
}
__device__ __forceinline__ void rms_row_to_bf16(const float* xrow, const float* g, bf16* orow, int lane) {
    const GAS f32x4* xr = (const GAS f32x4*)xrow + lane; const GAS f32x4* gr = (const GAS f32x4*)g + lane;
    f32x4 v[4]; float s = 0.f;
#pragma unroll
    for (int j = 0; j < 4; ++j) { v[j] = xr[64 * j]; s += (v[j].x * v[j].x + v[j].y * v[j].y) + (v[j].z * v[j].z + v[j].w * v[j].w); }
    const float rs = rsqrtf(wave_sum(s) * (1.f / D) + EPS);
    GAS unsigned long long* o8 = (GAS unsigned long long*)orow + lane;
#pragma unroll
    for (int j = 0; j < 4; ++j) { const f32x4 gg = gr[64 * j]; o8[64 * j] = (unsigned long long)pk2(v[j].x * rs * gg.x, v[j].y * rs * gg.y) | ((unsigned long long)pk2(v[j].z * rs * gg.z, v[j].w * rs * gg.w) << 32); }
}
__device__ __forceinline__ void rms_row_to_f32(float* xrow, const float* g, int lane) {
    GAS f32x4* xr = (GAS f32x4*)xrow + lane; const GAS f32x4* gr = (const GAS f32x4*)g + lane;
    f32x4 v[4]; float s = 0.f;
#pragma unroll
    for (int j = 0; j < 4; ++j) { v[j] = xr[64 * j]; s += (v[j].x * v[j].x + v[j].y * v[j].y) + (v[j].z * v[j].z + v[j].w * v[j].w); }
    const float rs = rsqrtf(wave_sum(s) * (1.f / D) + EPS);
#pragma unroll
    for (int j = 0; j < 4; ++j) { const f32x4 gg = gr[64 * j]; xr[64 * j] = v[j] * rs * gg; }
}

struct Args { P p; int ph_lo, ph_hi, li, pad; };
__global__ void __launch_bounds__(NWAVES * 64, 2) mega(Args args) {
    extern __shared__ __attribute__((aligned(16))) unsigned char lds_raw[];
    LAS unsigned char* lds = (LAS unsigned char*)lds_raw;
    volatile LAS unsigned* MISC = (volatile LAS unsigned*)(lds + MISC_OFF);
    const int tid = threadIdx.x, lane = tid & 63, wave = __builtin_amdgcn_readfirstlane(tid >> 6);
    const int G = gridDim.x; const int bx = blockIdx.x; const int vcu = (G % 8 == 0) ? (bx % 8) * (G / 8) + bx / 8 : bx;
    const P& p = args.p; unsigned char* ws = p.ws;
    gu32* ctl = (gu32*)(ws + WS_CTL);
    for (int u = tid; u < (LDS_BYTES - LDSCTL_OFF) / 4; u += NWAVES * 64) ((LAS unsigned*)(lds + LDSCTL_OFF))[u] = 0u;
#ifdef LDSPOISON
    for (int u = tid; u < RING_BYTES / 16; u += NWAVES * 64) ((LAS v4u*)lds)[u] = (v4u){0x7fc07fc0u, 0x7fc07fc0u, 0x7fc07fc0u, 0x7fc07fc0u};
#endif
    __syncthreads();
    XcdBarrier bar = xcd_barrier_post((unsigned*)(ctl + CW_BAR) + args.li * XCD_BAR_WORDS, MISC + 8);
    const int lo = args.ph_lo, hi = args.ph_hi;
#ifndef PHMASK
#define PHMASK 0x3ffff
#endif
#ifndef REPMASK
#define REPMASK 0
#endif
#define REPS(k) for (int rep_ = 0; rep_ <= ((REPMASK >> (k)) & 1); ++rep_) { if (rep_) xcd_barrier(bar);
#define REPE }
#define IN(k) (((PHMASK >> (k)) & 1) && lo <= (k) && (k) < hi)
#define SEAM(k) do { if (IN(k) && IN((k) + (((k) == 2 || (k) == 13) ? 2 : 1))) xcd_barrier(bar); } while (0)
    float *cs = (float*)(ws + WS_COS), *sn = (float*)(ws + WS_SIN), *ssqq = (float*)(ws + WS_SSQQ), *ssqkv = (float*)(ws + WS_SSQKV);
    bf16 *XN = (bf16*)(ws + WS_XN), *MEMN = (bf16*)(ws + WS_MEMN), *ACT = (bf16*)(ws + SC_ACT), *OMLA = (bf16*)(ws + SC_OMLA), *OX = (bf16*)(ws + SC_OX), *KVX = (bf16*)(ws + SC_KVX),
         *GZ = (bf16*)(ws + SC_GZ), *ZC = (bf16*)(ws + SC_ZC), *ZKV = (bf16*)(ws + SC_ZKV), *ZG = (bf16*)(ws + SC_ZG), *ZXQ = OX, *Q = (bf16*)(ws + SC_Q), *KVM = (bf16*)(ws + SC_KVM), *KR = (bf16*)(ws + SC_KR),
         *MERGED = (bf16*)(ws + SC_MERGED);
    float *SS1 = (float*)(ws + WS_SS1), *SS2 = (float*)(ws + WS_SS2), *SS3 = (float*)(ws + WS_SS3); bf16* XN3 = (bf16*)(ws + SC_XN3);
    const int gw = vcu * NWAVES + wave, NGW = G * NWAVES;

    if (IN(0)) REPS(0) {
        constexpr int I_GU = 16 * 176, I_D = 44 * 32, I_IN1 = 16 * 88, I_GZ = 16 * 96, I_UQ = 6 * 24, I_UKV = 4 * 32, I_O = 8 * 32, I_SQ = 16 * 32;
        constexpr int NITEMS = 2 * I_GU + 2 * I_D + I_IN1 + I_GZ + I_UQ + I_UKV + 3 * I_O + 2 * I_SQ;
        for (int it = gw; it < NITEMS; it += NGW) {
            int r = it; ConvJob j; j.gain = nullptr; j.nvalid = 32;
            if (r < 2 * I_GU) { const int second = r >= I_GU; if (second) r -= I_GU; const int kb = r / 176, rb = r % 176, tile = rb >> 3, sub = rb & 7;
                j.W = sub < 4 ? (second ? p.ffn2_wg : p.ffn1_wg) : (second ? p.ffn2_wu : p.ffn1_wu); j.ldw = FF; j.col0 = 128 * tile + 32 * (sub & 3); j.gain = second ? p.ffn2_norm : p.ffn1_norm; j.K = D; j.k0 = 64 * kb; j.WT = (bf16*)(ws + (second ? WS_WGU2 : WS_WGU1)); j.drow0 = 32 * rb; }
            else if ((r -= 2 * I_GU) < 2 * I_D) { const int second = r >= I_D; if (second) r -= I_D; const int kb = r / 32, rb = r % 32;
                j.W = second ? p.ffn2_wd : p.ffn1_wd; j.ldw = D; j.col0 = 32 * rb; j.K = FF; j.k0 = 64 * kb; j.WT = (bf16*)(ws + (second ? WS_WD2 : WS_WD1)); j.drow0 = 32 * rb; }
            else if ((r -= 2 * I_D) < I_IN1) { const int kb = r / 88, rb = r % 88; const int s = e1_src(32 * rb);
                j.W = p.w_in; j.ldw = DIN; j.col0 = s < 0 ? 0 : s; j.nvalid = s < 0 ? 0 : (32 * rb == ZC_GA ? 16 : 32); j.gain = p.mix_norm; j.K = D; j.k0 = 64 * kb; j.WT = (bf16*)(ws + WS_WIN1); j.drow0 = 32 * rb; }
            else if ((r -= I_IN1) < I_GZ) { const int kb = r / 96, rb = r % 96;
                j.W = p.w_in; j.ldw = DIN; j.col0 = 2736 + 32 * rb; j.gain = p.mix_norm; j.K = D; j.k0 = 64 * kb; j.WT = (bf16*)(ws + WS_WGZ); j.drow0 = 32 * rb; }
            else if ((r -= I_GZ) < I_UQ) { const int kb = r / 24, rb = r % 24, r0 = 32 * rb;
                j.W = p.w_uq; j.ldw = 768; j.col0 = r0 < 512 ? 96 * (r0 >> 6) + (r0 & 63) : 96 * ((r0 - 512) >> 5) + 64; j.gain = p.q_norm; j.K = 384; j.k0 = 64 * kb; j.WT = (bf16*)(ws + WS_WUQ); j.drow0 = r0; }
            else if ((r -= I_UQ) < I_UKV) { const int kb = r / 32, rb = r % 32, r0 = 32 * rb;
                j.W = p.w_ukv; j.ldw = 1024; j.col0 = r0 < 512 ? 128 * (r0 >> 6) + (r0 & 63) : 128 * ((r0 - 512) >> 6) + 64 + (r0 & 63); j.gain = p.kv_norm; j.K = 256; j.k0 = 64 * kb; j.WT = (bf16*)(ws + WS_WUKV); j.drow0 = r0; }
            else if ((r -= I_UKV) < 3 * I_O) { const int which = r / I_O; r -= which * I_O; const int kb = r / 32, rb = r % 32;
                j.W = which == 0 ? p.w_o_mla : which == 1 ? p.w_o_gla : p.x_w_o; j.ldw = D; j.col0 = 32 * rb; j.K = 512; j.k0 = 64 * kb; j.WT = (bf16*)(ws + WS_WOM + (size_t)which * MiB); j.drow0 = 32 * rb; }
            else { r -= 3 * I_O; const int which = r / I_SQ; r -= which * I_SQ; const int kb = r / 32, rb = r % 32;
                j.W = which == 0 ? p.x_w_kv : p.w_out; j.ldw = D; j.col0 = 32 * rb; j.K = D; j.k0 = 64 * kb; j.WT = (bf16*)(ws + (which == 0 ? WS_WXKV : WS_WOUT)); j.drow0 = 32 * rb; }
            conv_item(j, lane);
        }
        for (int m = gw; m < M; m += NGW) cvt_row_ss(p.x + (size_t)m * D, XN + (size_t)m * D, SS1 + m, lane);
        for (int m = gw; m < MMEM; m += NGW) rms_row_to_bf16(p.mem + (size_t)m * D, p.mem_norm, MEMN + (size_t)m * D, lane);
        for (int i = vcu * NWAVES * 64 + tid; i < M * 16; i += G * NWAVES * 64) { const int m = i >> 4, jj = i & 15;
            const float inv = powf(10000.f, -(float)jj / 16.f); const float ang = (float)p.pos[m] * inv; cs[i] = cosf(ang); sn[i] = sinf(ang); }
    }
    REPE
    SEAM(0);
#define GEMM_PHASE(EPI, ORDER, g, S, E) pg8::gemm_phase<EPI, ORDER, true, true>(lds + RING_OFF, g, S, E)
    if (IN(1)) REPS(1) { pg8::Gemm g{XN, (const bf16*)(ws + WS_WGU1), 0, 0, D, D, D, 0}; pg8::StaticOrder S; S.init(M, 2 * FF, G, bx); pg8::EpiSwiGLU E{ACT, SS1, FF, 0}; GEMM_PHASE(pg8::EpiSwiGLU, pg8::StaticOrder, g, S, E); }
    REPE
    SEAM(1);
    if (IN(2)) { pg8::Gemm g{ACT, (const bf16*)(ws + WS_WD1), 0, 0, FF, FF, FF, 0}; pg8::StaticOrder S; S.init(M, D, G, bx); pg8::EpiResid E{p.x, p.out, XN, SS2, 0.5f, 0}; GEMM_PHASE(pg8::EpiResid, pg8::StaticOrder, g, S, E); }
    SEAM(2);
    if (IN(4)) {
        { pg8::Gemm g{XN, (const bf16*)(ws + WS_WIN1), 0, 0, D, D, D, 0}; pg8::StaticOrder S; S.init(M, Z1_W, G, bx); pg8::EpiZ1 E{ZC, ZKV, ZG, ZXQ, ssqq, ssqkv, SS2}; GEMM_PHASE(pg8::EpiZ1, pg8::StaticOrder, g, S, E); }
        { pg8::Gemm g{MEMN, (const bf16*)(ws + WS_WXKV), 0, 0, D, D, D, 0}; pg8::StaticOrder S; S.init(MMEM, 1024, G, (bx + 64) % G); pg8::EpiPlain E{KVX, 1024, 0}; GEMM_PHASE(pg8::EpiPlain, pg8::StaticOrder, g, S, E); }
    }
    SEAM(4);
    float* DSb = (float*)(ws + SC_DS); float* DECb = (float*)(ws + SC_DEC); bf16* SPREV = (bf16*)(ws + SC_SPREV); bf16* OGLA = (bf16*)(ws + SC_OGLA);
    if (IN(5)) REPS(5) { int lasth = -1;
        for (int u = vcu; u < NB * 4 * GLA_N; u += G) { const int n = u & 31, h = (u >> 5) & 3, b = u >> 7;
            if (h != lasth) { __syncthreads(); att::gla_load_w(lds, p.w_a2, p.b_a, h); __syncthreads(); lasth = h; }
            att::gla_pass_a(lds, ZC, ZG, DSb, DECb, b, h, n); } }
    REPE
    SEAM(5);
    if (IN(6)) REPS(6) { for (int gid = vcu * NWAVES * 64 + tid; gid < NB * 4 * 4096; gid += G * NWAVES * 64) { const int bh = gid >> 12, e2 = gid & 4095, dv = e2 >> 5, d = 2 * (e2 & 31); float s0 = 0.f, s1 = 0.f;
            const float* dsp = DSb + ((size_t)bh * GLA_N * 128 + dv) * 64 + d; const float* dcp = DECb + (size_t)bh * GLA_N * 64 + d; bf16* spp = SPREV + ((size_t)bh * GLA_N * 128 + dv) * 64 + d;
#pragma unroll 4
            for (int n = 0; n < GLA_N; ++n) { *(unsigned*)(spp + (size_t)n * 8192) = pk2(s0, s1); const float2 ds = *(const float2*)(dsp + (size_t)n * 8192), dc = *(const float2*)(dcp + n * 64); s0 = dc.x * s0 + ds.x; s1 = dc.y * s1 + ds.y; } } }
    REPE
    SEAM(6);
    if (IN(7)) REPS(7) { int lasth = -1;
        for (int u = vcu; u < NB * 4 * GLA_N; u += G) { const int n = u & 31, h = (u >> 5) & 3, b = u >> 7;
            if (h != lasth) { __syncthreads(); att::gla_load_w(lds, p.w_a2, p.b_a, h); __syncthreads(); lasth = h; }
            att::gla_pass_c(lds, ZC, ZG, SPREV, p.o_norm, OGLA, b, h, n); } }
    REPE
    SEAM(7);
    if (IN(8)) REPS(8) {
        for (int i = vcu * NWAVES * 64 + tid; i < M * 16; i += G * NWAVES * 64) { const int r = i >> 4, jj = i & 15; const float c = cs[i], s = sn[i];
            const bf16* z = ZC + (size_t)r * ZC_W + ZC_KROPE; const float x1 = bf2f(z[jj]), x2 = bf2f(z[jj + 16]); KR[(size_t)r * 32 + jj] = f2bf(x1 * c - x2 * s); KR[(size_t)r * 32 + jj + 16] = f2bf(x1 * s + x2 * c); }
        { pg8::Gemm g{ZC, (const bf16*)(ws + WS_WUQ), 0, 0, ZC_W, 384, 384, 0}; pg8::StaticOrder S; S.init(M, QW, G, bx); pg8::EpiQ E{Q, ssqq, cs, sn}; GEMM_PHASE(pg8::EpiQ, pg8::StaticOrder, g, S, E); }
        { pg8::Gemm g{ZKV, (const bf16*)(ws + WS_WUKV), 0, 0, ZKV_W, 256, 256, 0}; pg8::StaticOrder S; S.init(M, KVW, G, (bx + 192) % G); pg8::EpiKV E{KVM, ssqkv}; GEMM_PHASE(pg8::EpiKV, pg8::StaticOrder, g, S, E); }
    }
    REPE
    SEAM(8);
    if (IN(9)) REPS(9) { for (int it = vcu; it < NB * 8 * 4; it += G) { const int s4 = it & 3, hd = (it >> 2) & 7, b = it >> 5; att::MlaT T{Q, KVM, KR, OMLA, hd, 0};
            att::attn_unit<att::MlaT>(lds, T, b, 7 - s4); att::attn_unit<att::MlaT>(lds, T, b, s4); } }
    REPE
    SEAM(9);
    if (IN(10)) { for (int it = vcu; it < NB * 4 * 8; it += G) { const int qb = it & 7, hd = (it >> 3) & 3, b = it >> 5; att::CrossT T{ZXQ, KVX, OX, hd, 0}; att::attn_unit<att::CrossT>(lds, T, b, qb); } }
    SEAM(10);
    if (IN(11)) REPS(11) { pg8::Gemm g{XN, (const bf16*)(ws + WS_WGZ), 0, 0, D, D, D, 0}; pg8::StaticOrder S; S.init(M, 3072, G, bx);
#ifdef X3
        pg8::EpiPlain E{GZ, 3072, 0}; GEMM_PHASE(pg8::EpiPlain, pg8::StaticOrder, g, S, E);
#else
        pg8::EpiGate E{GZ, p.gate_bias, SS2}; GEMM_PHASE(pg8::EpiGate, pg8::StaticOrder, g, S, E);
#endif
    }
    REPE
    SEAM(11);
    if (IN(12)) REPS(12) { pg8::Gemm g{OMLA, (const bf16*)(ws + WS_WOM), (size_t)16 * MiB, (size_t)1 * MiB, 512, 512, 512, 0}; pg8::MergeOrder S; S.init(M, D, G, bx); pg8::EpiMerge E{MERGED, GZ}; GEMM_PHASE(pg8::EpiMerge, pg8::MergeOrder, g, S, E); }
    REPE
    SEAM(12);
    if (IN(13)) { pg8::Gemm g{MERGED, (const bf16*)(ws + WS_WOUT), 0, 0, D, D, D, 0}; pg8::StaticOrder S; S.init(M, D, G, bx); pg8::EpiResid E{p.out, p.out, XN3, SS3, 1.0f, 0}; GEMM_PHASE(pg8::EpiResid, pg8::StaticOrder, g, S, E); }
    SEAM(13);
    if (IN(15)) { pg8::Gemm g{XN3, (const bf16*)(ws + WS_WGU2), 0, 0, D, D, D, 0}; pg8::StaticOrder S; S.init(M, 2 * FF, G, bx); pg8::EpiSwiGLU E{ACT, SS3, FF, 0}; GEMM_PHASE(pg8::EpiSwiGLU, pg8::StaticOrder, g, S, E); }
    SEAM(15);
    if (IN(16)) {
        if (G == 256) {
            pg8::Gemm g{ACT, (const bf16*)(ws + WS_WD2), 0, 0, FF, FF, FF, 0}; pg8::StaticOrder S; S.init(M, D, G, bx);
            pg8::EpiFinal E{p.out, p.out, p.final_norm, (float*)(ws + WS_SSF), (unsigned*)(ws + WS_FCNT), 0.5f, 0}; pg8::gemm_phase<pg8::EpiFinal, pg8::StaticOrder, false, true>(lds + RING_OFF, g, S, E);
        } else {
            { pg8::Gemm g{ACT, (const bf16*)(ws + WS_WD2), 0, 0, FF, FF, FF, 0}; pg8::StaticOrder S; S.init(M, D, G, bx); pg8::EpiResid E{p.out, p.out, nullptr, nullptr, 0.5f, 0}; GEMM_PHASE(pg8::EpiResid, pg8::StaticOrder, g, S, E); }
            xcd_barrier(bar);
            for (int m = gw; m < M; m += NGW) rms_row_to_f32(p.out + (size_t)m * D, p.final_norm, lane);
        }
    }
#undef IN
#undef SEAM
}

#ifndef FASTMASK
#define FASTMASK 0x3FFFFu
#endif
extern "C" void kernel_launch(void* const* d_in, const int* in_sizes, int n_in, void* d_out, int out_size, void* d_ws, size_t ws_size, hipStream_t stream) {
    if (n_in != 28 || in_sizes[0] != M * D || out_size != M * D || ws_size < WS_END) { fprintf(stderr, "kernel_launch: unexpected shapes (n_in %d, in0 %d, out %d, ws %zu)\n", n_in, n_in > 0 ? in_sizes[0] : -1, out_size, ws_size); return; }
    static int grid = 0;
    if (grid == 0) {
        int dev = 0, cus = 0;
        if (hipGetDevice(&dev) != hipSuccess || hipDeviceGetAttribute(&cus, hipDeviceAttributeMultiprocessorCount, dev) != hipSuccess) { fprintf(stderr, "kernel_launch: device query failed\n"); grid = -1; return; }
        if (hipFuncSetAttribute((const void*)mega, hipFuncAttributeMaxDynamicSharedMemorySize, LDS_BYTES) != hipSuccess) { fprintf(stderr, "kernel_launch: hipFuncSetAttribute failed\n"); grid = -1; return; }
        int per_cu = 0; if (hipOccupancyMaxActiveBlocksPerMultiprocessor(&per_cu, (const void*)mega, NWAVES * 64, LDS_BYTES) != hipSuccess || per_cu < 1) fprintf(stderr, "kernel_launch: occupancy query says %d\n", per_cu);
        (void)hipGetLastError();
        grid = cus;
    }
    if (grid < 0) return;
    P p{};
    p.x = (const float*)d_in[0]; p.mem = (const float*)d_in[1]; p.pos = (const int*)d_in[2];
    p.ffn1_norm = (const float*)d_in[3]; p.ffn1_wg = (const float*)d_in[4]; p.ffn1_wu = (const float*)d_in[5]; p.ffn1_wd = (const float*)d_in[6]; p.mix_norm = (const float*)d_in[7]; p.mem_norm = (const float*)d_in[8];
    p.w_in = (const float*)d_in[9]; p.gate_bias = (const float*)d_in[10]; p.q_norm = (const float*)d_in[11]; p.w_uq = (const float*)d_in[12]; p.kv_norm = (const float*)d_in[13]; p.w_ukv = (const float*)d_in[14];
    p.w_o_mla = (const float*)d_in[15]; p.w_a2 = (const float*)d_in[16]; p.b_a = (const float*)d_in[17]; p.o_norm = (const float*)d_in[18]; p.w_o_gla = (const float*)d_in[19]; p.x_w_kv = (const float*)d_in[20];
    p.x_w_o = (const float*)d_in[21]; p.w_out = (const float*)d_in[22]; p.ffn2_norm = (const float*)d_in[23]; p.ffn2_wg = (const float*)d_in[24]; p.ffn2_wu = (const float*)d_in[25]; p.ffn2_wd = (const float*)d_in[26];
    p.final_norm = (const float*)d_in[27]; p.out = (float*)d_out; p.ws = (unsigned char*)d_ws;
    unsigned char* ws = p.ws;
    float *cs = (float*)(ws + WS_COS), *sn = (float*)(ws + WS_SIN), *ssqq = (float*)(ws + WS_SSQQ), *ssqkv = (float*)(ws + WS_SSQKV);
    bf16 *XN = (bf16*)(ws + WS_XN), *MEMN = (bf16*)(ws + WS_MEMN), *ACT = (bf16*)(ws + SC_ACT), *OMLA = (bf16*)(ws + SC_OMLA), *OGLA = (bf16*)(ws + SC_OGLA), *OX = (bf16*)(ws + SC_OX), *KVX = (bf16*)(ws + SC_KVX),
         *GZ = (bf16*)(ws + SC_GZ), *ZC = (bf16*)(ws + SC_ZC), *ZKV = (bf16*)(ws + SC_ZKV), *ZG = (bf16*)(ws + SC_ZG), *ZXQ = OX, *Q = (bf16*)(ws + SC_Q), *KVM = (bf16*)(ws + SC_KVM), *KR = (bf16*)(ws + SC_KR),
         *MERGED = (bf16*)(ws + SC_MERGED);
    float* OTMP = (float*)(ws + SC_DS);
    (void)hipMemsetAsync((char*)d_ws + WS_CTL, 0, CTL_ZERO_BYTES, stream);
    const unsigned mask = FASTMASK; int li = 0;
    for (int ph = 0; ph < NPH; ) {
        const bool fast = (mask >> (ph >= 5 && ph <= 7 ? 5 : ph)) & 1u;
        if (fast) { int e = ph + 1; while (e < NPH && ((mask >> (e >= 5 && e <= 7 ? 5 : e)) & 1u)) ++e;
            Args a{}; a.p = p; a.ph_lo = ph; a.ph_hi = e; a.li = li++; a.pad = 0;
            hipLaunchKernelGGL(mega, dim3(grid), dim3(NWAVES * 64), LDS_BYTES, stream, a);
#ifdef X3
            if (ph == 11) n_gate_fin<<<M * 3072 / 256, 256, 0, stream>>>(GZ, p.gate_bias);
#endif
#ifdef X2
            if (ph == 11) n_gemm<1, DGate><<<dim3(3072 / 64, M / 64), 256, 0, stream>>>(DGate{XN, p.w_in, p.gate_bias, GZ, M, 3072, D, 0});
#endif
            ph = e; continue; }
        switch (ph) {
        case 0: n_rope_tab<<<M * 16 / 256, 256, 0, stream>>>(p.pos, cs, sn); n_rmsnorm<false><<<M / 4, 256, 0, stream>>>(p.x, p.ffn1_norm, XN, nullptr, M); n_rmsnorm<false><<<MMEM / 4, 256, 0, stream>>>(p.mem, p.mem_norm, MEMN, nullptr, MMEM); break;
        case 1: n_gemm<2, DUp><<<dim3(FF / 64, M / 64), 256, 0, stream>>>(DUp{XN, p.ffn1_wg, p.ffn1_wu, ACT, M, FF, D, 0}); break;
        case 2: n_gemm<1, DRes><<<dim3(D / 64, M / 64), 256, 0, stream>>>(DRes{ACT, p.ffn1_wd, p.x, p.out, M, D, FF, FF, 0.5f, 0}); break;
        case 3: n_rmsnorm<false><<<M / 4, 256, 0, stream>>>(p.out, p.mix_norm, XN, nullptr, M); break;
        case 4: n_gemm<1, DE1><<<dim3(Z1_W / 64, M / 64), 256, 0, stream>>>(DE1{XN, p.w_in, ZC, ZKV, ZG, ZXQ, M, Z1_W, D, 0});
                n_gemm<1, DPlain><<<dim3(1024 / 64, MMEM / 64), 256, 0, stream>>>(DPlain{MEMN, p.x_w_kv, KVX, MMEM, 1024, D, D, 1024, 1024});
                n_ssq<<<(M * 20 + 255) / 256, 256, 0, stream>>>(ZC, ZKV, ssqq, ssqkv); break;
        case 5: n_gla_rec<<<NB * 4, 128, 0, stream>>>(ZC, ZG, p.w_a2, p.b_a, OTMP); n_gla_fin<<<M * 4 / 4, 256, 0, stream>>>(OTMP, ZG, p.o_norm, OGLA); break;
        case 6: case 7: break;
        case 8: n_gemm<1, DQ><<<dim3(QW / 64, M / 64), 256, 0, stream>>>(DQ{ZC, p.w_uq, p.q_norm, ssqq, Q, M, QW, 384, 0});
                n_gemm<1, DKV><<<dim3(KVW / 64, M / 64), 256, 0, stream>>>(DKV{ZKV, p.w_ukv, p.kv_norm, ssqkv, KVM, M, KVW, 256, 0});
                n_rope<<<(M * 144 + 255) / 256, 256, 0, stream>>>(Q, ZC, KR, cs, sn); break;
        case 9: n_mla_attn<<<NB * 8 * SEQ * 4 / 256, 256, 0, stream>>>(Q, KVM, KR, OMLA); break;
        case 10: { bf16* OXT = (bf16*)(ws + SC_DS); n_cross_attn<<<NB * 4 * SEQ * 4 / 256, 256, 0, stream>>>(ZXQ, KVX, OXT); (void)hipMemcpyAsync(OX, OXT, (size_t)M * 512 * 2, hipMemcpyDeviceToDevice, stream); } break;
        case 11: n_gemm<1, DGate><<<dim3(3072 / 64, M / 64), 256, 0, stream>>>(DGate{XN, p.w_in, p.gate_bias, GZ, M, 3072, D, 0}); break;
        case 12: n_gemm<3, DMerge><<<dim3(D / 64, M / 64), 256, 0, stream>>>(DMerge{OMLA, p.w_o_mla, p.w_o_gla, p.x_w_o, GZ, MERGED, M, D, 512, 0}); break;
        case 13: n_gemm<1, DRes><<<dim3(D / 64, M / 64), 256, 0, stream>>>(DRes{MERGED, p.w_out, p.out, p.out, M, D, D, D, 1.0f, 0}); break;
        case 14: n_rmsnorm<false><<<M / 4, 256, 0, stream>>>(p.out, p.ffn2_norm, XN, nullptr, M); break;
        case 15: n_gemm<2, DUp><<<dim3(FF / 64, M / 64), 256, 0, stream>>>(DUp{XN, p.ffn2_wg, p.ffn2_wu, ACT, M, FF, D, 0}); break;
        case 16: n_gemm<1, DRes><<<dim3(D / 64, M / 64), 256, 0, stream>>>(DRes{ACT, p.ffn2_wd, p.out, p.out, M, D, FF, FF, 0.5f, 0}); break;
        case 17: n_rmsnorm<true><<<M / 4, 256, 0, stream>>>(p.out, p.final_norm, nullptr, p.out, M); break;
        }
        ++ph;
    }
}
```

```cpp
#include <hip/hip_runtime.h>
#include <cstdint>
#include <cstdio>


typedef unsigned short bf16;
__device__ __forceinline__ float bf2f(bf16 v) { return __uint_as_float((unsigned)v << 16); }
__device__ __forceinline__ bf16 f2bf(float f) { unsigned u = __float_as_uint(f); return (bf16)((u + 0x7fffu + ((u >> 16) & 1u)) >> 16); }

constexpr int NB = 8, SEQ = 2048, D = 1024, M = NB * SEQ, NMEM = 256, MMEM = NB * NMEM, FF = 2816, DIN = 5808;
constexpr float EPS = 1e-6f;
constexpr int ZC_W = 512, ZKV_W = 256, ZG_W = 1536, ZXQ_W = 512, Z1_W = 2816;
constexpr int ZC_KROPE = 384, ZC_GA = 416;
constexpr int ZG_Q = 0, ZG_K = 256, ZG_V = 512, ZG_R = 1024;
constexpr int QW = 768, KVW = 1024;
constexpr float QSCALE = 0.10206207261596577f * 1.4426950408889634f;
constexpr float XSCALE = 0.08838834764831845f * 1.4426950408889634f;
constexpr int GLA_N = SEQ / 64;

constexpr size_t MiB = 1u << 20;
constexpr size_t WS_CTL = 0, WS_COS = 1 * MiB, WS_SIN = 2 * MiB, WS_SSQQ = 3 * MiB, WS_SSQKV = 4 * MiB;
constexpr size_t WS_WGU1 = 5 * MiB, WS_WD1 = 16 * MiB, WS_WIN1 = 21 * MiB + 512 * 1024, WS_WGZ = 27 * MiB, WS_WUQ = 33 * MiB, WS_WUKV = 34 * MiB, WS_WOM = 35 * MiB, WS_WOG = 36 * MiB,
                 WS_WOX = 37 * MiB, WS_WXKV = 38 * MiB, WS_WOUT = 40 * MiB, WS_WGU2 = 42 * MiB, WS_WD2 = 53 * MiB;
constexpr size_t WS_MEMN = 59 * MiB, WS_XN = 63 * MiB, WS_SCR = 95 * MiB;
constexpr size_t SC_ACT = WS_SCR, SC_OMLA = WS_SCR, SC_OGLA = WS_SCR + 16 * MiB, SC_OX = WS_SCR + 32 * MiB, SC_KVX = WS_SCR + 48 * MiB, SC_GZ = WS_SCR + 52 * MiB,
                 SC_ZC = WS_SCR + 52 * MiB, SC_ZKV = WS_SCR + 68 * MiB, SC_ZG = WS_SCR + 76 * MiB, SC_DS = WS_SCR + 124 * MiB, SC_DEC = WS_SCR + 156 * MiB, SC_SPREV = WS_SCR,
                 SC_Q = WS_SCR + 76 * MiB, SC_KVM = WS_SCR + 100 * MiB, SC_KR = WS_SCR + 132 * MiB, SC_MERGED = WS_XN;
constexpr size_t WS_SS2 = WS_CTL + 512 * 1024, WS_SS3 = WS_CTL + 576 * 1024, WS_SS1 = WS_CTL + 640 * 1024;
constexpr size_t WS_SSF = WS_CTL + 704 * 1024, WS_FCNT = WS_CTL + 768 * 1024;
constexpr size_t SC_XN3 = WS_SCR + 96 * MiB;
constexpr size_t WS_END = 256 * MiB;
static_assert(SC_DEC + MiB <= WS_END && SC_GZ + 96 * MiB <= WS_END, "ws map");

struct P {
    const float *x, *mem; const int* pos;
    const float *ffn1_norm, *ffn1_wg, *ffn1_wu, *ffn1_wd, *mix_norm, *mem_norm, *w_in, *gate_bias, *q_norm, *w_uq, *kv_norm, *w_ukv, *w_o_mla, *w_a2, *b_a, *o_norm, *w_o_gla,
        *x_w_kv, *x_w_o, *w_out, *ffn2_norm, *ffn2_wg, *ffn2_wu, *ffn2_wd, *final_norm;
    float* out; unsigned char* ws;
};

template <bool F32OUT> __global__ void __launch_bounds__(256) n_rmsnorm(const float* in, const float* g, bf16* outb, float* outf, int rows) {
    const int row = blockIdx.x * 4 + (threadIdx.x >> 6), lane = threadIdx.x & 63; if (row >= rows) return;
    const float* r = in + (size_t)row * D; float v[16]; float s = 0.f;
#pragma unroll
    for (int j = 0; j < 16; ++j) { v[j] = r[lane + 64 * j]; s += v[j] * v[j]; }
#pragma unroll
    for (int o = 1; o < 64; o <<= 1) s += __shfl_xor(s, o);
    const float rs = rsqrtf(s * (1.f / D) + EPS);
#pragma unroll
    for (int j = 0; j < 16; ++j) { const float y = v[j] * rs * g[lane + 64 * j]; if (F32OUT) outf[(size_t)row * D + lane + 64 * j] = y; else outb[(size_t)row * D + lane + 64 * j] = f2bf(y); }
}
__global__ void __launch_bounds__(256) n_rope_tab(const int* pos, float* cs, float* sn) {
    const int i = blockIdx.x * 256 + threadIdx.x; if (i >= M * 16) return; const int m = i >> 4, j = i & 15;
    const float inv = powf(10000.f, -(float)j / 16.f); const float ang = (float)pos[m] * inv; cs[i] = cosf(ang); sn[i] = sinf(ang);
}
template <int NACC, class Desc> __global__ void __launch_bounds__(256) n_gemm(Desc d) {
    __shared__ float As[NACC][16][65], Bs[NACC][16][65];
    const int tid = threadIdx.x, tx = tid & 15, ty = tid >> 4, row0 = blockIdx.y * 64, col0 = blockIdx.x * 64;
    float acc[NACC][4][4];
#pragma unroll
    for (int s = 0; s < NACC; ++s)
#pragma unroll
        for (int i = 0; i < 4; ++i)
#pragma unroll
            for (int j = 0; j < 4; ++j) acc[s][i][j] = 0.f;
    for (int k0 = 0; k0 < d.K; k0 += 16) {
#pragma unroll
        for (int s = 0; s < NACC; ++s) {
            const int ar = tid >> 2, ak = (tid & 3) * 4;
#pragma unroll
            for (int e = 0; e < 4; ++e) As[s][ak + e][ar] = d.a(s, row0 + ar, k0 + ak + e);
            const int bk = tid >> 4, bc = (tid & 15) * 4;
#pragma unroll
            for (int e = 0; e < 4; ++e) Bs[s][bk][bc + e] = d.b(s, k0 + bk, col0 + bc + e);
        }
        __syncthreads();
#pragma unroll
        for (int k = 0; k < 16; ++k)
#pragma unroll
            for (int s = 0; s < NACC; ++s) {
                float av[4], bv[4];
#pragma unroll
                for (int i = 0; i < 4; ++i) { av[i] = As[s][k][ty * 4 + i]; bv[i] = Bs[s][k][tx * 4 + i]; }
#pragma unroll
                for (int i = 0; i < 4; ++i)
#pragma unroll
                    for (int j = 0; j < 4; ++j) acc[s][i][j] += av[i] * bv[j];
            }
        __syncthreads();
    }
#pragma unroll
    for (int i = 0; i < 4; ++i)
#pragma unroll
        for (int j = 0; j < 4; ++j) { float a[NACC];
#pragma unroll
            for (int s = 0; s < NACC; ++s) a[s] = acc[s][i][j];
            d.epi(row0 + ty * 4 + i, col0 + tx * 4 + j, a); }
}
__device__ __forceinline__ float silu_f(float v) { return v / (1.f + __expf(-v)); }
__device__ __forceinline__ float sigmoid_f(float v) { return 1.f / (1.f + __expf(-v)); }

struct DUp { const bf16* A; const float *wg, *wu; bf16* act; int M, N, K, pad;
    __device__ float a(int, int r, int k) const { return bf2f(A[(size_t)r * D + k]); }
    __device__ float b(int s, int k, int c) const { return (s == 0 ? wg : wu)[(size_t)k * FF + c]; }
    __device__ void epi(int r, int c, const float (&a)[2]) const { act[(size_t)r * FF + c] = f2bf(silu_f(a[0]) * a[1]); } };
struct DRes { const bf16* A; const float* W; const float* base; float* out; int M, N, K, lda; float sc; int pad;
    __device__ float a(int, int r, int k) const { return bf2f(A[(size_t)r * lda + k]); }
    __device__ float b(int, int k, int c) const { return W[(size_t)k * D + c]; }
    __device__ void epi(int r, int c, const float (&a)[1]) const { out[(size_t)r * D + c] = base[(size_t)r * D + c] + sc * a[0]; } };
__device__ __forceinline__ int e1_src(int c) {
    if (c < 384) return c; if (c < 416) return 640 + (c - 384); if (c < 432) return 1696 + (c - 416); if (c < 512) return -1; if (c < 768) return 384 + (c - 512);
    if (c < 1024) return 672 + (c - 768); if (c < 1280) return 928 + (c - 1024); if (c < 1792) return 1184 + (c - 1280); if (c < 2304) return 1712 + (c - 1792); return 2224 + (c - 2304); }
struct DE1 { const bf16* A; const float* W; bf16 *zc, *zkv, *zg, *zxq; int M, N, K, pad;
    __device__ float a(int, int r, int k) const { return bf2f(A[(size_t)r * D + k]); }
    __device__ float b(int, int k, int c) const { const int s = e1_src(c); return s < 0 ? 0.f : W[(size_t)k * DIN + s]; }
    __device__ void epi(int r, int c, const float (&a)[1]) const { const bf16 v = f2bf(a[0]);
        if (c < 512) zc[(size_t)r * ZC_W + c] = v; else if (c < 768) zkv[(size_t)r * ZKV_W + c - 512] = v; else if (c < 2304) zg[(size_t)r * ZG_W + c - 768] = v; else zxq[(size_t)r * ZXQ_W + c - 2304] = v; } };
struct DPlain { const bf16* A; const float* W; bf16* O; int M, N, K, lda, ldw, ldo;
    __device__ float a(int, int r, int k) const { return bf2f(A[(size_t)r * lda + k]); }
    __device__ float b(int, int k, int c) const { return W[(size_t)k * ldw + c]; }
    __device__ void epi(int r, int c, const float (&a)[1]) const { O[(size_t)r * ldo + c] = f2bf(a[0]); } };
struct DQ { const bf16* zc; const float *W, *g, *ssq; bf16* Q; int M, N, K, pad;
    __device__ float a(int, int r, int k) const { return bf2f(zc[(size_t)r * ZC_W + k]); }
    __device__ float b(int, int k, int c) const { const int s = c < 512 ? 96 * (c >> 6) + (c & 63) : 96 * ((c - 512) >> 5) + 64 + (c & 31); return g[k] * W[(size_t)k * 768 + s]; }
    __device__ void epi(int r, int c, const float (&a)[1]) const { float s = 0.f; for (int j = 0; j < 12; ++j) s += ssq[(size_t)r * 12 + j]; Q[(size_t)r * QW + c] = f2bf(a[0] * rsqrtf(s * (1.f / 384.f) + EPS) * QSCALE); } };
struct DKV { const bf16* zkv; const float *W, *g, *ssq; bf16* KV; int M, N, K, pad;
    __device__ float a(int, int r, int k) const { return bf2f(zkv[(size_t)r * ZKV_W + k]); }
    __device__ float b(int, int k, int c) const { const int s = c < 512 ? 128 * (c >> 6) + (c & 63) : 128 * ((c - 512) >> 6) + 64 + (c & 63); return g[k] * W[(size_t)k * 1024 + s]; }
    __device__ void epi(int r, int c, const float (&a)[1]) const { float s = 0.f; for (int j = 0; j < 8; ++j) s += ssq[(size_t)r * 8 + j]; KV[(size_t)r * KVW + c] = f2bf(a[0] * rsqrtf(s * (1.f / 256.f) + EPS)); } };
struct DGate { const bf16* A; const float *W, *bias; bf16* gz; int M, N, K, pad;
    __device__ float a(int, int r, int k) const { return bf2f(A[(size_t)r * D + k]); }
    __device__ float b(int, int k, int c) const { return W[(size_t)k * DIN + 2736 + c]; }
    __device__ void epi(int r, int c, const float (&a)[1]) const { gz[(size_t)r * 3072 + c] = f2bf(sigmoid_f(a[0] + bias[c])); } };
struct DMerge { const bf16* O0; const float *W0, *W1, *W2; const bf16* gz; bf16* mg; int M, N, K, pad;
    __device__ float a(int s, int r, int k) const { return bf2f(O0[(size_t)s * M * 512 + (size_t)r * 512 + k]); }
    __device__ float b(int s, int k, int c) const { return (s == 0 ? W0 : s == 1 ? W1 : W2)[(size_t)k * D + c]; }
    __device__ void epi(int r, int c, const float (&a)[3]) const { const bf16* gp = gz + (size_t)r * 3072 + c; const float v = bf2f(gp[0]) * a[0] + bf2f(gp[1024]) * a[1] + bf2f(gp[2048]) * a[2]; mg[(size_t)r * D + c] = f2bf(v); } };

__global__ void __launch_bounds__(256) n_ssq(const bf16* zc, const bf16* zkv, float* sq, float* skv) {
    const int i = blockIdx.x * 256 + threadIdx.x; if (i >= M * 20) return; const int r = i / 20, j = i % 20; float s = 0.f;
    if (j < 12) { for (int c = 0; c < 32; ++c) { const float v = bf2f(zc[(size_t)r * ZC_W + 32 * j + c]); s += v * v; } sq[(size_t)r * 12 + j] = s; }
    else { for (int c = 0; c < 32; ++c) { const float v = bf2f(zkv[(size_t)r * ZKV_W + 32 * (j - 12) + c]); s += v * v; } skv[(size_t)r * 8 + (j - 12)] = s; }
}
__global__ void __launch_bounds__(256) n_rope(bf16* Q, const bf16* zc, bf16* KR, const float* cs, const float* sn) {
    const int i = blockIdx.x * 256 + threadIdx.x; if (i >= M * 9 * 16) return; const int r = i / 144, h = (i % 144) / 16, j = i & 15;
    const float c = cs[r * 16 + j], s = sn[r * 16 + j];
    if (h < 8) { bf16* q = Q + (size_t)r * QW + 512 + 32 * h; const float x1 = bf2f(q[j]), x2 = bf2f(q[j + 16]); q[j] = f2bf(x1 * c - x2 * s); q[j + 16] = f2bf(x1 * s + x2 * c); }
    else { const bf16* z = zc + (size_t)r * ZC_W + ZC_KROPE; const float x1 = bf2f(z[j]), x2 = bf2f(z[j + 16]); KR[(size_t)r * 32 + j] = f2bf(x1 * c - x2 * s); KR[(size_t)r * 32 + j + 16] = f2bf(x1 * s + x2 * c); }
}
__global__ void __launch_bounds__(256) n_mla_attn(const bf16* Q, const bf16* KV, const bf16* KR, bf16* O) {
    const int i = blockIdx.x * 256 + threadIdx.x; const int sl = i & 3, q = (i >> 2) % SEQ, h = (i >> 2) / SEQ % 8, b = (i >> 2) / SEQ / 8; if (b >= NB) return;
    const size_t r = (size_t)b * SEQ + q; float qv[96];
#pragma unroll
    for (int d = 0; d < 64; ++d) qv[d] = bf2f(Q[r * QW + 64 * h + d]);
#pragma unroll
    for (int d = 0; d < 32; ++d) qv[64 + d] = bf2f(Q[r * QW + 512 + 32 * h + d]);
    float m = -INFINITY, l = 0.f, acc[16];
#pragma unroll
    for (int d = 0; d < 16; ++d) acc[d] = 0.f;
    for (int k = 0; k <= q; ++k) { const size_t kr = (size_t)b * SEQ + k; float s = 0.f;
#pragma unroll
        for (int d = 0; d < 64; ++d) s += qv[d] * bf2f(KV[kr * KVW + 64 * h + d]);
#pragma unroll
        for (int d = 0; d < 32; ++d) s += qv[64 + d] * bf2f(KR[kr * 32 + d]);
        const float mn = fmaxf(m, s), f = exp2f(m - mn), p = exp2f(s - mn); m = mn; l = l * f + p;
#pragma unroll
        for (int d = 0; d < 16; ++d) acc[d] = acc[d] * f + p * bf2f(KV[kr * KVW + 512 + 64 * h + 16 * sl + d]); }
    const float il = 1.f / l;
#pragma unroll
    for (int d = 0; d < 16; ++d) O[r * 512 + 64 * h + 16 * sl + d] = f2bf(acc[d] * il);
}
__global__ void __launch_bounds__(256) n_cross_attn(const bf16* XQ, const bf16* KVX, bf16* O) {
    const int i = blockIdx.x * 256 + threadIdx.x; const int sl = i & 3, q = (i >> 2) % SEQ, h = (i >> 2) / SEQ % 4, b = (i >> 2) / SEQ / 4; if (b >= NB) return;
    const size_t r = (size_t)b * SEQ + q; float qv[128];
#pragma unroll
    for (int d = 0; d < 128; ++d) qv[d] = bf2f(XQ[r * ZXQ_W + 128 * h + d]) * XSCALE;
    float m = -INFINITY, l = 0.f, acc[32];
#pragma unroll
    for (int d = 0; d < 32; ++d) acc[d] = 0.f;
    for (int k = 0; k < NMEM; ++k) { const size_t kr = (size_t)b * NMEM + k; float s = 0.f;
#pragma unroll
        for (int d = 0; d < 128; ++d) s += qv[d] * bf2f(KVX[kr * 1024 + 128 * h + d]);
        const float mn = fmaxf(m, s), f = exp2f(m - mn), p = exp2f(s - mn); m = mn; l = l * f + p;
#pragma unroll
        for (int d = 0; d < 32; ++d) acc[d] = acc[d] * f + p * bf2f(KVX[kr * 1024 + 512 + 128 * h + 32 * sl + d]); }
    const float il = 1.f / l;
#pragma unroll
    for (int d = 0; d < 32; ++d) O[r * 512 + 128 * h + 32 * sl + d] = f2bf(acc[d] * il);
}
__global__ void __launch_bounds__(128) n_gla_rec(const bf16* zc, const bf16* zg, const float* w_a2, const float* b_a, float* otmp) {
    __shared__ float a_s[64], k_s[64], q_s[64];
    const int b = blockIdx.x >> 2, h = blockIdx.x & 3, dv = threadIdx.x; float S[64];
#pragma unroll
    for (int d = 0; d < 64; ++d) S[d] = 0.f;
    for (int t = 0; t < SEQ; ++t) { const size_t r = (size_t)b * SEQ + t;
        if (dv < 64) { float pre = b_a[64 * h + dv];
            for (int j = 0; j < 16; ++j) pre += bf2f(zc[r * ZC_W + ZC_GA + j]) * w_a2[j * 256 + 64 * h + dv];
            const float ls = fminf(pre, 0.f) - log1pf(__expf(-fabsf(pre)));
            a_s[dv] = __expf(ls * (1.f / 16.f)); k_s[dv] = bf2f(zg[r * ZG_W + ZG_K + 64 * h + dv]); q_s[dv] = bf2f(zg[r * ZG_W + ZG_Q + 64 * h + dv]); }
        __syncthreads();
        const float v = bf2f(zg[r * ZG_W + ZG_V + 128 * h + dv]); float o = 0.f;
#pragma unroll
        for (int d = 0; d < 64; ++d) { S[d] = a_s[d] * S[d] + k_s[d] * v; o += q_s[d] * S[d]; }
        otmp[r * 512 + 128 * h + dv] = o * 0.125f;
        __syncthreads(); }
}
__global__ void __launch_bounds__(256) n_gla_fin(const float* otmp, const bf16* zg, const float* o_norm, bf16* O) {
    const int w = blockIdx.x * 4 + (threadIdx.x >> 6), lane = threadIdx.x & 63; if (w >= M * 4) return; const int r = w >> 2, h = w & 3;
    const float a = otmp[(size_t)r * 512 + 128 * h + lane], c = otmp[(size_t)r * 512 + 128 * h + 64 + lane]; float s = a * a + c * c;
#pragma unroll
    for (int o = 1; o < 64; o <<= 1) s += __shfl_xor(s, o);
    const float rs = rsqrtf(s * (1.f / 128.f) + EPS);
    const float r0 = bf2f(zg[(size_t)r * ZG_W + ZG_R + 128 * h + lane]), r1 = bf2f(zg[(size_t)r * ZG_W + ZG_R + 128 * h + 64 + lane]);
    O[(size_t)r * 512 + 128 * h + lane] = f2bf(a * rs * o_norm[lane] * silu_f(r0)); O[(size_t)r * 512 + 128 * h + 64 + lane] = f2bf(c * rs * o_norm[64 + lane] * silu_f(r1));
}


__global__ void __launch_bounds__(256) n_gate_fin(bf16* gz, const float* bias) { const size_t i = (size_t)blockIdx.x * 256 + threadIdx.x; gz[i] = f2bf(sigmoid_f(bf2f(gz[i]) + bias[i % 3072])); }
__global__ void __launch_bounds__(256) n_flush(const float* x, float* sink) { float s = 0.f; for (size_t i = (size_t)blockIdx.x * 256 + threadIdx.x; i < (size_t)M * D; i += (size_t)gridDim.x * 256) s += x[i]; if (s == 123.456f) sink[0] = s; }
namespace pg8 {
#define PG8_LAS __attribute__((address_space(3)))
typedef unsigned short bf16_t;
typedef short bf16x8 __attribute__((ext_vector_type(8)));
typedef float f32x4 __attribute__((ext_vector_type(4)));
typedef unsigned u32x4 __attribute__((ext_vector_type(4)));
typedef unsigned u32x2 __attribute__((ext_vector_type(2)));
constexpr int BM = 256, BK = 64, HALF = 128, HTB = HALF * BK * 2  , STAGE_BYTES = 8 * HTB, NXCD = 8, WGM = 8;

__host__ __device__ __forceinline__ int lds_byte(int r, int c) { const int st = (r >> 4) * 2 + (c >> 5), rr = r & 15, cc = c & 31, ob = rr * 64 + cc * 2; return st * 1024 + (ob ^ (((ob >> 9) & 1) << 5)); }
__host__ __device__ __forceinline__ void stage_rc(int b, int& R, int& C) { const int st = b / 1024, sb = b % 1024, swz = sb ^ (((sb >> 9) & 1) << 5); R = (st >> 1) * 16 + swz / 64; C = (st & 1) * 32 + (swz % 64) / 2; }
__host__ __device__ __forceinline__ int perm32(int rho) { const int n = rho >> 4, i = rho & 15; return 8 * (i >> 2) + 4 * n + (i & 3); }

struct Unit { int pm, pn, z; };
struct Gemm { const bf16_t* A; const bf16_t* Bt; size_t zA, zB; int lda, ldb, K, pad; };

__device__ __forceinline__ void tile_of(int L, int nM, int nN, Unit& u) {
    const int nwg = nM * nN; int wgid = L; { const int q = nwg / NXCD, r = nwg % NXCD, xcd = wgid % NXCD, off = wgid / NXCD; wgid = (xcd < r ? xcd * (q + 1) : r * (q + 1) + (xcd - r) * q) + off; }
    const int nig = WGM * nN, gid = wgid / nig, fm = gid * WGM, gsz = (nM - fm) < WGM ? (nM - fm) : WGM;
    u.pm = fm + ((wgid % nig) % gsz); u.pn = (wgid % nig) / gsz;
}
struct StaticOrder {
    int nM, nN, nwg, G, c;
    __device__ void init(int M_, int N_, int G_, int c_) { nM = M_ / BM; nN = N_ / BM; nwg = nM * nN; G = G_; c = c_; }
    __device__ bool next(int i, Unit& u) const { const long L = (long)i * G + c; if (L >= nwg) return false; tile_of((int)L, nM, nN, u); u.z = 0; return true; }
    __device__ __forceinline__ void a_ready(const Unit&) const {}
    __device__ __forceinline__ void done(const Unit&) const {}
};
struct MergeOrder {
    int nM, nN, nwg, G, c;
    __device__ void init(int M_, int N_, int G_, int c_) { nM = M_ / BM; nN = N_ / BM; nwg = nM * nN; G = G_; c = c_; }
    __device__ bool next(int i, Unit& u) const { const int r = i / 3; const long L = (long)r * G + c; if (L >= nwg) return false; tile_of((int)L, nM, nN, u); u.z = i - 3 * r; return true; }
    __device__ __forceinline__ void a_ready(const Unit&) const {}
    __device__ __forceinline__ void done(const Unit&) const {}
};

typedef float f32x2_t __attribute__((ext_vector_type(2))); typedef __bf16 bf16x2_t __attribute__((ext_vector_type(2)));
__device__ __forceinline__ unsigned cvt_pk_bf16(float lo, float hi) { f32x2_t v = {lo, hi}; bf16x2_t b = __builtin_convertvector(v, bf16x2_t); return __builtin_bit_cast(unsigned, b); }
__device__ __forceinline__ float fsig(float v) { return __builtin_amdgcn_rcpf(1.f + __builtin_amdgcn_exp2f(-1.4426950408889634f * v)); }
__device__ __forceinline__ f32x4 bfx4lo(u32x2 w) { return (f32x4){__uint_as_float(w.x << 16), __uint_as_float(w.x & 0xffff0000u), __uint_as_float(w.y << 16), __uint_as_float(w.y & 0xffff0000u)}; }
#ifndef WT_STORES
#define WT_STORES 0
#endif
__device__ __forceinline__ void st16(void* base, size_t byte_off, u32x4 v) {
#if WT_STORES
    __amdgpu_buffer_rsrc_t r = __builtin_amdgcn_make_buffer_rsrc(base, 0, 0x7fffffff, 0x00020000); __builtin_amdgcn_raw_buffer_store_b128(v, r, (unsigned)byte_off, 0, 16);
#else
    *(u32x4*)((char*)base + byte_off) = v;
#endif
}
__device__ __forceinline__ void st16f(float* base, size_t elem, f32x4 v) { st16(base, elem * 4, __builtin_bit_cast(u32x4, v)); }
__device__ __forceinline__ void st16h(bf16_t* base, size_t elem, u32x4 v) { st16(base, elem * 2, v); }
__device__ __forceinline__ u32x4 pack8(f32x4 v0, f32x4 v1) { u32x4 w; w.x = cvt_pk_bf16(v0[0], v0[1]); w.y = cvt_pk_bf16(v0[2], v0[3]); w.z = cvt_pk_bf16(v1[0], v1[1]); w.w = cvt_pk_bf16(v1[2], v1[3]); return w; }

struct EpiSwiGLU {
    static constexpr bool PERM = true, AFTER_DRAIN = false; bf16_t* O; const float* ss; int ldc, pad;
    __device__ __forceinline__ void operator()(const f32x4 (&acc)[2][2][4][2], const Unit& u, int wr, int wc, int fr, int fq) const {
        const int row0 = u.pm * BM + wr * 64 + fr, col0 = u.pn * HALF + wc * 32 + 8 * fq;
#pragma unroll
        for (int ai = 0; ai < 2; ++ai)
#pragma unroll
            for (int m = 0; m < 4; ++m) { f32x4 v[2]; const float rs = rsqrtf(ss[row0 + ai * HALF + m * 16] * (1.f / D) + EPS);
#pragma unroll
                for (int n = 0; n < 2; ++n) { const f32x4 g = acc[ai][0][m][n] * rs, up = acc[ai][1][m][n] * rs;
#pragma unroll
                    for (int e = 0; e < 4; ++e) v[n][e] = g[e] * fsig(g[e]) * up[e]; }
                st16h(O, (size_t)(row0 + ai * HALF + m * 16) * ldc + col0, pack8(v[0], v[1])); }
    }
};
template <bool BASE_BF16> struct EpiResidT {
    static constexpr bool PERM = true, AFTER_DRAIN = false; const void* base; bf16_t* xb; float* ssq; float sc; int pad;
    __device__ __forceinline__ void operator()(const f32x4 (&acc)[2][2][4][2], const Unit& u, int wr, int wc, int fr, int fq) const {
        const int row0 = u.pm * BM + wr * 64 + fr, col0 = u.pn * BM + wc * 32 + 8 * fq;
#pragma unroll
        for (int ai = 0; ai < 2; ++ai)
#pragma unroll
            for (int m = 0; m < 4; ++m) { float s = 0.f; const int row = row0 + ai * HALF + m * 16;
#pragma unroll
                for (int bj = 0; bj < 2; ++bj) { const size_t off = (size_t)row * D + col0 + bj * HALF; f32x4 b0, b1;
                    if (BASE_BF16) { const u32x4 bw = *(const u32x4*)((const bf16_t*)base + off); b0 = bfx4lo((u32x2){bw.x, bw.y}); b1 = bfx4lo((u32x2){bw.z, bw.w}); }
                    else { b0 = *(const f32x4*)((const float*)base + off); b1 = *(const f32x4*)((const float*)base + off + 4); }
                    const f32x4 o0 = b0 + acc[ai][bj][m][0] * sc, o1 = b1 + acc[ai][bj][m][1] * sc;
                    st16h(xb, off, pack8(o0, o1)); s += ((o0[0] * o0[0] + o0[1] * o0[1]) + (o0[2] * o0[2] + o0[3] * o0[3])) + ((o1[0] * o1[0] + o1[1] * o1[1]) + (o1[2] * o1[2] + o1[3] * o1[3])); }
                s += __shfl_xor(s, 16); s += __shfl_xor(s, 32); if (fq == 0) atomicAdd(ssq + row, s);
                asm volatile("" ::: "memory"); }
    }
};
struct EpiFinal {
    static constexpr bool PERM = true, AFTER_DRAIN = true; const bf16_t* base; float* out; const float* gain; float* ssf; unsigned* cnt; float sc; int pad;
    __device__ __forceinline__ void operator()(const f32x4 (&)[2][2][4][2], const Unit&, int, int, int, int) const {}
    __device__ __forceinline__ void fused(f32x4 (&acc)[2][2][4][2], const Unit& u, int wr, int wc, int fr, int fq, PG8_LAS unsigned char* lds, int wid, int lane) const {
        const int row0 = u.pm * BM + wr * 64 + fr, col0 = u.pn * BM + wc * 32 + 8 * fq;
#pragma unroll
        for (int ai = 0; ai < 2; ++ai)
#pragma unroll
            for (int m = 0; m < 4; ++m) { float s = 0.f; const int row = row0 + ai * HALF + m * 16;
#pragma unroll
                for (int bj = 0; bj < 2; ++bj) { const size_t off = (size_t)row * D + col0 + bj * HALF;
                    const u32x4 bw = *(const u32x4*)(base + off); const f32x4 b0 = bfx4lo((u32x2){bw.x, bw.y}), b1 = bfx4lo((u32x2){bw.z, bw.w});
                    const f32x4 o0 = b0 + acc[ai][bj][m][0] * sc, o1 = b1 + acc[ai][bj][m][1] * sc; acc[ai][bj][m][0] = o0; acc[ai][bj][m][1] = o1;
                    s += ((o0[0] * o0[0] + o0[1] * o0[1]) + (o0[2] * o0[2] + o0[3] * o0[3])) + ((o1[0] * o1[0] + o1[1] * o1[1]) + (o1[2] * o1[2] + o1[3] * o1[3])); }
                s += __shfl_xor(s, 16); s += __shfl_xor(s, 32); if (fq == 0) atomicAdd(ssf + row, s);
                asm volatile("" ::: "memory"); }
        asm volatile("s_waitcnt vmcnt(0)" ::: "memory");
        __syncthreads();
        if (threadIdx.x == 0) { unsigned* c = cnt + 64 * u.pm; __hip_atomic_fetch_add(c, 1u, __ATOMIC_RELAXED, __HIP_MEMORY_SCOPE_AGENT);
            unsigned sp = 0; while (__hip_atomic_load(c, __ATOMIC_RELAXED, __HIP_MEMORY_SCOPE_AGENT) < 4u) { __builtin_amdgcn_s_sleep(1); if (++sp > (1u << 22)) break; } }
        __syncthreads();
        f32x4 gv[2][2];
#pragma unroll
        for (int bj = 0; bj < 2; ++bj)
#pragma unroll
            for (int n = 0; n < 2; ++n) gv[bj][n] = *(const f32x4*)(gain + col0 + bj * HALF + 4 * n);
#pragma unroll
        for (int ai = 0; ai < 2; ++ai)
#pragma unroll
            for (int m = 0; m < 4; ++m) { const int row = row0 + ai * HALF + m * 16;
                const float rs = rsqrtf(__hip_atomic_load(ssf + row, __ATOMIC_RELAXED, __HIP_MEMORY_SCOPE_AGENT) * (1.f / D) + EPS);
#pragma unroll
                for (int bj = 0; bj < 2; ++bj) { const size_t off = (size_t)row * D + col0 + bj * HALF;
                    st16f(out, off, acc[ai][bj][m][0] * rs * gv[bj][0]); st16f(out, off + 4, acc[ai][bj][m][1] * rs * gv[bj][1]); } }
    }
};
struct EpiZ1 {
    static constexpr bool PERM = true, AFTER_DRAIN = false; bf16_t *zc, *zkv, *zg, *zxq; float *ssqq, *ssqkv; const float* ss;
    __device__ __forceinline__ void operator()(const f32x4 (&acc)[2][2][4][2], const Unit& u, int wr, int wc, int fr, int fq) const {
        const int pn = u.pn; bf16_t* base; int ldc, cb;
        if (pn < 2) { base = zc; ldc = ZC_W; cb = 256 * pn; } else if (pn == 2) { base = zkv; ldc = ZKV_W; cb = 0; } else if (pn < 9) { base = zg; ldc = ZG_W; cb = 256 * (pn - 3); } else { base = zxq; ldc = ZXQ_W; cb = 256 * (pn - 9); }
        const int row0 = u.pm * BM + wr * 64 + fr, col0 = cb + wc * 32 + 8 * fq;
#pragma unroll
        for (int ai = 0; ai < 2; ++ai)
#pragma unroll
            for (int m = 0; m < 4; ++m) { const int row = row0 + ai * HALF + m * 16; const float rs = rsqrtf(ss[row] * (1.f / D) + EPS);
#pragma unroll
                for (int bj = 0; bj < 2; ++bj) st16h(base, (size_t)row * ldc + col0 + bj * HALF, pack8(acc[ai][bj][m][0] * rs, acc[ai][bj][m][1] * rs));
                if (pn <= 2) {
#pragma unroll
                    for (int bj = 0; bj < 2; ++bj) { const f32x4 a = acc[ai][bj][m][0] * rs, b = acc[ai][bj][m][1] * rs;
                        float s = (a[0] * a[0] + a[1] * a[1]) + (a[2] * a[2] + a[3] * a[3]) + (b[0] * b[0] + b[1] * b[1]) + (b[2] * b[2] + b[3] * b[3]);
                        s += __shfl_xor(s, 16); s += __shfl_xor(s, 32);
                        if (fq == 0) { if (pn == 0) ssqq[(size_t)row * 12 + 4 * bj + wc] = s; else if (pn == 1) { if (bj == 0) ssqq[(size_t)row * 12 + 8 + wc] = s; } else ssqkv[(size_t)row * 8 + 4 * bj + wc] = s; } } } }
    }
};
struct EpiPlain {
    static constexpr bool PERM = true, AFTER_DRAIN = false; bf16_t* O; int ldc, pad;
    __device__ __forceinline__ void operator()(const f32x4 (&acc)[2][2][4][2], const Unit& u, int wr, int wc, int fr, int fq) const {
        const int row0 = u.pm * BM + wr * 64 + fr, col0 = u.pn * BM + wc * 32 + 8 * fq;
#pragma unroll
        for (int ai = 0; ai < 2; ++ai)
#pragma unroll
            for (int m = 0; m < 4; ++m)
#pragma unroll
                for (int bj = 0; bj < 2; ++bj) st16h(O, (size_t)(row0 + ai * HALF + m * 16) * ldc + col0 + bj * HALF, pack8(acc[ai][bj][m][0], acc[ai][bj][m][1]));
    }
};
struct EpiQ {
    static constexpr bool PERM = false, AFTER_DRAIN = false; bf16_t* Q; const float *ssq, *cs, *sn;
    __device__ __forceinline__ void operator()(const f32x4 (&acc)[2][2][4][2], const Unit& u, int wr, int wc, int fr, int fq) const {
#pragma unroll
        for (int ai = 0; ai < 2; ++ai)
#pragma unroll
            for (int m = 0; m < 4; ++m) { const int row = u.pm * BM + ai * HALF + wr * 64 + m * 16 + fr;
                const f32x4 s0 = *(const f32x4*)(ssq + (size_t)row * 12), s1 = *(const f32x4*)(ssq + (size_t)row * 12 + 4), s2 = *(const f32x4*)(ssq + (size_t)row * 12 + 8);
                const float ss = ((s0[0] + s0[1]) + (s0[2] + s0[3])) + ((s1[0] + s1[1]) + (s1[2] + s1[3])) + ((s2[0] + s2[1]) + (s2[2] + s2[3]));
                const float sc = rsqrtf(ss * (1.f / 384.f) + EPS) * QSCALE;
                if (u.pn < 2) {
#pragma unroll
                    for (int bj = 0; bj < 2; ++bj)
#pragma unroll
                        for (int n = 0; n < 2; ++n) { const f32x4 v = acc[ai][bj][m][n] * sc; u32x2 w; w.x = cvt_pk_bf16(v[0], v[1]); w.y = cvt_pk_bf16(v[2], v[3]);
                            *(u32x2*)(Q + (size_t)row * QW + u.pn * BM + bj * HALF + wc * 32 + 16 * n + 4 * fq) = w; }
                } else { const f32x4 c4 = *(const f32x4*)(cs + (size_t)row * 16 + 4 * fq), s4 = *(const f32x4*)(sn + (size_t)row * 16 + 4 * fq);
#pragma unroll
                    for (int bj = 0; bj < 2; ++bj) { const f32x4 x1 = acc[ai][bj][m][0] * sc, x2 = acc[ai][bj][m][1] * sc; const f32x4 o1 = x1 * c4 - x2 * s4, o2 = x1 * s4 + x2 * c4;
                        u32x2 w1, w2; w1.x = cvt_pk_bf16(o1[0], o1[1]); w1.y = cvt_pk_bf16(o1[2], o1[3]); w2.x = cvt_pk_bf16(o2[0], o2[1]); w2.y = cvt_pk_bf16(o2[2], o2[3]);
                        bf16_t* q = Q + (size_t)row * QW + 512 + bj * HALF + wc * 32 + 4 * fq; *(u32x2*)q = w1; *(u32x2*)(q + 16) = w2; } }
                asm volatile("" ::: "memory"); }
    }
};
struct EpiKV {
    static constexpr bool PERM = true, AFTER_DRAIN = false; bf16_t* O; const float* ssq;
    __device__ __forceinline__ void operator()(const f32x4 (&acc)[2][2][4][2], const Unit& u, int wr, int wc, int fr, int fq) const {
        const int row0 = u.pm * BM + wr * 64 + fr, col0 = u.pn * BM + wc * 32 + 8 * fq;
#pragma unroll
        for (int ai = 0; ai < 2; ++ai)
#pragma unroll
            for (int m = 0; m < 4; ++m) { const int row = row0 + ai * HALF + m * 16;
                const f32x4 s0 = *(const f32x4*)(ssq + (size_t)row * 8), s1 = *(const f32x4*)(ssq + (size_t)row * 8 + 4);
                const float sc = rsqrtf((((s0[0] + s0[1]) + (s0[2] + s0[3])) + ((s1[0] + s1[1]) + (s1[2] + s1[3]))) * (1.f / 256.f) + EPS);
#pragma unroll
                for (int bj = 0; bj < 2; ++bj) st16h(O, (size_t)row * KVW + col0 + bj * HALF, pack8(acc[ai][bj][m][0] * sc, acc[ai][bj][m][1] * sc));
                asm volatile("" ::: "memory"); }
    }
};
struct EpiGate {
    static constexpr bool PERM = true, AFTER_DRAIN = false; bf16_t* O; const float* bias; const float* ss;
    __device__ __forceinline__ void operator()(const f32x4 (&acc)[2][2][4][2], const Unit& u, int wr, int wc, int fr, int fq) const {
        const int row0 = u.pm * BM + wr * 64 + fr, col0 = u.pn * BM + wc * 32 + 8 * fq;
        f32x4 bv[2][2];
#pragma unroll
        for (int bj = 0; bj < 2; ++bj)
#pragma unroll
            for (int n = 0; n < 2; ++n) bv[bj][n] = *(const f32x4*)(bias + col0 + bj * HALF + 4 * n);
#pragma unroll
        for (int ai = 0; ai < 2; ++ai)
#pragma unroll
            for (int m = 0; m < 4; ++m) { const float rs = rsqrtf(ss[row0 + ai * HALF + m * 16] * (1.f / D) + EPS);
#pragma unroll
                for (int bj = 0; bj < 2; ++bj) { f32x4 v[2];
#pragma unroll
                    for (int n = 0; n < 2; ++n) { const f32x4 t = acc[ai][bj][m][n] * rs + bv[bj][n];
#pragma unroll
                        for (int e = 0; e < 4; ++e) v[n][e] = fsig(t[e]); }
                    st16h(O, (size_t)(row0 + ai * HALF + m * 16) * 3072 + col0 + bj * HALF, pack8(v[0], v[1])); } }
    }
};
struct EpiMerge {
    static constexpr bool PERM = true, AFTER_DRAIN = false; bf16_t* MG; const bf16_t* gz;
    __device__ __forceinline__ void operator()(const f32x4 (&acc)[2][2][4][2], const Unit& u, int wr, int wc, int fr, int fq) const {
        const int row0 = u.pm * BM + wr * 64 + fr, col0 = u.pn * BM + wc * 32 + 8 * fq;
#pragma unroll
        for (int ai = 0; ai < 2; ++ai)
#pragma unroll
            for (int m = 0; m < 4; ++m) {
#pragma unroll
                for (int bj = 0; bj < 2; ++bj) { const int row = row0 + ai * HALF + m * 16, col = col0 + bj * HALF;
                    const u32x4 gw = *(const u32x4*)(gz + (size_t)row * 3072 + 1024 * u.z + col);
                    f32x4 v0 = bfx4lo((u32x2){gw.x, gw.y}) * acc[ai][bj][m][0], v1 = bfx4lo((u32x2){gw.z, gw.w}) * acc[ai][bj][m][1];
                    bf16_t* mp = MG + (size_t)row * D + col;
                    if (u.z > 0) {
                        const unsigned long long o0 = __hip_atomic_load((const unsigned long long*)mp, __ATOMIC_RELAXED, __HIP_MEMORY_SCOPE_AGENT), o1 = __hip_atomic_load((const unsigned long long*)mp + 1, __ATOMIC_RELAXED, __HIP_MEMORY_SCOPE_AGENT);
                        v0 += bfx4lo((u32x2){(unsigned)o0, (unsigned)(o0 >> 32)}); v1 += bfx4lo((u32x2){(unsigned)o1, (unsigned)(o1 >> 32)}); }
                    st16h(MG, (size_t)row * D + col, pack8(v0, v1)); }
                asm volatile("" ::: "memory"); }
    }
};

template <class Epi, class Sched, bool ALIGN_EPI = false, bool SP2 = false>
__device__ __forceinline__ void gemm_phase(PG8_LAS unsigned char* lds, const Gemm g, const Sched& S, const Epi& E) {
    const int tid = threadIdx.x, wid = __builtin_amdgcn_readfirstlane(tid >> 6), lane = tid & 63, wr = wid >> 2, wc = wid & 3, fr = lane & 15, fq = lane >> 4;
    const int K = g.K, nt = K / BK;
    unsigned voffA[2], voffB[2];
#pragma unroll
    for (int i = 0; i < 2; ++i) { int R, C; stage_rc(tid * 16 + i * 8192, R, C); const int Rb = Epi::PERM ? ((R & ~31) + perm32(R & 31)) : R;
        voffA[i] = (unsigned)(R * g.lda + C) * 2u; voffB[i] = (unsigned)(Rb * g.ldb + C) * 2u; }
    const size_t kstep = (size_t)(BK * 2);
    const size_t hstepA = (size_t)HALF * g.lda * 2, hstepB = (size_t)HALF * g.ldb * 2;
    const size_t tstepA = 2 * hstepA, tstepB = 2 * hstepB;
    const unsigned ldsw = (unsigned)wid * 1024u;
    const int aoff = lds_byte(wr * 64 + fr, fq * 8), boff = lds_byte(wc * 32 + fr, fq * 8);
#define PG8_SA(b, h) (((b) * 2 + (h)) * HTB)
#define PG8_SB(b, h) ((4 + (b) * 2 + (h)) * HTB)
#define PG8_STAGE(bufoff, gbase, voff) do { _Pragma("unroll") for (int _i = 0; _i < 2; ++_i) \
        __builtin_amdgcn_global_load_lds((const unsigned*)((const char*)(gbase) + (voff)[_i]), (PG8_LAS unsigned*)(lds + (bufoff) + ldsw + _i * 8192), 16, 0, 0); } while (0)
#define PG8_LDA(dst, b, h) do { _Pragma("unroll") for (int m = 0; m < 4; ++m) _Pragma("unroll") for (int k = 0; k < 2; ++k) dst[m][k] = *(const PG8_LAS bf16x8*)(lds + PG8_SA(b, h) + aoff + m * 2048 + k * 1024); } while (0)
#define PG8_LDB(dst, b, h) do { _Pragma("unroll") for (int n = 0; n < 2; ++n) _Pragma("unroll") for (int k = 0; k < 2; ++k) dst[n][k] = *(const PG8_LAS bf16x8*)(lds + PG8_SB(b, h) + boff + n * 2048 + k * 1024); } while (0)
#define PG8_MMA(ai, bj, At, Bt) do { __builtin_amdgcn_s_setprio(1); _Pragma("unroll") for (int m = 0; m < 4; ++m) _Pragma("unroll") for (int n = 0; n < 2; ++n) _Pragma("unroll") for (int k = 0; k < 2; ++k) \
        acc[ai][bj][m][n] = __builtin_amdgcn_mfma_f32_16x16x32_bf16(Bt[n][k], At[m][k], acc[ai][bj][m][n], 0, 0, 0); __builtin_amdgcn_s_setprio(0); } while (0)
#define PG8_WAIT_V(n) asm volatile("s_waitcnt vmcnt(" #n ")" ::: "memory")
#define PG8_WAIT_L(n) asm volatile("s_waitcnt lgkmcnt(" #n ")" ::: "memory")
#define PG8_BAR __builtin_amdgcn_s_barrier()
#define PG8_SCHED __builtin_amdgcn_sched_barrier(0)
    Unit cur, nxt; int ui = 0;
    if (!S.next(0, cur)) return;
    f32x4 acc[2][2][4][2];
#pragma unroll
    for (int a = 0; a < 2; ++a)
#pragma unroll
        for (int b = 0; b < 2; ++b)
#pragma unroll
            for (int m = 0; m < 4; ++m)
#pragma unroll
                for (int n = 0; n < 2; ++n) acc[a][b][m][n] = (f32x4){0.f, 0.f, 0.f, 0.f};
    bf16x8 At[4][2], B0[2][2], B1[2][2];
    const char* cA = (const char*)g.A + (size_t)cur.z * g.zA + (size_t)cur.pm * tstepA; const char* cB = (const char*)g.Bt + (size_t)cur.z * g.zB + (size_t)cur.pn * tstepB;
    S.a_ready(cur);
    if constexpr (SP2) {
        PG8_STAGE(PG8_SB(0, 0), cB, voffB); PG8_STAGE(PG8_SB(0, 1), cB + hstepB, voffB); PG8_STAGE(PG8_SA(0, 0), cA, voffA); PG8_STAGE(PG8_SA(0, 1), cA + hstepA, voffA);
        if (wr == 1) PG8_BAR;
        PG8_WAIT_V(2); PG8_BAR;
        PG8_STAGE(PG8_SB(1, 0), cB + kstep, voffB); PG8_STAGE(PG8_SA(1, 0), cA + kstep, voffA); PG8_STAGE(PG8_SB(1, 1), cB + hstepB + kstep, voffB);
        PG8_WAIT_V(6); PG8_BAR;
    } else {
        PG8_STAGE(PG8_SB(0, 0), cB, voffB); PG8_STAGE(PG8_SA(0, 0), cA, voffA); PG8_STAGE(PG8_SB(0, 1), cB + hstepB, voffB); PG8_STAGE(PG8_SA(0, 1), cA + hstepA, voffA);
        if (wr == 1) PG8_BAR;
        PG8_WAIT_V(4); PG8_BAR;
        PG8_STAGE(PG8_SB(1, 0), cB + kstep, voffB); PG8_STAGE(PG8_SA(1, 0), cA + kstep, voffA); PG8_STAGE(PG8_SB(1, 1), cB + hstepB + kstep, voffB);
        PG8_WAIT_V(6); PG8_BAR;
    }
    for (;;) {
        const bool has_next = S.next(ui + 1, nxt);
        const char* nA = has_next ? (const char*)g.A + (size_t)nxt.z * g.zA + (size_t)nxt.pm * tstepA : cA; const char* nB = has_next ? (const char*)g.Bt + (size_t)nxt.z * g.zB + (size_t)nxt.pn * tstepB : cB;
#pragma unroll 1
        for (int t = 0; t < nt; t += 2) {
            const bool last = (t == nt - 2);
            const char* a1 = cA + (size_t)(t + 1) * kstep;
            const char* a2 = last ? nA : cA + (size_t)(t + 2) * kstep; const char* b2 = last ? nB : cB + (size_t)(t + 2) * kstep;
            const char* a3 = a2 + kstep; const char* b3 = b2 + kstep;
            if (last && has_next) S.a_ready(nxt);
            if constexpr (SP2) {
            PG8_LDB(B0, 0, 0); PG8_LDB(B1, 0, 1); PG8_SCHED; PG8_LDA(At, 0, 0); PG8_STAGE(PG8_SA(1, 1), a1 + hstepA, voffA);
            PG8_WAIT_V(8); PG8_WAIT_L(0); PG8_BAR; PG8_MMA(0, 0, At, B0); PG8_MMA(0, 1, At, B1); PG8_BAR; PG8_SCHED;
            PG8_LDA(At, 0, 1); PG8_STAGE(PG8_SB(0, 0), b2, voffB); PG8_STAGE(PG8_SB(0, 1), b2 + hstepB, voffB); PG8_STAGE(PG8_SA(0, 0), a2, voffA);
            PG8_WAIT_V(8); PG8_WAIT_L(0); PG8_BAR; PG8_MMA(1, 0, At, B0); PG8_MMA(1, 1, At, B1); PG8_BAR; PG8_SCHED;
            PG8_LDB(B0, 1, 0); PG8_LDB(B1, 1, 1); PG8_SCHED; PG8_LDA(At, 1, 0); PG8_STAGE(PG8_SA(0, 1), a2 + hstepA, voffA);
            PG8_WAIT_V(8); PG8_WAIT_L(0); PG8_BAR; PG8_MMA(0, 0, At, B0); PG8_MMA(0, 1, At, B1); PG8_BAR; PG8_SCHED;
            PG8_LDA(At, 1, 1); PG8_STAGE(PG8_SB(1, 0), b3, voffB); PG8_STAGE(PG8_SB(1, 1), b3 + hstepB, voffB); PG8_STAGE(PG8_SA(1, 0), a3, voffA);
            PG8_WAIT_V(8); PG8_WAIT_L(0); PG8_BAR; PG8_MMA(1, 0, At, B0); PG8_MMA(1, 1, At, B1); PG8_BAR; PG8_SCHED;
            } else {
            PG8_LDB(B0, 0, 0); PG8_SCHED; PG8_LDA(At, 0, 0); PG8_STAGE(PG8_SA(1, 1), a1 + hstepA, voffA);
            PG8_WAIT_L(8); PG8_BAR; PG8_WAIT_L(0); PG8_MMA(0, 0, At, B0); PG8_BAR; PG8_SCHED;
            PG8_LDB(B1, 0, 1); PG8_STAGE(PG8_SB(0, 0), b2, voffB);
            PG8_BAR; PG8_WAIT_L(0); PG8_MMA(0, 1, At, B1); PG8_BAR;
            PG8_LDA(At, 0, 1); PG8_STAGE(PG8_SA(0, 0), a2, voffA);
            PG8_BAR; PG8_WAIT_L(0); PG8_MMA(1, 0, At, B0); PG8_BAR; PG8_SCHED;
            PG8_STAGE(PG8_SB(0, 1), b2 + hstepB, voffB);
            PG8_WAIT_V(6); PG8_BAR; PG8_MMA(1, 1, At, B1); PG8_BAR;
            PG8_LDB(B0, 1, 0); PG8_SCHED; PG8_LDA(At, 1, 0); PG8_STAGE(PG8_SA(0, 1), a2 + hstepA, voffA);
            PG8_WAIT_L(8); PG8_BAR; PG8_WAIT_L(0); PG8_MMA(0, 0, At, B0); PG8_BAR; PG8_SCHED;
            PG8_LDB(B1, 1, 1); PG8_STAGE(PG8_SB(1, 0), b3, voffB);
            PG8_BAR; PG8_WAIT_L(0); PG8_MMA(0, 1, At, B1); PG8_BAR;
            PG8_LDA(At, 1, 1); PG8_STAGE(PG8_SA(1, 0), a3, voffA);
            PG8_BAR; PG8_WAIT_L(0); PG8_MMA(1, 0, At, B0); PG8_BAR; PG8_SCHED;
            PG8_STAGE(PG8_SB(1, 1), b3 + hstepB, voffB);
            PG8_WAIT_V(6); PG8_BAR; PG8_MMA(1, 1, At, B1); PG8_BAR;
            }
        }
        if constexpr (ALIGN_EPI) { if (wr == 0) PG8_BAR; }
        if constexpr (!Epi::AFTER_DRAIN) { E(acc, cur, wr, wc, fr, fq); S.done(cur); }
        if (!has_next) break;
#pragma unroll
        for (int a = 0; a < 2; ++a)
#pragma unroll
            for (int b = 0; b < 2; ++b)
#pragma unroll
                for (int m = 0; m < 4; ++m)
#pragma unroll
                    for (int n = 0; n < 2; ++n) acc[a][b][m][n] = (f32x4){0.f, 0.f, 0.f, 0.f};
        cur = nxt; cA = nA; cB = nB; ++ui;
        if constexpr (ALIGN_EPI) { if (wr == 1) PG8_BAR; }
    }
    PG8_WAIT_V(0);
    if constexpr (!ALIGN_EPI) { if (wr == 0) PG8_BAR; }
    PG8_BAR;
    if constexpr (Epi::AFTER_DRAIN) { E.fused(acc, cur, wr, wc, fr, fq, lds, wid, lane); S.done(cur); }
#undef PG8_SA
#undef PG8_SB
#undef PG8_STAGE
#undef PG8_LDA
#undef PG8_LDB
#undef PG8_MMA
#undef PG8_WAIT_V
#undef PG8_WAIT_L
#undef PG8_BAR
#undef PG8_SCHED
}
}


namespace att {
typedef short bf16x8 __attribute__((ext_vector_type(8)));
typedef short bf16x4 __attribute__((ext_vector_type(4)));
typedef float f32x16 __attribute__((ext_vector_type(16)));
typedef unsigned u32x4 __attribute__((ext_vector_type(4)));
#define ALAS __attribute__((address_space(3)))
__device__ __forceinline__ void lds_barrier() { asm volatile("s_waitcnt lgkmcnt(0)" ::: "memory"); __builtin_amdgcn_s_barrier(); asm volatile("" ::: "memory"); }
__device__ __forceinline__ int crow(int r, int hi) { return (r & 3) + 8 * (r >> 2) + 4 * hi; }
__device__ __forceinline__ unsigned pk(float lo, float hi) { return pg8::cvt_pk_bf16(lo, hi); }
__device__ __forceinline__ float swap_max(float v) { auto rr = __builtin_amdgcn_permlane32_swap(__float_as_uint(v), __float_as_uint(v), false, false); return fmaxf(__uint_as_float(rr[0]), __uint_as_float(rr[1])); }
__device__ __forceinline__ float swap_add(float v) { auto rr = __builtin_amdgcn_permlane32_swap(__float_as_uint(v), __float_as_uint(v), false, false); return __uint_as_float(rr[0]) + __uint_as_float(rr[1]); }
__device__ __forceinline__ bf16x8 pack8r(const f32x16& p, int b) {
    u32x4 w; w.x = pk(p[b], p[b + 1]); w.y = pk(p[b + 2], p[b + 3]); w.z = pk(p[b + 4], p[b + 5]); w.w = pk(p[b + 6], p[b + 7]); return __builtin_bit_cast(bf16x8, w); }

template <class T> __device__ __forceinline__ void attn_unit(ALAS unsigned char* lds, const T& t, int b, int qb) {
    constexpr int NDS = T::NDS, NDH = T::NDH, KP = NDS * 32 + 16, VP = 136, KB = 64 * KP, VB = NDH * 32 * VP, NKC = NDS * 2, NVC = NDH * 4;
    const int tid = threadIdx.x, lane = tid & 63, r = lane & 31, h = lane >> 5, w = __builtin_amdgcn_readfirstlane(tid >> 6);
    ALAS unsigned char* Kl = lds; ALAS unsigned char* Vl = lds + 2 * KB; ALAS float* wsc = (ALAS float*)(lds + 2 * KB + 2 * VB) + 32 * w;
    const int q0 = qb * 256; const size_t qrow = (size_t)b * SEQ + q0 + 32 * w + r;
    bf16x8 qf[NDS];
#pragma unroll
    for (int d0 = 0; d0 < NDS; ++d0) qf[d0] = *(const bf16x8*)t.qptr(qrow, d0, h);
    const int NT = T::CAUSAL ? 4 * qb + 4 : T::NKV / 64; const int my_last = T::CAUSAL ? 4 * qb + (w >> 1) : NT - 1;
    const size_t kvrow0 = (size_t)b * (T::CAUSAL ? SEQ : T::NKV) + lane;
    f32x16 o[NDH];
#pragma unroll
    for (int dh = 0; dh < NDH; ++dh)
#pragma unroll
        for (int i = 0; i < 16; ++i) o[dh][i] = 0.f;
    float m = -1e30f, l = 0.f;
    u32x4 kreg[2], vreg[2];
#define ATT_LOAD(tile) do { const size_t kr_ = kvrow0 + (size_t)(tile) * 64; \
        _Pragma("unroll") for (int i_ = 0; i_ < 2; ++i_) { if (w + 8 * i_ < NKC) kreg[i_] = *(const u32x4*)t.kchunk(kr_, w + 8 * i_); if (w + 8 * i_ < NVC) vreg[i_] = *(const u32x4*)t.vchunk(kr_, w + 8 * i_); } } while (0)
#define ATT_WRITE(buf) do { ALAS unsigned char* kb_ = Kl + (buf) * KB; ALAS unsigned char* vb_ = Vl + (buf) * VB; \
        _Pragma("unroll") for (int i_ = 0; i_ < 2; ++i_) { if (w + 8 * i_ < NKC) *(ALAS u32x4*)(kb_ + lane * KP + (w + 8 * i_) * 16) = kreg[i_]; \
            if (w + 8 * i_ < NVC) { const u32x4 v_ = vreg[i_]; ALAS unsigned short* vp_ = (ALAS unsigned short*)(vb_ + (8 * (w + 8 * i_)) * VP + lane * 2); \
                vp_[0 * (VP / 2)] = (unsigned short)(v_.x & 0xffff); vp_[1 * (VP / 2)] = (unsigned short)(v_.x >> 16); vp_[2 * (VP / 2)] = (unsigned short)(v_.y & 0xffff); vp_[3 * (VP / 2)] = (unsigned short)(v_.y >> 16); \
                vp_[4 * (VP / 2)] = (unsigned short)(v_.z & 0xffff); vp_[5 * (VP / 2)] = (unsigned short)(v_.z >> 16); vp_[6 * (VP / 2)] = (unsigned short)(v_.w & 0xffff); vp_[7 * (VP / 2)] = (unsigned short)(v_.w >> 16); } } } while (0)
    ATT_LOAD(0); ATT_WRITE(0); lds_barrier();
    for (int tile = 0; tile < NT; ++tile) {
        const bool more = tile + 1 < NT;
        if (more) ATT_LOAD(tile + 1);
        if (tile <= my_last) {
            const ALAS unsigned char* Kb = Kl + (tile & 1) * KB; const ALAS unsigned char* Vb = Vl + (tile & 1) * VB;
            f32x16 p0, p1;
#pragma unroll
            for (int i = 0; i < 16; ++i) { p0[i] = 0.f; p1[i] = 0.f; }
#pragma unroll
            for (int d0 = 0; d0 < NDS; ++d0) { const bf16x8 a0 = *(const ALAS bf16x8*)(Kb + r * KP + (16 * d0 + 8 * h) * 2), a1 = *(const ALAS bf16x8*)(Kb + (32 + r) * KP + (16 * d0 + 8 * h) * 2);
                p0 = __builtin_amdgcn_mfma_f32_32x32x16_bf16(a0, qf[d0], p0, 0, 0, 0); p1 = __builtin_amdgcn_mfma_f32_32x32x16_bf16(a1, qf[d0], p1, 0, 0, 0); }
            if (T::SCALE != 1.0f) {
#pragma unroll
                for (int i = 0; i < 16; ++i) { p0[i] *= T::SCALE; p1[i] *= T::SCALE; } }
            if (T::CAUSAL && tile >= 4 * qb) { const int qi = q0 + 32 * w + r, kb0 = 64 * tile;
#pragma unroll
                for (int i = 0; i < 16; ++i) { const int kv = kb0 + crow(i, h); if (kv > qi) p0[i] = -1e30f; if (kv + 32 > qi) p1[i] = -1e30f; } }
            float mx = fmaxf(p0[0], p1[0]);
#pragma unroll
            for (int i = 1; i < 16; ++i) mx = fmaxf(mx, fmaxf(p0[i], p1[i]));
            mx = swap_max(mx);
            const float mn = fmaxf(m, mx);
            if (__any(mn > m)) { const float alpha = __builtin_amdgcn_exp2f(m - mn); l *= alpha; m = mn;
                if (h == 0) wsc[r] = alpha;
#pragma unroll
                for (int i = 0; i < 16; ++i) { const float f = wsc[crow(i, h)];
#pragma unroll
                    for (int dh = 0; dh < NDH; ++dh) o[dh][i] *= f; } }
            float ls = 0.f;
#pragma unroll
            for (int i = 0; i < 16; ++i) { p0[i] = __builtin_amdgcn_exp2f(p0[i] - m); p1[i] = __builtin_amdgcn_exp2f(p1[i] - m); ls += p0[i] + p1[i]; }
            l += ls;
            bf16x8 pa[4]; pa[0] = pack8r(p0, 0); pa[1] = pack8r(p0, 8); pa[2] = pack8r(p1, 0); pa[3] = pack8r(p1, 8);
#pragma unroll
            for (int dh = 0; dh < NDH; ++dh)
#pragma unroll
                for (int ks = 0; ks < 4; ++ks) { const ALAS unsigned char* vp = Vb + (32 * dh + r) * VP + (16 * ks + 4 * h) * 2;
                    const bf16x4 lo = *(const ALAS bf16x4*)vp, hi = *(const ALAS bf16x4*)(vp + 16);
                    const bf16x8 vb = {lo[0], lo[1], lo[2], lo[3], hi[0], hi[1], hi[2], hi[3]};
                    o[dh] = __builtin_amdgcn_mfma_f32_32x32x16_bf16(pa[ks], vb, o[dh], 0, 0, 0); }
        }
        if (more) ATT_WRITE((tile + 1) & 1);
        lds_barrier();
    }
#undef ATT_LOAD
#undef ATT_WRITE
    l = swap_add(l);
    if (h == 0) wsc[r] = 1.f / l;
#pragma unroll
    for (int i = 0; i < 16; ++i) { const float f = wsc[crow(i, h)]; bf16* op = t.optr((size_t)b * SEQ + q0 + 32 * w + crow(i, h));
#pragma unroll
        for (int dh = 0; dh < NDH; ++dh) op[32 * dh + r] = f2bf(o[dh][i] * f); }
}
struct MlaT { static constexpr int NDS = 6, NDH = 2, NKV = SEQ; static constexpr bool CAUSAL = true; static constexpr float SCALE = 1.0f;
    const bf16 *Q, *KV, *KR; bf16* O; int head, pad;
    __device__ __forceinline__ const bf16* qptr(size_t row, int d0, int h) const { return d0 < 4 ? Q + row * QW + 64 * head + 16 * d0 + 8 * h : Q + row * QW + 512 + 32 * head + 16 * (d0 - 4) + 8 * h; }
    __device__ __forceinline__ const bf16* kchunk(size_t row, int c) const { return c < 8 ? KV + row * KVW + 64 * head + 8 * c : KR + row * 32 + 8 * (c - 8); }
    __device__ __forceinline__ const bf16* vchunk(size_t row, int c) const { return KV + row * KVW + 512 + 64 * head + 8 * c; }
    __device__ __forceinline__ bf16* optr(size_t row) const { return O + row * 512 + 64 * head; } };
struct CrossT { static constexpr int NDS = 8, NDH = 4, NKV = NMEM; static constexpr bool CAUSAL = false; static constexpr float SCALE = XSCALE;
    const bf16 *Q, *KV; bf16* O; int head, pad;
    __device__ __forceinline__ const bf16* qptr(size_t row, int d0, int h) const { return Q + row * ZXQ_W + 128 * head + 16 * d0 + 8 * h; }
    __device__ __forceinline__ const bf16* kchunk(size_t row, int c) const { return KV + row * 1024 + 128 * head + 8 * c; }
    __device__ __forceinline__ const bf16* vchunk(size_t row, int c) const { return KV + row * 1024 + 512 + 128 * head + 8 * c; }
    __device__ __forceinline__ bf16* optr(size_t row) const { return O + row * 512 + 128 * head; } };

constexpr int G_W = 0, G_B = 4096, G_LA = 4352, G_SEG = G_LA + 64 * 65 * 4, G_QT = G_SEG + 8 * 64 * 4, G_KT = G_QT + 64 * 144, G_VT = G_KT + 64 * 144, G_OT = G_VT + 128 * 144, G_END = G_OT + 64 * 132 * 4;
static_assert(G_END <= 131072 && (G_QT % 16) == 0 && (G_OT % 16) == 0, "gla lds map");
__device__ __forceinline__ void gla_load_w(ALAS unsigned char* lds, const float* w_a2, const float* b_a, int h) {
    ALAS float* W = (ALAS float*)(lds + G_W); ALAS float* Bv = (ALAS float*)(lds + G_B); const int tid = threadIdx.x;
    for (int i = tid; i < 1024; i += 512) W[i] = w_a2[(i >> 6) * 256 + 64 * h + (i & 63)];
    if (tid < 64) Bv[tid] = b_a[64 * h + tid];
}
struct GlaIn { u32x4 ga0, ga1, q, k, v0, v1, r0, r1; bf16x8 sp[4]; };
template <bool PASS_C> __device__ __forceinline__ void gla_load(GlaIn& g, const bf16* zc, const bf16* zg, const bf16* SPREV, int b, int h, int n) {
    const int tid = threadIdx.x, lane = tid & 63, r = lane & 31, hh = lane >> 5, w = tid >> 6, t = tid >> 3, db = tid & 7; const size_t row0 = (size_t)b * SEQ + 64 * n;
    g.ga0 = *(const u32x4*)(zc + (row0 + t) * ZC_W + ZC_GA); g.ga1 = *(const u32x4*)(zc + (row0 + t) * ZC_W + ZC_GA + 8);
    g.k = *(const u32x4*)(zg + (row0 + t) * ZG_W + ZG_K + 64 * h + 8 * db);
    g.v0 = *(const u32x4*)(zg + (row0 + lane) * ZG_W + ZG_V + 128 * h + 8 * w); g.v1 = *(const u32x4*)(zg + (row0 + lane) * ZG_W + ZG_V + 128 * h + 8 * (w + 8));
    if (PASS_C) { g.q = *(const u32x4*)(zg + (row0 + t) * ZG_W + ZG_Q + 64 * h + 8 * db);
        g.r0 = *(const u32x4*)(zg + (row0 + t) * ZG_W + ZG_R + 128 * h + 16 * db); g.r1 = *(const u32x4*)(zg + (row0 + t) * ZG_W + ZG_R + 128 * h + 16 * db + 8);
        const int vi = w & 3; const bf16* sp = SPREV + ((size_t)((b * 4 + h) * GLA_N + n) * 128) * 64;
#pragma unroll
        for (int ks = 0; ks < 4; ++ks) g.sp[ks] = *(const bf16x8*)(sp + (32 * vi + r) * 64 + 16 * ks + 8 * hh); }
}
__device__ __forceinline__ void gla_bcum(ALAS unsigned char* lds, const u32x4 g0, const u32x4 g1) {
    const ALAS float* W = (const ALAS float*)(lds + G_W); const ALAS float* Bv = (const ALAS float*)(lds + G_B); ALAS float* LA = (ALAS float*)(lds + G_LA); ALAS float* SEGS = (ALAS float*)(lds + G_SEG);
    const int tid = threadIdx.x; { const int t = tid >> 3, db = tid & 7;
        float ga[16]; ga[0] = __uint_as_float(g0.x << 16); ga[1] = __uint_as_float(g0.x & 0xffff0000u); ga[2] = __uint_as_float(g0.y << 16); ga[3] = __uint_as_float(g0.y & 0xffff0000u);
        ga[4] = __uint_as_float(g0.z << 16); ga[5] = __uint_as_float(g0.z & 0xffff0000u); ga[6] = __uint_as_float(g0.w << 16); ga[7] = __uint_as_float(g0.w & 0xffff0000u);
        ga[8] = __uint_as_float(g1.x << 16); ga[9] = __uint_as_float(g1.x & 0xffff0000u); ga[10] = __uint_as_float(g1.y << 16); ga[11] = __uint_as_float(g1.y & 0xffff0000u);
        ga[12] = __uint_as_float(g1.z << 16); ga[13] = __uint_as_float(g1.z & 0xffff0000u); ga[14] = __uint_as_float(g1.w << 16); ga[15] = __uint_as_float(g1.w & 0xffff0000u);
#pragma unroll
        for (int e = 0; e < 8; ++e) { const int d = 8 * db + e; float pre = Bv[d];
#pragma unroll
            for (int j = 0; j < 16; ++j) pre += ga[j] * W[j * 64 + d];
            LA[t * 65 + d] = (fminf(pre, 0.f) - __logf(1.f + __expf(-fabsf(pre)))) * (1.f / 16.f); } }
    lds_barrier();
    const int d = tid & 63, sg = tid >> 6; float v[8];
#pragma unroll
    for (int i = 0; i < 8; ++i) v[i] = LA[(8 * sg + i) * 65 + d];
#pragma unroll
    for (int i = 1; i < 8; ++i) v[i] += v[i - 1];
    SEGS[sg * 64 + d] = v[7];
    lds_barrier();
    float off = 0.f;
#pragma unroll
    for (int s2 = 0; s2 < 7; ++s2) off += (s2 < sg) ? SEGS[s2 * 64 + d] : 0.f;
#pragma unroll
    for (int i = 0; i < 8; ++i) LA[(8 * sg + i) * 65 + d] = v[i] + off;
    lds_barrier();
}
__device__ __forceinline__ void gla_stage_vt(ALAS unsigned char* lds, const u32x4 va, const u32x4 vb2) {
    const int tid = threadIdx.x, lane = tid & 63, w = tid >> 6;
#pragma unroll
    for (int i = 0; i < 2; ++i) { const int c = w + 8 * i; const u32x4 v = i ? vb2 : va;
        ALAS unsigned short* vp = (ALAS unsigned short*)(lds + G_VT + (8 * c) * 144 + lane * 2);
        vp[0 * 72] = (unsigned short)(v.x & 0xffff); vp[1 * 72] = (unsigned short)(v.x >> 16); vp[2 * 72] = (unsigned short)(v.y & 0xffff); vp[3 * 72] = (unsigned short)(v.y >> 16);
        vp[4 * 72] = (unsigned short)(v.z & 0xffff); vp[5 * 72] = (unsigned short)(v.z >> 16); vp[6 * 72] = (unsigned short)(v.w & 0xffff); vp[7 * 72] = (unsigned short)(v.w >> 16); }
}
__device__ __forceinline__ void gla_pass_a(ALAS unsigned char* lds, const bf16* zc, const bf16* zg, float* DS, float* DEC, const float* w_a2, const float* b_a, int first, int G) {
    const int tid = threadIdx.x, lane = tid & 63, r = lane & 31, hh = lane >> 5, w = __builtin_amdgcn_readfirstlane(tid >> 6);
    GlaIn cur, nxt; if (first < NB * 4 * GLA_N) gla_load<false>(cur, zc, zg, nullptr, first >> 7, (first >> 5) & 3, first & 31);
    int lasth = -1;
    for (int u = first; u < NB * 4 * GLA_N; u += G) { const int n = u & 31, h = (u >> 5) & 3, b = u >> 7;
        if (h != lasth) { lds_barrier(); gla_load_w(lds, w_a2, b_a, h); lds_barrier(); lasth = h; }
        const bool more = u + G < NB * 4 * GLA_N; if (more) gla_load<false>(nxt, zc, zg, nullptr, (u + G) >> 7, ((u + G) >> 5) & 3, (u + G) & 31);
        gla_bcum(lds, cur.ga0, cur.ga1);
        const ALAS float* LA = (const ALAS float*)(lds + G_LA);
        { const int t = tid >> 3, db = tid & 7; const u32x4 kk = cur.k;
          float kf[8]; kf[0] = __uint_as_float(kk.x << 16); kf[1] = __uint_as_float(kk.x & 0xffff0000u); kf[2] = __uint_as_float(kk.y << 16); kf[3] = __uint_as_float(kk.y & 0xffff0000u);
          kf[4] = __uint_as_float(kk.z << 16); kf[5] = __uint_as_float(kk.z & 0xffff0000u); kf[6] = __uint_as_float(kk.w << 16); kf[7] = __uint_as_float(kk.w & 0xffff0000u);
#pragma unroll
          for (int e = 0; e < 8; ++e) { const int d = 8 * db + e; const float kd = kf[e] * __expf(LA[63 * 65 + d] - LA[t * 65 + d]); *(ALAS unsigned short*)(lds + G_KT + d * 144 + t * 2) = f2bf(kd); } }
        gla_stage_vt(lds, cur.v0, cur.v1);
        lds_barrier();
        const int dvt = w >> 1, dt = w & 1; f32x16 acc;
#pragma unroll
        for (int i = 0; i < 16; ++i) acc[i] = 0.f;
#pragma unroll
        for (int ks = 0; ks < 4; ++ks) { const bf16x8 a = *(const ALAS bf16x8*)(lds + G_VT + (32 * dvt + r) * 144 + (16 * ks + 8 * hh) * 2), bb = *(const ALAS bf16x8*)(lds + G_KT + (32 * dt + r) * 144 + (16 * ks + 8 * hh) * 2);
            acc = __builtin_amdgcn_mfma_f32_32x32x16_bf16(a, bb, acc, 0, 0, 0); }
        float* dsp = DS + ((size_t)((b * 4 + h) * GLA_N + n) * 128) * 64;
#pragma unroll
        for (int i = 0; i < 16; ++i) dsp[(32 * dvt + crow(i, hh)) * 64 + 32 * dt + r] = acc[i];
        if (tid < 64) DEC[(size_t)((b * 4 + h) * GLA_N + n) * 64 + tid] = __expf(LA[63 * 65 + tid]);
        lds_barrier();
        if (more) cur = nxt;
    }
}
__device__ __forceinline__ void gla_pass_c(ALAS unsigned char* lds, const bf16* zc, const bf16* zg, const bf16* SPREV, const float* o_norm, bf16* OG, const float* w_a2, const float* b_a, int first, int G) {
    const int tid = threadIdx.x, lane = tid & 63, r = lane & 31, hh = lane >> 5, w = __builtin_amdgcn_readfirstlane(tid >> 6);
    float on[16];
#pragma unroll
    for (int e = 0; e < 16; ++e) on[e] = o_norm[16 * (tid & 7) + e];
    GlaIn cur, nxt; if (first < NB * 4 * GLA_N) gla_load<true>(cur, zc, zg, SPREV, first >> 7, (first >> 5) & 3, first & 31);
    int lasth = -1;
    for (int u = first; u < NB * 4 * GLA_N; u += G) { const int n = u & 31, h = (u >> 5) & 3, b = u >> 7; const size_t row0 = (size_t)b * SEQ + 64 * n;
        if (h != lasth) { lds_barrier(); gla_load_w(lds, w_a2, b_a, h); lds_barrier(); lasth = h; }
        const bool more = u + G < NB * 4 * GLA_N; if (more) gla_load<true>(nxt, zc, zg, SPREV, (u + G) >> 7, ((u + G) >> 5) & 3, (u + G) & 31);
        gla_bcum(lds, cur.ga0, cur.ga1);
        const ALAS float* LA = (const ALAS float*)(lds + G_LA);
        { const int t = tid >> 3, db = tid & 7; const u32x4 qq = cur.q, kk = cur.k;
          const unsigned qw[4] = {qq.x, qq.y, qq.z, qq.w}, kw[4] = {kk.x, kk.y, kk.z, kk.w}; unsigned qo[4], ko[4];
#pragma unroll
          for (int e = 0; e < 4; ++e) { const float b0 = LA[t * 65 + 8 * db + 2 * e], b1 = LA[t * 65 + 8 * db + 2 * e + 1]; const float e0 = __expf(b0), e1 = __expf(b1), i0 = __expf(-b0), i1 = __expf(-b1);
              qo[e] = pk(__uint_as_float(qw[e] << 16) * 0.125f * e0, __uint_as_float(qw[e] & 0xffff0000u) * 0.125f * e1); ko[e] = pk(__uint_as_float(kw[e] << 16) * i0, __uint_as_float(kw[e] & 0xffff0000u) * i1); }
          *(ALAS u32x4*)(lds + G_QT + t * 144 + db * 16) = (u32x4){qo[0], qo[1], qo[2], qo[3]}; *(ALAS u32x4*)(lds + G_KT + t * 144 + db * 16) = (u32x4){ko[0], ko[1], ko[2], ko[3]}; }
        gla_stage_vt(lds, cur.v0, cur.v1);
        lds_barrier();
        const int ci = w >> 2, vi = w & 3; bf16x8 pa[4];
#pragma unroll
        for (int jh = 0; jh < 2; ++jh) { if (jh <= ci) { f32x16 pj;
#pragma unroll
                for (int i = 0; i < 16; ++i) pj[i] = 0.f;
#pragma unroll
                for (int ks = 0; ks < 4; ++ks) { const bf16x8 a = *(const ALAS bf16x8*)(lds + G_KT + (32 * jh + r) * 144 + (16 * ks + 8 * hh) * 2), bb = *(const ALAS bf16x8*)(lds + G_QT + (32 * ci + r) * 144 + (16 * ks + 8 * hh) * 2);
                    pj = __builtin_amdgcn_mfma_f32_32x32x16_bf16(a, bb, pj, 0, 0, 0); }
#pragma unroll
                for (int i = 0; i < 16; ++i) if (32 * jh + crow(i, hh) > 32 * ci + r) pj[i] = 0.f;
                pa[2 * jh] = pack8r(pj, 0); pa[2 * jh + 1] = pack8r(pj, 8); } else { pa[2 * jh] = (bf16x8){0, 0, 0, 0, 0, 0, 0, 0}; pa[2 * jh + 1] = pa[2 * jh]; } }
        f32x16 acc;
#pragma unroll
        for (int i = 0; i < 16; ++i) acc[i] = 0.f;
#pragma unroll
        for (int ks = 0; ks < 4; ++ks) { if ((ks >> 1) <= ci) { const ALAS unsigned char* vp = lds + G_VT + (32 * vi + r) * 144 + (16 * ks + 4 * hh) * 2;
                const bf16x4 lo = *(const ALAS bf16x4*)vp, hi = *(const ALAS bf16x4*)(vp + 16); const bf16x8 vb = {lo[0], lo[1], lo[2], lo[3], hi[0], hi[1], hi[2], hi[3]};
                acc = __builtin_amdgcn_mfma_f32_32x32x16_bf16(pa[ks], vb, acc, 0, 0, 0); } }
#pragma unroll
        for (int ks = 0; ks < 4; ++ks) { const bf16x8 a = *(const ALAS bf16x8*)(lds + G_QT + (32 * ci + r) * 144 + (16 * ks + 8 * hh) * 2);
            acc = __builtin_amdgcn_mfma_f32_32x32x16_bf16(a, cur.sp[ks], acc, 0, 0, 0); }
        ALAS float* OT = (ALAS float*)(lds + G_OT);
#pragma unroll
        for (int i = 0; i < 16; ++i) OT[(32 * ci + crow(i, hh)) * 132 + 32 * vi + r] = acc[i];
        lds_barrier();
        { const int c = tid >> 3, part = tid & 7; float v[16]; float ss = 0.f;
#pragma unroll
          for (int e = 0; e < 16; ++e) { v[e] = OT[c * 132 + 16 * part + e]; ss += v[e] * v[e]; }
          ss += __shfl_xor(ss, 1); ss += __shfl_xor(ss, 2); ss += __shfl_xor(ss, 4);
          const float rs = rsqrtf(ss * (1.f / 128.f) + EPS);
          const u32x4 g0 = cur.r0, g1 = cur.r1;
          const unsigned gw[8] = {g0.x, g0.y, g0.z, g0.w, g1.x, g1.y, g1.z, g1.w}; unsigned ow[8];
#pragma unroll
          for (int e = 0; e < 8; ++e) { const float r0 = __uint_as_float(gw[e] << 16), r1 = __uint_as_float(gw[e] & 0xffff0000u);
              ow[e] = pk(v[2 * e] * rs * on[2 * e] * (r0 * pg8::fsig(r0)), v[2 * e + 1] * rs * on[2 * e + 1] * (r1 * pg8::fsig(r1))); }
          bf16* op = OG + (row0 + c) * 512 + 128 * h + 16 * part; *(u32x4*)op = (u32x4){ow[0], ow[1], ow[2], ow[3]}; *(u32x4*)(op + 8) = (u32x4){ow[4], ow[5], ow[6], ow[7]}; }
        lds_barrier();
        if (more) cur = nxt;
    }
}
#undef ALAS
}
constexpr int NWAVES = 8;
constexpr int RING_OFF = 0, RING_BYTES = 131072;
constexpr int LDSCTL_OFF = RING_BYTES, MISC_OFF = LDSCTL_OFF + 320;
constexpr int LDS_BYTES = 147456;
constexpr int CW_TMO = 0, CW_CODE = 1, CW_BAR = 4096;
constexpr size_t CTL_ZERO_BYTES = 1 * MiB;
constexpr int NPH = 18;
#define GAS __attribute__((address_space(1)))
#define LAS __attribute__((address_space(3)))
typedef unsigned short bf16;
typedef unsigned v4u __attribute__((ext_vector_type(4)));
typedef float f32x4 __attribute__((ext_vector_type(4)));
typedef short bf16x8 __attribute__((ext_vector_type(8)));
typedef GAS unsigned gu32;
typedef GAS unsigned long long gu64;
#define RLX_AGENT __ATOMIC_RELAXED, __HIP_MEMORY_SCOPE_AGENT
#define LDS_WAIT() asm volatile("s_waitcnt lgkmcnt(0)" ::: "memory")
#define VM_WAIT() asm volatile("s_waitcnt vmcnt(0)" ::: "memory")
__device__ __forceinline__ unsigned long long rt() { return __builtin_amdgcn_s_memrealtime(); }
__device__ __forceinline__ unsigned f2bfu(float f) { unsigned u = __builtin_bit_cast(unsigned, f); return (u + 0x7fffu + ((u >> 16) & 1u)) >> 16; }
__device__ __forceinline__ unsigned pk2(float lo, float hi) { return pg8::cvt_pk_bf16(lo, hi); }

#define XB_TMO      128
#define XB_XCNT(j)  (256  + 64 * (j))
#define XB_XSUB(j)  (1280 + 64 * (j))
#define XB_XGEN(j)  (2304 + 64 * (j))
#define XB_TOP      3328
#define XB_TOPGEN   3392
#define XCD_BAR_WORDS 3456
#define XB_SPIN_CAP (1u << 18)

__device__ __forceinline__ unsigned xb_ld(unsigned* p)              { return __hip_atomic_load(p, __ATOMIC_RELAXED, __HIP_MEMORY_SCOPE_AGENT); }
__device__ __forceinline__ unsigned xb_add(unsigned* p, unsigned v) { return __hip_atomic_fetch_add(p, v, __ATOMIC_RELAXED, __HIP_MEMORY_SCOPE_AGENT); }
__device__ __forceinline__ unsigned xb_xcc_id() { return (unsigned)__builtin_amdgcn_s_getreg((3 << 11) | 20) & 0xFu; }
#define XB_SPIN(cond, bar) do { unsigned _sp = 0; while (cond) { __builtin_amdgcn_s_sleep(1); \
    if ((++_sp & 255u) == 0u) { if (xb_ld(&(bar)[XB_TMO])) break; if (_sp > XB_SPIN_CAP) { atomicAdd(&(bar)[XB_TMO], 1u); break; } } } } while (0)

struct XcdBarrier {
    unsigned* bar; unsigned x;
    volatile LAS unsigned* st;
};

__device__ __forceinline__ XcdBarrier xcd_barrier_post(unsigned* bar, volatile LAS unsigned* st) {
    XcdBarrier b; b.bar = bar; b.x = xb_xcc_id(); b.st = st;
    if (threadIdx.x == 0) (void)xb_add(&bar[XB_XCNT(b.x)], 1u);
    return b;
}
__device__ __forceinline__ void xcd_barrier_complete(unsigned* bar, unsigned x, unsigned& nloc, unsigned& nx) {
    const unsigned G = gridDim.x * gridDim.y * gridDim.z;
    unsigned sum, cnt, mine, sp = 0u;
    for (;;) {
        sum = 0u; cnt = 0u; mine = 0u;
#pragma unroll
        for (unsigned j = 0; j < 16; ++j) { const unsigned c = xb_ld(&bar[XB_XCNT(j)]); sum += c; cnt += (c > 0u) ? 1u : 0u; mine = (j == x) ? c : mine; }
        if (sum == G) break;
        __builtin_amdgcn_s_sleep(1);
        if ((++sp & 255u) == 0u) { if (xb_ld(&bar[XB_TMO])) break; if (sp > XB_SPIN_CAP) { atomicAdd(&bar[XB_TMO], 1u); break; } }
    }
    nloc = mine > 0u ? mine : 1u; nx = cnt > 0u ? cnt : 1u;
}

__device__ __forceinline__ void xcd_barrier(const XcdBarrier& b) {
    asm volatile("s_waitcnt vmcnt(0)" ::: "memory");
    __syncthreads();
    if (threadIdx.x == 0) {
        unsigned* bar = b.bar;
        __builtin_amdgcn_s_waitcnt(0);
        unsigned nloc = b.st[0], nx = b.st[1];
        if (nloc == 0u) { xcd_barrier_complete(bar, b.x, nloc, nx); b.st[0] = nloc; b.st[1] = nx; }
        const unsigned old = xb_add(&bar[XB_XSUB(b.x)], 1u);
        const unsigned gen = old / nloc;
        if (old + 1u == (gen + 1u) * nloc) {
            __builtin_amdgcn_fence(__ATOMIC_RELEASE, "agent");
            asm volatile("s_waitcnt vmcnt(0)" ::: "memory");
            const unsigned og = xb_add(&bar[XB_TOP], 1u);
            const unsigned tg = og / nx;
            if (og + 1u == (tg + 1u) * nx) xb_add(&bar[XB_TOPGEN], 1u);
            else XB_SPIN(xb_ld(&bar[XB_TOPGEN]) == tg, bar);
            __builtin_amdgcn_fence(__ATOMIC_ACQUIRE, "agent");
            xb_add(&bar[XB_XGEN(b.x)], 1u);
            asm volatile("s_waitcnt vmcnt(0)" ::: "memory");
        } else {
            XB_SPIN(xb_ld(&bar[XB_XGEN(b.x)]) == gen, bar);
            __builtin_amdgcn_fence(__ATOMIC_ACQUIRE, "agent");
            asm volatile("s_waitcnt vmcnt(0)" ::: "memory");
        }
    }
    __syncthreads();
}

__device__ __forceinline__ float wave_sum(float v) {
#pragma unroll
    for (int o = 1; o < 64; o <<= 1) v += __shfl_xor(v, o);
    return v;
}
struct ConvJob { const float* W; const float* gain; bf16* WT; int ldw, col0, nvalid, K, k0, drow0; };
__device__ __forceinline__ void conv_item(const ConvJob& j, int lane) {
    const int n4 = lane & 7, kg = lane >> 3; f32x4 v[8];
    const bool valid = 4 * n4 < j.nvalid;
#pragma unroll
    for (int i = 0; i < 8; ++i) v[i] = valid ? *(const GAS f32x4*)(j.W + (size_t)(j.k0 + 8 * kg + i) * j.ldw + j.col0 + 4 * n4) : (f32x4){0.f, 0.f, 0.f, 0.f};
    if (j.gain) {
#pragma unroll
        for (int i = 0; i < 8; ++i) v[i] = v[i] * j.gain[j.k0 + 8 * kg + i]; }
#pragma unroll
    for (int e = 0; e < 4; ++e) { v4u o; o.x = pk2(v[0][e], v[1][e]); o.y = pk2(v[2][e], v[3][e]); o.z = pk2(v[4][e], v[5][e]); o.w = pk2(v[6][e], v[7][e]);
        *(GAS v4u*)(j.WT + (size_t)(j.drow0 + 4 * n4 + e) * j.K + j.k0 + 8 * kg) = o; }
}
__device__ __forceinline__ void cvt_row_ss(const float* xrow, bf16* orow, float* ssrow, int lane) {
    const GAS f32x4* xr = (const GAS f32x4*)xrow + lane; f32x4 v[4]; float s = 0.f;
#pragma unroll
    for (int j = 0; j < 4; ++j) { v[j] = xr[64 * j]; s += (v[j].x * v[j].x + v[j].y * v[j].y) + (v[j].z * v[j].z + v[j].w * v[j].w); }
    s = wave_sum(s); if (lane == 0) *ssrow = s;
    GAS unsigned long long* o8 = (GAS unsigned long long*)orow + lane;
#pragma unroll
    for (int j = 0; j < 4; ++j) o8[64 * j] = (unsigned long long)pk2(v[j].x, v[j].y) | ((unsigned long long)pk2(v[j].z, v[j].w) << 32);
}
__device__ __forceinline__ void rms_row_to_bf16(const float* xrow, const float* g, bf16* orow, int lane) {
    const GAS f32x4* xr = (const GAS f32x4*)xrow + lane; const GAS f32x4* gr = (const GAS f32x4*)g + lane;
    f32x4 v[4]; float s = 0.f;
#pragma unroll
    for (int j = 0; j < 4; ++j) { v[j] = xr[64 * j]; s += (v[j].x * v[j].x + v[j].y * v[j].y) + (v[j].z * v[j].z + v[j].w * v[j].w); }
    const float rs = rsqrtf(wave_sum(s) * (1.f / D) + EPS);
    GAS unsigned long long* o8 = (GAS unsigned long long*)orow + lane;
#pragma unroll
    for (int j = 0; j < 4; ++j) { const f32x4 gg = gr[64 * j]; o8[64 * j] = (unsigned long long)pk2(v[j].x * rs * gg.x, v[j].y * rs * gg.y) | ((unsigned long long)pk2(v[j].z * rs * gg.z, v[j].w * rs * gg.w) << 32); }
}
__device__ __forceinline__ void rms_row_to_f32(float* xrow, const float* g, int lane) {
    GAS f32x4* xr = (GAS f32x4*)xrow + lane; const GAS f32x4* gr = (const GAS f32x4*)g + lane;
    f32x4 v[4]; float s = 0.f;
#pragma unroll
    for (int j = 0; j < 4; ++j) { v[j] = xr[64 * j]; s += (v[j].x * v[j].x + v[j].y * v[j].y) + (v[j].z * v[j].z + v[j].w * v[j].w); }
    const float rs = rsqrtf(wave_sum(s) * (1.f / D) + EPS);
#pragma unroll
    for (int j = 0; j < 4; ++j) { const f32x4 gg = gr[64 * j]; xr[64 * j] = v[j] * rs * gg; }
}

constexpr int I_GU = 16 * 176, I_D = 44 * 32, I_IN1 = 16 * 88, I_GZ = 16 * 96, I_UQ = 6 * 24, I_UKV = 4 * 32, I_O = 8 * 32, I_SQ = 16 * 32;
constexpr int NITEMS = 2 * I_GU + 2 * I_D + I_IN1 + I_GZ + I_UQ + I_UKV + 3 * I_O + 2 * I_SQ, NEARLY = I_GU + I_D, NLATE = NITEMS - NEARLY;
__device__ __forceinline__ void conv_do(const P& p, unsigned char* ws, int it, int lane) {
            int r = it; ConvJob j; j.gain = nullptr; j.nvalid = 32;
            if (r < 2 * I_GU) { const int second = r >= I_GU; if (second) r -= I_GU; const int kb = r / 176, rb = r % 176, tile = rb >> 3, sub = rb & 7;
                j.W = sub < 4 ? (second ? p.ffn2_wg : p.ffn1_wg) : (second ? p.ffn2_wu : p.ffn1_wu); j.ldw = FF; j.col0 = 128 * tile + 32 * (sub & 3); j.gain = second ? p.ffn2_norm : p.ffn1_norm; j.K = D; j.k0 = 64 * kb; j.WT = (bf16*)(ws + (second ? WS_WGU2 : WS_WGU1)); j.drow0 = 32 * rb; }
            else if ((r -= 2 * I_GU) < 2 * I_D) { const int second = r >= I_D; if (second) r -= I_D; const int kb = r / 32, rb = r % 32;
                j.W = second ? p.ffn2_wd : p.ffn1_wd; j.ldw = D; j.col0 = 32 * rb; j.K = FF; j.k0 = 64 * kb; j.WT = (bf16*)(ws + (second ? WS_WD2 : WS_WD1)); j.drow0 = 32 * rb; }
            else if ((r -= 2 * I_D) < I_IN1) { const int kb = r / 88, rb = r % 88; const int s = e1_src(32 * rb);
                j.W = p.w_in; j.ldw = DIN; j.col0 = s < 0 ? 0 : s; j.nvalid = s < 0 ? 0 : (32 * rb == ZC_GA ? 16 : 32); j.gain = p.mix_norm; j.K = D; j.k0 = 64 * kb; j.WT = (bf16*)(ws + WS_WIN1); j.drow0 = 32 * rb; }
            else if ((r -= I_IN1) < I_GZ) { const int kb = r / 96, rb = r % 96;
                j.W = p.w_in; j.ldw = DIN; j.col0 = 2736 + 32 * rb; j.gain = p.mix_norm; j.K = D; j.k0 = 64 * kb; j.WT = (bf16*)(ws + WS_WGZ); j.drow0 = 32 * rb; }
            else if ((r -= I_GZ) < I_UQ) { const int kb = r / 24, rb = r % 24, r0 = 32 * rb;
                j.W = p.w_uq; j.ldw = 768; j.col0 = r0 < 512 ? 96 * (r0 >> 6) + (r0 & 63) : 96 * ((r0 - 512) >> 5) + 64; j.gain = p.q_norm; j.K = 384; j.k0 = 64 * kb; j.WT = (bf16*)(ws + WS_WUQ); j.drow0 = r0; }
            else if ((r -= I_UQ) < I_UKV) { const int kb = r / 32, rb = r % 32, r0 = 32 * rb;
                j.W = p.w_ukv; j.ldw = 1024; j.col0 = r0 < 512 ? 128 * (r0 >> 6) + (r0 & 63) : 128 * ((r0 - 512) >> 6) + 64 + (r0 & 63); j.gain = p.kv_norm; j.K = 256; j.k0 = 64 * kb; j.WT = (bf16*)(ws + WS_WUKV); j.drow0 = r0; }
            else if ((r -= I_UKV) < 3 * I_O) { const int which = r / I_O; r -= which * I_O; const int kb = r / 32, rb = r % 32;
                j.W = which == 0 ? p.w_o_mla : which == 1 ? p.w_o_gla : p.x_w_o; j.ldw = D; j.col0 = 32 * rb; j.K = 512; j.k0 = 64 * kb; j.WT = (bf16*)(ws + WS_WOM + (size_t)which * MiB); j.drow0 = 32 * rb; }
            else { r -= 3 * I_O; const int which = r / I_SQ; r -= which * I_SQ; const int kb = r / 32, rb = r % 32;
                j.W = which == 0 ? p.x_w_kv : p.w_out; j.ldw = D; j.col0 = 32 * rb; j.K = D; j.k0 = 64 * kb; j.WT = (bf16*)(ws + (which == 0 ? WS_WXKV : WS_WOUT)); j.drow0 = 32 * rb; }
            conv_item(j, lane);
}
struct Args { P p; int ph_lo, ph_hi, li, pad; };
__global__ void __launch_bounds__(NWAVES * 64, 2) mega(Args args) {
    extern __shared__ __attribute__((aligned(16))) unsigned char lds_raw[];
    LAS unsigned char* lds = (LAS unsigned char*)lds_raw;
    volatile LAS unsigned* MISC = (volatile LAS unsigned*)(lds + MISC_OFF);
    const int tid = threadIdx.x, lane = tid & 63, wave = __builtin_amdgcn_readfirstlane(tid >> 6);
    const int G = gridDim.x; const int bx = blockIdx.x; const int vcu = (G % 8 == 0) ? (bx % 8) * (G / 8) + bx / 8 : bx;
    const P& p = args.p; unsigned char* ws = p.ws;
    gu32* ctl = (gu32*)(ws + WS_CTL);
    for (int u = tid; u < (LDS_BYTES - LDSCTL_OFF) / 4; u += NWAVES * 64) ((LAS unsigned*)(lds + LDSCTL_OFF))[u] = 0u;
#ifdef LDSPOISON
    for (int u = tid; u < RING_BYTES / 16; u += NWAVES * 64) ((LAS v4u*)lds)[u] = (v4u){0x7fc07fc0u, 0x7fc07fc0u, 0x7fc07fc0u, 0x7fc07fc0u};
#endif
    __syncthreads();
    XcdBarrier bar = xcd_barrier_post((unsigned*)(ctl + CW_BAR) + args.li * XCD_BAR_WORDS, MISC + 8);
    const int lo = args.ph_lo, hi = args.ph_hi;
#ifndef PHMASK
#define PHMASK 0x3ffff
#endif
#ifndef REPMASK
#define REPMASK 0
#endif
#define REPS(k) for (int rep_ = 0; rep_ <= ((REPMASK >> (k)) & 1); ++rep_) { if (rep_) xcd_barrier(bar);
#define REPE }
#define IN(k) (((PHMASK >> (k)) & 1) && lo <= (k) && (k) < hi)
#define SEAM(k) do { if (IN(k) && IN((k) + (((k) == 2 || (k) == 13) ? 2 : 1))) xcd_barrier(bar); } while (0)
    float *cs = (float*)(ws + WS_COS), *sn = (float*)(ws + WS_SIN), *ssqq = (float*)(ws + WS_SSQQ), *ssqkv = (float*)(ws + WS_SSQKV);
    bf16 *XN = (bf16*)(ws + WS_XN), *MEMN = (bf16*)(ws + WS_MEMN), *ACT = (bf16*)(ws + SC_ACT), *OMLA = (bf16*)(ws + SC_OMLA), *OX = (bf16*)(ws + SC_OX), *KVX = (bf16*)(ws + SC_KVX),
         *GZ = (bf16*)(ws + SC_GZ), *ZC = (bf16*)(ws + SC_ZC), *ZKV = (bf16*)(ws + SC_ZKV), *ZG = (bf16*)(ws + SC_ZG), *ZXQ = OX, *Q = (bf16*)(ws + SC_Q), *KVM = (bf16*)(ws + SC_KVM), *KR = (bf16*)(ws + SC_KR),
         *MERGED = (bf16*)p.out;
    float *SS1 = (float*)(ws + WS_SS1), *SS2 = (float*)(ws + WS_SS2), *SS3 = (float*)(ws + WS_SS3); bf16* XN3 = (bf16*)(ws + SC_XN3);
    const int gw = vcu * NWAVES + wave, NGW = G * NWAVES;

    if (IN(0)) REPS(0) {
        for (int e = gw; e < NEARLY; e += NGW) conv_do(p, ws, e < I_GU ? e : e + I_GU, lane);
        for (int m = gw; m < M; m += NGW) cvt_row_ss(p.x + (size_t)m * D, XN + (size_t)m * D, SS1 + m, lane);
    }
    REPE
    SEAM(0);
#define GEMM_PHASE(EPI, ORDER, g, S, E) pg8::gemm_phase<EPI, ORDER, true, true>(lds + RING_OFF, g, S, E)
    if (IN(1)) REPS(1) { pg8::Gemm g{XN, (const bf16*)(ws + WS_WGU1), 0, 0, D, D, D, 0}; pg8::StaticOrder S; S.init(M, 2 * FF, G, bx); pg8::EpiSwiGLU E{ACT, SS1, FF, 0}; GEMM_PHASE(pg8::EpiSwiGLU, pg8::StaticOrder, g, S, E);
        { const int nwg1 = (M / 256) * (2 * FF / 256), rem = nwg1 % G, nshort = G - rem;
          if (bx >= rem) { const int sw = (bx - rem) * NWAVES + wave, nsw = nshort * NWAVES;
              for (int e = sw; e < NLATE; e += nsw) conv_do(p, ws, e < I_GU ? I_GU + e : (e < I_GU + I_D ? e + I_GU + I_D : e + I_GU + I_D), lane);
              for (int m = sw; m < MMEM; m += nsw) rms_row_to_bf16(p.mem + (size_t)m * D, p.mem_norm, MEMN + (size_t)m * D, lane);
              for (int i = (bx - rem) * NWAVES * 64 + tid; i < M * 16; i += nshort * NWAVES * 64) { const int m = i >> 4, jj = i & 15;
                  const float inv = powf(10000.f, -(float)jj / 16.f); const float ang = (float)p.pos[m] * inv; cs[i] = cosf(ang); sn[i] = sinf(ang); } } } }
    REPE
    SEAM(1);
    if (IN(2)) { pg8::Gemm g{ACT, (const bf16*)(ws + WS_WD1), 0, 0, FF, FF, FF, 0}; pg8::StaticOrder S; S.init(M, D, G, bx); pg8::EpiResidT<false> E{p.x, XN, SS2, 0.5f, 0}; GEMM_PHASE(pg8::EpiResidT<false>, pg8::StaticOrder, g, S, E); }
    SEAM(2);
    if (IN(4)) {
        { pg8::Gemm g{XN, (const bf16*)(ws + WS_WIN1), 0, 0, D, D, D, 0}; pg8::StaticOrder S; S.init(M, Z1_W, G, bx); pg8::EpiZ1 E{ZC, ZKV, ZG, ZXQ, ssqq, ssqkv, SS2}; GEMM_PHASE(pg8::EpiZ1, pg8::StaticOrder, g, S, E); }
        { pg8::Gemm g{MEMN, (const bf16*)(ws + WS_WXKV), 0, 0, D, D, D, 0}; pg8::StaticOrder S; S.init(MMEM, 1024, G, (bx + 64) % G); pg8::EpiPlain E{KVX, 1024, 0}; GEMM_PHASE(pg8::EpiPlain, pg8::StaticOrder, g, S, E); }
    }
    SEAM(4);
    float* DSb = (float*)(ws + SC_DS); float* DECb = (float*)(ws + SC_DEC); bf16* SPREV = (bf16*)(ws + SC_SPREV); bf16* OGLA = (bf16*)(ws + SC_OGLA);
    if (IN(5)) REPS(5) { att::gla_pass_a(lds, ZC, ZG, DSb, DECb, p.w_a2, p.b_a, vcu, G); }
    REPE
    SEAM(5);
    if (IN(6)) REPS(6) { for (int gid = vcu * NWAVES * 64 + tid; gid < NB * 4 * 4096; gid += G * NWAVES * 64) { const int bh = gid >> 12, e2 = gid & 4095, dv = e2 >> 5, d = 2 * (e2 & 31); float s0 = 0.f, s1 = 0.f;
            const float* dsp = DSb + ((size_t)bh * GLA_N * 128 + dv) * 64 + d; const float* dcp = DECb + (size_t)bh * GLA_N * 64 + d; bf16* spp = SPREV + ((size_t)bh * GLA_N * 128 + dv) * 64 + d;
#pragma unroll 4
            for (int n = 0; n < GLA_N; ++n) { *(unsigned*)(spp + (size_t)n * 8192) = pk2(s0, s1); const float2 ds = *(const float2*)(dsp + (size_t)n * 8192), dc = *(const float2*)(dcp + n * 64); s0 = dc.x * s0 + ds.x; s1 = dc.y * s1 + ds.y; } } }
    REPE
    SEAM(6);
    if (IN(7)) REPS(7) { att::gla_pass_c(lds, ZC, ZG, SPREV, p.o_norm, OGLA, p.w_a2, p.b_a, vcu, G); }
    REPE
    SEAM(7);
    if (IN(8)) REPS(8) {
        for (int i = vcu * NWAVES * 64 + tid; i < M * 16; i += G * NWAVES * 64) { const int r = i >> 4, jj = i & 15; const float c = cs[i], s = sn[i];
            const bf16* z = ZC + (size_t)r * ZC_W + ZC_KROPE; const float x1 = bf2f(z[jj]), x2 = bf2f(z[jj + 16]); KR[(size_t)r * 32 + jj] = f2bf(x1 * c - x2 * s); KR[(size_t)r * 32 + jj + 16] = f2bf(x1 * s + x2 * c); }
        { pg8::Gemm g{ZC, (const bf16*)(ws + WS_WUQ), 0, 0, ZC_W, 384, 384, 0}; pg8::StaticOrder S; S.init(M, QW, G, bx); pg8::EpiQ E{Q, ssqq, cs, sn}; GEMM_PHASE(pg8::EpiQ, pg8::StaticOrder, g, S, E); }
        { pg8::Gemm g{ZKV, (const bf16*)(ws + WS_WUKV), 0, 0, ZKV_W, 256, 256, 0}; pg8::StaticOrder S; S.init(M, KVW, G, (bx + 192) % G); pg8::EpiKV E{KVM, ssqkv}; GEMM_PHASE(pg8::EpiKV, pg8::StaticOrder, g, S, E); }
    }
    REPE
    SEAM(8);
    if (IN(9)) REPS(9) { for (int it = vcu; it < NB * 8 * 4; it += G) { const int s4 = it & 3, hd = (it >> 2) & 7, b = it >> 5; att::MlaT T{Q, KVM, KR, OMLA, hd, 0};
            att::attn_unit<att::MlaT>(lds, T, b, 7 - s4); att::attn_unit<att::MlaT>(lds, T, b, s4); } }
    REPE
    SEAM(9);
    if (IN(10)) { for (int it = vcu; it < NB * 4 * 8; it += G) { const int qb = it & 7, hd = (it >> 3) & 3, b = it >> 5; att::CrossT T{ZXQ, KVX, OX, hd, 0}; att::attn_unit<att::CrossT>(lds, T, b, qb); } }
    SEAM(10);
    if (IN(11)) REPS(11) { pg8::Gemm g{XN, (const bf16*)(ws + WS_WGZ), 0, 0, D, D, D, 0}; pg8::StaticOrder S; S.init(M, 3072, G, bx);
#ifdef X3
        pg8::EpiPlain E{GZ, 3072, 0}; GEMM_PHASE(pg8::EpiPlain, pg8::StaticOrder, g, S, E);
#else
        pg8::EpiGate E{GZ, p.gate_bias, SS2}; GEMM_PHASE(pg8::EpiGate, pg8::StaticOrder, g, S, E);
#endif
    }
    REPE
    SEAM(11);
    if (IN(12)) REPS(12) { pg8::Gemm g{OMLA, (const bf16*)(ws + WS_WOM), (size_t)16 * MiB, (size_t)1 * MiB, 512, 512, 512, 0}; pg8::MergeOrder S; S.init(M, D, G, bx); pg8::EpiMerge E{MERGED, GZ}; GEMM_PHASE(pg8::EpiMerge, pg8::MergeOrder, g, S, E); }
    REPE
    SEAM(12);
    if (IN(13)) { pg8::Gemm g{MERGED, (const bf16*)(ws + WS_WOUT), 0, 0, D, D, D, 0}; pg8::StaticOrder S; S.init(M, D, G, bx); pg8::EpiResidT<true> E{XN, XN3, SS3, 1.0f, 0}; GEMM_PHASE(pg8::EpiResidT<true>, pg8::StaticOrder, g, S, E); }
    SEAM(13);
    if (IN(15)) { pg8::Gemm g{XN3, (const bf16*)(ws + WS_WGU2), 0, 0, D, D, D, 0}; pg8::StaticOrder S; S.init(M, 2 * FF, G, bx); pg8::EpiSwiGLU E{ACT, SS3, FF, 0}; GEMM_PHASE(pg8::EpiSwiGLU, pg8::StaticOrder, g, S, E); }
    SEAM(15);
    if (IN(16)) {
        if (G == 256) {
            pg8::Gemm g{ACT, (const bf16*)(ws + WS_WD2), 0, 0, FF, FF, FF, 0}; pg8::StaticOrder S; S.init(M, D, G, bx);
            pg8::EpiFinal E{XN3, p.out, p.final_norm, (float*)(ws + WS_SSF), (unsigned*)(ws + WS_FCNT), 0.5f, 0}; pg8::gemm_phase<pg8::EpiFinal, pg8::StaticOrder, false, true>(lds + RING_OFF, g, S, E);
        } else {
            { pg8::Gemm g{ACT, (const bf16*)(ws + WS_WD2), 0, 0, FF, FF, FF, 0}; pg8::StaticOrder S; S.init(M, D, G, bx); pg8::EpiResidT<true> E{XN3, XN, (float*)(ws + WS_SSF), 0.5f, 0}; GEMM_PHASE(pg8::EpiResidT<true>, pg8::StaticOrder, g, S, E); }
            xcd_barrier(bar);
            for (int m = gw; m < M; m += NGW) { const float rs = rsqrtf(__hip_atomic_load((float*)(ws + WS_SSF) + m, __ATOMIC_RELAXED, __HIP_MEMORY_SCOPE_AGENT) * (1.f / D) + EPS);
                for (int c = lane; c < D; c += 64) p.out[(size_t)m * D + c] = bf2f(XN[(size_t)m * D + c]) * rs * p.final_norm[c]; }
        }
    }
#undef IN
#undef SEAM
}

#ifndef FASTMASK
#define FASTMASK 0x3FFFFu
#endif
extern "C" void kernel_launch(void* const* d_in, const int* in_sizes, int n_in, void* d_out, int out_size, void* d_ws, size_t ws_size, hipStream_t stream) {
    if (n_in != 28 || in_sizes[0] != M * D || out_size != M * D || ws_size < WS_END) { fprintf(stderr, "kernel_launch: unexpected shapes (n_in %d, in0 %d, out %d, ws %zu)\n", n_in, n_in > 0 ? in_sizes[0] : -1, out_size, ws_size); return; }
    static int grid = 0;
    if (grid == 0) {
        int dev = 0, cus = 0;
        if (hipGetDevice(&dev) != hipSuccess || hipDeviceGetAttribute(&cus, hipDeviceAttributeMultiprocessorCount, dev) != hipSuccess) { fprintf(stderr, "kernel_launch: device query failed\n"); grid = -1; return; }
        if (hipFuncSetAttribute((const void*)mega, hipFuncAttributeMaxDynamicSharedMemorySize, LDS_BYTES) != hipSuccess) { fprintf(stderr, "kernel_launch: hipFuncSetAttribute failed\n"); grid = -1; return; }
        int per_cu = 0; if (hipOccupancyMaxActiveBlocksPerMultiprocessor(&per_cu, (const void*)mega, NWAVES * 64, LDS_BYTES) != hipSuccess || per_cu < 1) fprintf(stderr, "kernel_launch: occupancy query says %d\n", per_cu);
        (void)hipGetLastError();
        grid = cus;
    }
    if (grid < 0) return;
    P p{};
    p.x = (const float*)d_in[0]; p.mem = (const float*)d_in[1]; p.pos = (const int*)d_in[2];
    p.ffn1_norm = (const float*)d_in[3]; p.ffn1_wg = (const float*)d_in[4]; p.ffn1_wu = (const float*)d_in[5]; p.ffn1_wd = (const float*)d_in[6]; p.mix_norm = (const float*)d_in[7]; p.mem_norm = (const float*)d_in[8];
    p.w_in = (const float*)d_in[9]; p.gate_bias = (const float*)d_in[10]; p.q_norm = (const float*)d_in[11]; p.w_uq = (const float*)d_in[12]; p.kv_norm = (const float*)d_in[13]; p.w_ukv = (const float*)d_in[14];
    p.w_o_mla = (const float*)d_in[15]; p.w_a2 = (const float*)d_in[16]; p.b_a = (const float*)d_in[17]; p.o_norm = (const float*)d_in[18]; p.w_o_gla = (const float*)d_in[19]; p.x_w_kv = (const float*)d_in[20];
    p.x_w_o = (const float*)d_in[21]; p.w_out = (const float*)d_in[22]; p.ffn2_norm = (const float*)d_in[23]; p.ffn2_wg = (const float*)d_in[24]; p.ffn2_wu = (const float*)d_in[25]; p.ffn2_wd = (const float*)d_in[26];
    p.final_norm = (const float*)d_in[27]; p.out = (float*)d_out; p.ws = (unsigned char*)d_ws;
    unsigned char* ws = p.ws;
    float *cs = (float*)(ws + WS_COS), *sn = (float*)(ws + WS_SIN), *ssqq = (float*)(ws + WS_SSQQ), *ssqkv = (float*)(ws + WS_SSQKV);
    bf16 *XN = (bf16*)(ws + WS_XN), *MEMN = (bf16*)(ws + WS_MEMN), *ACT = (bf16*)(ws + SC_ACT), *OMLA = (bf16*)(ws + SC_OMLA), *OGLA = (bf16*)(ws + SC_OGLA), *OX = (bf16*)(ws + SC_OX), *KVX = (bf16*)(ws + SC_KVX),
         *GZ = (bf16*)(ws + SC_GZ), *ZC = (bf16*)(ws + SC_ZC), *ZKV = (bf16*)(ws + SC_ZKV), *ZG = (bf16*)(ws + SC_ZG), *ZXQ = OX, *Q = (bf16*)(ws + SC_Q), *KVM = (bf16*)(ws + SC_KVM), *KR = (bf16*)(ws + SC_KR),
         *MERGED = (bf16*)(ws + SC_MERGED);
    float* OTMP = (float*)(ws + SC_DS);
    (void)hipMemsetAsync((char*)d_ws + WS_CTL, 0, CTL_ZERO_BYTES, stream);
    const unsigned mask = FASTMASK; int li = 0;
    for (int ph = 0; ph < NPH; ) {
        const bool fast = (mask >> (ph >= 5 && ph <= 7 ? 5 : ph)) & 1u;
        if (fast) { int e = ph + 1; while (e < NPH && ((mask >> (e >= 5 && e <= 7 ? 5 : e)) & 1u)) ++e;
            Args a{}; a.p = p; a.ph_lo = ph; a.ph_hi = e; a.li = li++; a.pad = 0;
            hipLaunchKernelGGL(mega, dim3(grid), dim3(NWAVES * 64), LDS_BYTES, stream, a);
#ifdef X3
            if (ph == 11) n_gate_fin<<<M * 3072 / 256, 256, 0, stream>>>(GZ, p.gate_bias);
#endif
#ifdef X2
            if (ph == 11) n_gemm<1, DGate><<<dim3(3072 / 64, M / 64), 256, 0, stream>>>(DGate{XN, p.w_in, p.gate_bias, GZ, M, 3072, D, 0});
#endif
            ph = e; continue; }
        switch (ph) {
        case 0: n_rope_tab<<<M * 16 / 256, 256, 0, stream>>>(p.pos, cs, sn); n_rmsnorm<false><<<M / 4, 256, 0, stream>>>(p.x, p.ffn1_norm, XN, nullptr, M); n_rmsnorm<false><<<MMEM / 4, 256, 0, stream>>>(p.mem, p.mem_norm, MEMN, nullptr, MMEM); break;
        case 1: n_gemm<2, DUp><<<dim3(FF / 64, M / 64), 256, 0, stream>>>(DUp{XN, p.ffn1_wg, p.ffn1_wu, ACT, M, FF, D, 0}); break;
        case 2: n_gemm<1, DRes><<<dim3(D / 64, M / 64), 256, 0, stream>>>(DRes{ACT, p.ffn1_wd, p.x, p.out, M, D, FF, FF, 0.5f, 0}); break;
        case 3: n_rmsnorm<false><<<M / 4, 256, 0, stream>>>(p.out, p.mix_norm, XN, nullptr, M); break;
        case 4: n_gemm<1, DE1><<<dim3(Z1_W / 64, M / 64), 256, 0, stream>>>(DE1{XN, p.w_in, ZC, ZKV, ZG, ZXQ, M, Z1_W, D, 0});
                n_gemm<1, DPlain><<<dim3(1024 / 64, MMEM / 64), 256, 0, stream>>>(DPlain{MEMN, p.x_w_kv, KVX, MMEM, 1024, D, D, 1024, 1024});
                n_ssq<<<(M * 20 + 255) / 256, 256, 0, stream>>>(ZC, ZKV, ssqq, ssqkv); break;
        case 5: n_gla_rec<<<NB * 4, 128, 0, stream>>>(ZC, ZG, p.w_a2, p.b_a, OTMP); n_gla_fin<<<M * 4 / 4, 256, 0, stream>>>(OTMP, ZG, p.o_norm, OGLA); break;
        case 6: case 7: break;
        case 8: n_gemm<1, DQ><<<dim3(QW / 64, M / 64), 256, 0, stream>>>(DQ{ZC, p.w_uq, p.q_norm, ssqq, Q, M, QW, 384, 0});
                n_gemm<1, DKV><<<dim3(KVW / 64, M / 64), 256, 0, stream>>>(DKV{ZKV, p.w_ukv, p.kv_norm, ssqkv, KVM, M, KVW, 256, 0});
                n_rope<<<(M * 144 + 255) / 256, 256, 0, stream>>>(Q, ZC, KR, cs, sn); break;
        case 9: n_mla_attn<<<NB * 8 * SEQ * 4 / 256, 256, 0, stream>>>(Q, KVM, KR, OMLA); break;
        case 10: { bf16* OXT = (bf16*)(ws + SC_DS); n_cross_attn<<<NB * 4 * SEQ * 4 / 256, 256, 0, stream>>>(ZXQ, KVX, OXT); (void)hipMemcpyAsync(OX, OXT, (size_t)M * 512 * 2, hipMemcpyDeviceToDevice, stream); } break;
        case 11: n_gemm<1, DGate><<<dim3(3072 / 64, M / 64), 256, 0, stream>>>(DGate{XN, p.w_in, p.gate_bias, GZ, M, 3072, D, 0}); break;
        case 12: n_gemm<3, DMerge><<<dim3(D / 64, M / 64), 256, 0, stream>>>(DMerge{OMLA, p.w_o_mla, p.w_o_gla, p.x_w_o, GZ, MERGED, M, D, 512, 0}); break;
        case 13: n_gemm<1, DRes><<<dim3(D / 64, M / 64), 256, 0, stream>>>(DRes{MERGED, p.w_out, p.out, p.out, M, D, D, D, 1.0f, 0}); break;
        case 14: n_rmsnorm<false><<<M / 4, 256, 0, stream>>>(p.out, p.ffn2_norm, XN, nullptr, M); break;
        case 15: n_gemm<2, DUp><<<dim3(FF / 64, M / 64), 256, 0, stream>>>(DUp{XN, p.ffn2_wg, p.ffn2_wu, ACT, M, FF, D, 0}); break;
        case 16: n_gemm<1, DRes><<<dim3(D / 64, M / 64), 256, 0, stream>>>(DRes{ACT, p.ffn2_wd, p.out, p.out, M, D, FF, FF, 0.5f, 0}); break;
        case 17: n_rmsnorm<true><<<M / 4, 256, 0, stream>>>(p.out, p.final_norm, nullptr, p.out, M); break;
        }
        ++ph;
    }
}
```
